# Optimizing an MI355X kernel written in HIP

```python
import math
import jax
import jax.numpy as jnp
from jax import lax
import numpy as np

D_MODEL = 1024
BATCH = 8
SEQ = 4096
DEPTH = 1

SSD_D_INNER = 1024
SSD_HEADDIM = 64
SSD_HEADS = SSD_D_INNER // SSD_HEADDIM
SSD_GROUPS = 2
SSD_HPG = SSD_HEADS // SSD_GROUPS
SSD_STATE = 128
CONV_WIDTH = 3
CHUNK = 128
SSD_CONV_DIM = SSD_D_INNER + 2 * SSD_GROUPS * SSD_STATE

MLA_HEADS = 16
QK_NOPE = 64
QK_ROPE = 32
V_HEAD = 64
Q_LORA = 384
KV_LORA = 256
Q_BLOCK = 128
ROPE_THETA = 10000.0

PEER_HEADS = 8
N_KEYS = 128
N_EXPERTS = N_KEYS * N_KEYS
KEY_HALF = 128
PEER_TOPK = 16
TOK_BLOCK = 128

EPS = 1e-6

IN_SIZES = (SSD_D_INNER, SSD_CONV_DIM, 2 * SSD_HEADS, Q_LORA, KV_LORA, QK_ROPE, 2 * D_MODEL)
IN_COLS = sum(IN_SIZES)

kernel_name = "hybrid_ssd_mla_peer_block"


def _split_points(sizes):
    pts, acc = [], 0
    for s in sizes[:-1]:
        acc += s
        pts.append(acc)
    return pts


def rms_norm(x, w):
    xf = x.astype(jnp.float32)
    y = xf * lax.rsqrt(jnp.mean(xf * xf, axis=-1, keepdims=True) + EPS)
    return (y * w.astype(jnp.float32)).astype(x.dtype)


def depthwise_conv_centred(x, w, b):
    c = x.shape[-1]
    k = w.shape[0]
    y = lax.conv_general_dilated(x, w[:, None, :], window_strides=(1,),
                                 padding=[(k // 2, k // 2)],
                                 dimension_numbers=('NWC', 'WIO', 'NWC'),
                                 feature_group_count=c)
    return y + b


def segsum(a):
    t = a.shape[-1]
    cs = jnp.cumsum(a, axis=-1)
    diff = cs[..., :, None] - cs[..., None, :]
    mask = jnp.tril(jnp.ones((t, t), dtype=bool))
    return jnp.where(mask, diff, -jnp.inf)


def ssd_scan(xh, dt, A, Bm, Cm):
    b, l, g, r, p = xh.shape
    n = Bm.shape[-1]
    c = l // CHUNK
    f32 = jnp.float32
    xd = (xh.astype(f32) * dt.astype(f32)[..., None]).reshape(b, c, CHUNK, g, r, p)
    a = (dt.astype(f32) * A.astype(f32)).reshape(b, c, CHUNK, g, r)
    a = jnp.moveaxis(a, 2, -1)
    Bc = Bm.astype(f32).reshape(b, c, CHUNK, g, n)
    Cc = Cm.astype(f32).reshape(b, c, CHUNK, g, n)
    a_cs = jnp.cumsum(a, axis=-1)
    L = jnp.exp(segsum(a))
    CB = jnp.einsum('bclgn,bcsgn->bcgls', Cc, Bc)
    y_diag = jnp.einsum('bcgls,bcgrls,bcsgrp->bclgrp', CB, L, xd)
    decay_states = jnp.exp(a_cs[..., -1:] - a_cs)
    states = jnp.einsum('bcsgn,bcgrs,bcsgrp->bcgrpn', Bc, decay_states, xd)
    chunk_tot = jnp.moveaxis(a_cs[..., -1], 1, -1)
    decay_chunk = jnp.exp(segsum(jnp.pad(chunk_tot, ((0, 0), (0, 0), (0, 0), (1, 0)))))
    states0 = jnp.pad(states, ((0, 0), (1, 0), (0, 0), (0, 0), (0, 0), (0, 0)))
    new_states = jnp.einsum('bgrzc,bcgrpn->bzgrpn', decay_chunk, states0)
    prev = new_states[:, :-1]
    state_decay_out = jnp.exp(a_cs)
    y_off = jnp.einsum('bclgn,bcgrpn,bcgrl->bclgrp', Cc, prev, state_decay_out)
    return (y_diag + y_off).reshape(b, l, g, r, p)


def rope_tables(positions, dim, dtype):
    inv = 1.0 / (ROPE_THETA ** (jnp.arange(0, dim, 2, dtype=jnp.float32) / dim))
    ang = positions.astype(jnp.float32)[..., None] * inv
    return jnp.cos(ang).astype(dtype), jnp.sin(ang).astype(dtype)


def apply_rope(x, cos, sin):
    x1, x2 = jnp.split(x, 2, axis=-1)
    return jnp.concatenate([x1 * cos - x2 * sin, x1 * sin + x2 * cos], axis=-1)


def mla_attention(q_nope, q_rope, k_nope, k_rope, v):
    b, s, h, _ = q_nope.shape
    nb = s // Q_BLOCK
    scale = (QK_NOPE + QK_ROPE) ** -0.5

    def block(args):
        qn, qr = args
        sc = (jnp.einsum('bqhd,bkhd->bhqk', qn, k_nope)
              + jnp.einsum('bqhd,bkd->bhqk', qr, k_rope))
        p = jax.nn.softmax(sc.astype(jnp.float32) * scale, axis=-1).astype(v.dtype)
        return jnp.einsum('bhqk,bkhd->bqhd', p, v)

    qn_b = q_nope.reshape(b, nb, Q_BLOCK, h, QK_NOPE).swapaxes(0, 1)
    qr_b = q_rope.reshape(b, nb, Q_BLOCK, h, QK_ROPE).swapaxes(0, 1)
    out = lax.map(block, (qn_b, qr_b))
    return out.swapaxes(0, 1).reshape(b, s, h * V_HEAD)


def peer_ffn(u, w_q, sub_keys, peer_u, peer_v):
    b, s, d = u.shape
    ub = u.reshape((b * s) // TOK_BLOCK, TOK_BLOCK, d)

    def block(ut):
        q = (ut @ w_q).reshape(TOK_BLOCK, PEER_HEADS, 2, KEY_HALF)
        sc = jnp.einsum('thid,ind->thin', q, sub_keys).astype(jnp.float32)
        v_top, i_top = lax.top_k(sc, PEER_TOPK)
        cand = v_top[:, :, 0, :, None] + v_top[:, :, 1, None, :]
        cand_idx = i_top[:, :, 0, :, None] * N_KEYS + i_top[:, :, 1, None, :]
        cand = cand.reshape(TOK_BLOCK, PEER_HEADS, PEER_TOPK * PEER_TOPK)
        cand_idx = cand_idx.reshape(TOK_BLOCK, PEER_HEADS, PEER_TOPK * PEER_TOPK)
        best, pos = lax.top_k(cand, PEER_TOPK)
        idx = jnp.take_along_axis(cand_idx, pos, axis=-1)
        gate = jax.nn.softmax(best, axis=-1).astype(ut.dtype)
        act = jax.nn.gelu(jnp.einsum('td,thkd->thk', ut, peer_u[idx]), approximate=False)
        return jnp.einsum('thk,thkd->td', gate * act, peer_v[idx])

    return lax.map(block, ub).reshape(b, s, d)


def setup_inputs(seed: int = 0) -> dict:
    key = jax.random.key(seed)
    ks = jax.random.split(key, 32)
    f32 = jnp.float32
    nrm = lambda k, shape, scale: jax.random.normal(k, shape, f32) * scale
    gain = lambda k, n: 1.0 + 0.1 * jax.random.normal(k, (n,), f32)

    x = jax.random.normal(ks[0], (BATCH, SEQ, D_MODEL), f32)
    offsets = jax.random.randint(ks[1], (BATCH, 1), 0, 4096, dtype=jnp.int32)
    positions = offsets + jnp.arange(SEQ, dtype=jnp.int32)[None, :]

    dt_init_f = jnp.exp(jax.random.uniform(ks[6], (SSD_HEADS,), f32, math.log(1e-3), math.log(1e-1)))
    dt_init_b = jnp.exp(jax.random.uniform(ks[7], (SSD_HEADS,), f32, math.log(1e-3), math.log(1e-1)))
    inv_softplus = lambda t: t + jnp.log(-jnp.expm1(-t))

    return {
        "x": x,
        "positions": positions,
        "norm_mix_w": gain(ks[2], D_MODEL),
        "w_in": nrm(ks[3], (D_MODEL, IN_COLS), D_MODEL ** -0.5),
        "conv_w": nrm(ks[4], (CONV_WIDTH, SSD_CONV_DIM), CONV_WIDTH ** -0.5),
        "conv_b": nrm(ks[5], (SSD_CONV_DIM,), 0.02),
        "dt_bias_fwd": inv_softplus(dt_init_f),
        "dt_bias_bwd": inv_softplus(dt_init_b),
        "a_log_fwd": jnp.log(jax.random.uniform(ks[8], (SSD_HEADS,), f32, 1.0, 16.0)),
        "a_log_bwd": jnp.log(jax.random.uniform(ks[9], (SSD_HEADS,), f32, 1.0, 16.0)),
        "d_skip": gain(ks[10], SSD_HEADS),
        "ssd_norm_w": gain(ks[11], SSD_D_INNER),
        "q_a_norm_w": gain(ks[12], Q_LORA),
        "w_q_b": nrm(ks[13], (Q_LORA, MLA_HEADS * (QK_NOPE + QK_ROPE)), Q_LORA ** -0.5),
        "kv_a_norm_w": gain(ks[14], KV_LORA),
        "w_kv_b": nrm(ks[15], (KV_LORA, MLA_HEADS * (QK_NOPE + V_HEAD)), KV_LORA ** -0.5),
        "w_proj_ssd": nrm(ks[16], (SSD_D_INNER, D_MODEL), SSD_D_INNER ** -0.5),
        "w_proj_mla": nrm(ks[17], (MLA_HEADS * V_HEAD, D_MODEL), (MLA_HEADS * V_HEAD) ** -0.5),
        "w_out": nrm(ks[18], (D_MODEL, D_MODEL), D_MODEL ** -0.5),
        "norm_ffn_w": gain(ks[19], D_MODEL),
        "peer_w_q": nrm(ks[20], (D_MODEL, PEER_HEADS * 2 * KEY_HALF), D_MODEL ** -0.5),
        "peer_sub_keys": nrm(ks[21], (2, N_KEYS, KEY_HALF), KEY_HALF ** -0.5),
        "peer_u": nrm(ks[22], (N_EXPERTS, D_MODEL), D_MODEL ** -0.5),
        "peer_v": nrm(ks[23], (N_EXPERTS, D_MODEL), 0.5),
        "norm_final_w": gain(ks[24], D_MODEL),
    }


def reference(x, positions, norm_mix_w, w_in, conv_w, conv_b, dt_bias_fwd, dt_bias_bwd,
              a_log_fwd, a_log_bwd, d_skip, ssd_norm_w, q_a_norm_w, w_q_b, kv_a_norm_w,
              w_kv_b, w_proj_ssd, w_proj_mla, w_out, norm_ffn_w, peer_w_q, peer_sub_keys,
              peer_u, peer_v, norm_final_w):
    b, s, _ = x.shape
    h = x
    for _layer in range(DEPTH):
        u = rms_norm(h, norm_mix_w)
        proj = u @ w_in
        z, xbc, dt_raw, q_a, kv_a, k_rope, gate_logits = jnp.split(proj, _split_points(IN_SIZES), axis=-1)

        xbc = jax.nn.silu(depthwise_conv_centred(xbc, conv_w, conv_b))
        xs, Bm, Cm = jnp.split(xbc, [SSD_D_INNER, SSD_D_INNER + SSD_GROUPS * SSD_STATE], axis=-1)
        xh = xs.reshape(b, s, SSD_GROUPS, SSD_HPG, SSD_HEADDIM)
        Bm = Bm.reshape(b, s, SSD_GROUPS, SSD_STATE)
        Cm = Cm.reshape(b, s, SSD_GROUPS, SSD_STATE)
        dt_f_raw, dt_b_raw = jnp.split(dt_raw, 2, axis=-1)
        dt_f = jax.nn.softplus(dt_f_raw + dt_bias_fwd).reshape(b, s, SSD_GROUPS, SSD_HPG)
        dt_b = jax.nn.softplus(dt_b_raw + dt_bias_bwd).reshape(b, s, SSD_GROUPS, SSD_HPG)
        A_f = -jnp.exp(a_log_fwd).reshape(SSD_GROUPS, SSD_HPG)
        A_b = -jnp.exp(a_log_bwd).reshape(SSD_GROUPS, SSD_HPG)
        flip = lambda t: jnp.flip(t, axis=1)
        y_f = ssd_scan(xh, dt_f, A_f, Bm, Cm)
        y_b = flip(ssd_scan(flip(xh), flip(dt_b), A_b, flip(Bm), flip(Cm)))
        y = (y_f + y_b).astype(h.dtype) + xh * d_skip.reshape(SSD_GROUPS, SSD_HPG, 1)
        yg = (y.reshape(b, s, SSD_D_INNER) * jax.nn.silu(z)).reshape(b, s, SSD_GROUPS, SSD_D_INNER // SSD_GROUPS)
        y_ssd = rms_norm(yg, ssd_norm_w.reshape(SSD_GROUPS, SSD_D_INNER // SSD_GROUPS)).reshape(b, s, SSD_D_INNER)

        q = (rms_norm(q_a, q_a_norm_w) @ w_q_b).reshape(b, s, MLA_HEADS, QK_NOPE + QK_ROPE)
        q_nope, q_rope = jnp.split(q, [QK_NOPE], axis=-1)
        kv = (rms_norm(kv_a, kv_a_norm_w) @ w_kv_b).reshape(b, s, MLA_HEADS, QK_NOPE + V_HEAD)
        k_nope, v = jnp.split(kv, [QK_NOPE], axis=-1)
        cos, sin = rope_tables(positions, QK_ROPE, h.dtype)
        q_rope = apply_rope(q_rope, cos[:, :, None, :], sin[:, :, None, :])
        k_rope = apply_rope(k_rope, cos, sin)
        y_mla = mla_attention(q_nope, q_rope, k_nope, k_rope, v)

        g_ssd, g_mla = jnp.split(jax.nn.sigmoid(gate_logits), 2, axis=-1)
        m = g_ssd * (y_ssd @ w_proj_ssd) + g_mla * (y_mla @ w_proj_mla)
        h = h + m @ w_out

        h = h + peer_ffn(rms_norm(h, norm_ffn_w), peer_w_q, peer_sub_keys, peer_u, peer_v)
    return rms_norm(h, norm_final_w)
```

```cpp
#include <hip/hip_runtime.h>
#include <hip/hip_cooperative_groups.h>
#include <cstdio>
#include <cstdint>
namespace cg = cooperative_groups;

#define LAS __attribute__((address_space(3)))
typedef unsigned short bf16_t;
typedef short bf16x8 __attribute__((ext_vector_type(8)));
typedef float f32x4 __attribute__((ext_vector_type(4)));
typedef float f32x2 __attribute__((ext_vector_type(2)));
typedef float f32x16 __attribute__((ext_vector_type(16)));
typedef unsigned u32x4 __attribute__((ext_vector_type(4)));
typedef unsigned u32x2 __attribute__((ext_vector_type(2)));

constexpr int BATCH = 8, SEQ = 4096, TOK = BATCH * SEQ, DM = 1024;
constexpr int NW = 8, NT = NW * 64;
constexpr int CHUNK = 128, NCHUNK = SEQ / CHUNK;
constexpr int IN_PAD = 5376;
constexpr int QW = 1536, KW = 1024;
constexpr float EPS = 1e-6f;
constexpr float QSCALE = 0.10206207261596577f * 1.4426950408889634f;

__device__ __forceinline__ unsigned f2bf(float f) { unsigned u = __builtin_bit_cast(unsigned, f); return (u + 0x7fffu + ((u >> 16) & 1u)) >> 16; }
typedef __bf16 bf16x2_t __attribute__((ext_vector_type(2)));
__device__ __forceinline__ unsigned pk2(float lo, float hi) { f32x2 v = {lo, hi}; bf16x2_t b = __builtin_convertvector(v, bf16x2_t); return __builtin_bit_cast(unsigned, b); }
__device__ __forceinline__ float bflo(unsigned u) { return __builtin_bit_cast(float, u << 16); }
__device__ __forceinline__ float bfhi(unsigned u) { return __builtin_bit_cast(float, u & 0xffff0000u); }
__device__ __forceinline__ float bf1(bf16_t u) { return __builtin_bit_cast(float, (unsigned)u << 16); }
__device__ __forceinline__ float wave_sum(float v) {
#pragma unroll
    for (int o = 1; o < 64; o <<= 1) v += __shfl_xor(v, o);
    return v;
}
__device__ __forceinline__ int opaque_bx() { int b = blockIdx.x; asm volatile("" : "+s"(b)); return b; }
__device__ __forceinline__ int opaque_tid() { int t = threadIdx.x; asm volatile("" : "+v"(t)); return t; }
__device__ __forceinline__ float fast_rcp(float x) { return __builtin_amdgcn_rcpf(x); }
__device__ __forceinline__ float sigmoidf_(float x) { return fast_rcp(1.f + __expf(-x)); }
__device__ __forceinline__ float siluf_(float x) { return x * sigmoidf_(x); }

#define SWAP_PAIR(BUILTIN, x, r0, r1) unsigned r0, r1; { unsigned a_ = __builtin_bit_cast(unsigned, x), b_ = a_; asm volatile("" : "+v"(b_)); auto r_ = BUILTIN(a_, b_, false, false); r0 = r_[0]; r1 = r_[1]; asm volatile("" : "+v"(r0), "+v"(r1)); }

template <int CTRL> __device__ __forceinline__ float dppf(float x) { return __builtin_bit_cast(float, __builtin_amdgcn_update_dpp(0, __builtin_bit_cast(int, x), CTRL, 0xF, 0xF, true)); }
__device__ __forceinline__ float swap16_max(float x) { SWAP_PAIR(__builtin_amdgcn_permlane16_swap, x, r0, r1); return fmaxf(__builtin_bit_cast(float, r0), __builtin_bit_cast(float, r1)); }
__device__ __forceinline__ float swap32_max(float x) { SWAP_PAIR(__builtin_amdgcn_permlane32_swap, x, r0, r1); return fmaxf(__builtin_bit_cast(float, r0), __builtin_bit_cast(float, r1)); }
__device__ __forceinline__ float swap16_sum(float x) { SWAP_PAIR(__builtin_amdgcn_permlane16_swap, x, r0, r1); return __builtin_bit_cast(float, r0) + __builtin_bit_cast(float, r1); }
__device__ __forceinline__ float swap32_sum(float x) { SWAP_PAIR(__builtin_amdgcn_permlane32_swap, x, r0, r1); return __builtin_bit_cast(float, r0) + __builtin_bit_cast(float, r1); }
__device__ __forceinline__ float wave_max(float x) {
    x = fmaxf(x, dppf<0xB1>(x)); x = fmaxf(x, dppf<0x4E>(x)); x = fmaxf(x, dppf<0x141>(x)); x = fmaxf(x, dppf<0x140>(x));
    return swap32_max(swap16_max(x));
}
__device__ __forceinline__ float row_sum16(float x) {
    x += dppf<0xB1>(x); x += dppf<0x4E>(x); x += dppf<0x141>(x); x += dppf<0x140>(x); return x;
}
__device__ __forceinline__ float wave_sum_fast(float x) { return swap32_sum(swap16_sum(row_sum16(x))); }

namespace pg8 {
constexpr int BM = 256, BK = 64, HALF = 128, HTB = HALF * BK * 2, STAGE_BYTES = 8 * HTB, NXCD = 8, WGM = 8;
__host__ __device__ __forceinline__ int lds_byte(int r, int c) { const int st = (r >> 4) * 2 + (c >> 5), rr = r & 15, cc = c & 31, ob = rr * 64 + cc * 2; return st * 1024 + (ob ^ (((ob >> 9) & 1) << 5)); }
__host__ __device__ __forceinline__ void stage_rc(int b, int& R, int& C) { const int st = b / 1024, sb = b % 1024, swz = sb ^ (((sb >> 9) & 1) << 5); R = (st >> 1) * 16 + swz / 64; C = (st & 1) * 32 + (swz % 64) / 2; }
__host__ __device__ __forceinline__ int perm32(int rho) { const int n = rho >> 4, i = rho & 15; return 8 * (i >> 2) + 4 * n + (i & 3); }
struct Unit { int pm, pn; };
struct Gemm { const bf16_t* A; const bf16_t* Bt; int M, N, K, lda, ldb; };
struct StaticOrder {
    int nM, nN, nwg, G, c;
    __device__ void init(int M, int N, int G_, int c_) { nM = M / BM; nN = N / BM; nwg = nM * nN; G = G_; c = c_; }
    __device__ bool next(int i, Unit& u) const {
        const long L = (long)i * G + c; if (L >= nwg) return false;
        int wgid = (int)L; { const int q = nwg / NXCD, r = nwg % NXCD, xcd = wgid % NXCD, off = wgid / NXCD; wgid = (xcd < r ? xcd * (q + 1) : r * (q + 1) + (xcd - r) * q) + off; }
        const int nig = WGM * nN, gid = wgid / nig, fm = gid * WGM, gsz = (nM - fm) < WGM ? (nM - fm) : WGM;
        u.pm = fm + ((wgid % nig) % gsz); u.pn = (wgid % nig) / gsz; return true;
    }
};
template <class Epi>
__device__ __forceinline__ void gemm_phase(LAS unsigned char* lds, const Gemm g, const StaticOrder& S, const Epi& E) {
    const int tid = opaque_tid(), wid = __builtin_amdgcn_readfirstlane(tid >> 6), lane = tid & 63, wr = wid >> 2, wc = wid & 3, fr = lane & 15, fq = lane >> 4;
    const int K = g.K, nt = K / BK;
    unsigned voffA[2], voffB[2];
#pragma unroll
    for (int i = 0; i < 2; ++i) { int R, C; stage_rc(tid * 16 + i * 8192, R, C); const int Rb = (R & ~31) + perm32(R & 31);
        voffA[i] = (unsigned)(R * g.lda + C) * 2u; voffB[i] = (unsigned)(Rb * g.ldb + C) * 2u; }
    const size_t kstep = (size_t)(BK * 2);
    const size_t hstepA = (size_t)HALF * g.lda * 2, hstepB = (size_t)HALF * g.ldb * 2;
    const size_t tstepA = 2 * hstepA, tstepB = 2 * hstepB;
    const unsigned ldsw = (unsigned)wid * 1024u;
    const int aoff = lds_byte(wr * 64 + fr, fq * 8), boff = lds_byte(wc * 32 + fr, fq * 8);
#define PG8_SA(b, h) (((b) * 2 + (h)) * HTB)
#define PG8_SB(b, h) ((4 + (b) * 2 + (h)) * HTB)
#define PG8_STAGE(bufoff, gbase, voff) do { _Pragma("unroll") for (int _i = 0; _i < 2; ++_i) \
        __builtin_amdgcn_global_load_lds((const unsigned*)((const char*)(gbase) + (voff)[_i]), (LAS unsigned*)(lds + (bufoff) + ldsw + _i * 8192), 16, 0, 0); } while (0)
#define PG8_LDA(dst, b, h) do { _Pragma("unroll") for (int m = 0; m < 4; ++m) _Pragma("unroll") for (int k = 0; k < 2; ++k) dst[m][k] = *(const LAS bf16x8*)(lds + PG8_SA(b, h) + aoff + m * 2048 + k * 1024); } while (0)
#define PG8_LDB(dst, b, h) do { _Pragma("unroll") for (int n = 0; n < 2; ++n) _Pragma("unroll") for (int k = 0; k < 2; ++k) dst[n][k] = *(const LAS bf16x8*)(lds + PG8_SB(b, h) + boff + n * 2048 + k * 1024); } while (0)
#define PG8_MMA(ai, bj, At, Bt) do { __builtin_amdgcn_s_setprio(1); _Pragma("unroll") for (int m = 0; m < 4; ++m) _Pragma("unroll") for (int n = 0; n < 2; ++n) _Pragma("unroll") for (int k = 0; k < 2; ++k) \
        acc[ai][bj][m][n] = __builtin_amdgcn_mfma_f32_16x16x32_bf16(Bt[n][k], At[m][k], acc[ai][bj][m][n], 0, 0, 0); __builtin_amdgcn_s_setprio(0); } while (0)
#define PG8_WAIT_V(n) asm volatile("s_waitcnt vmcnt(" #n ")" ::: "memory")
#define PG8_WAIT_L(n) asm volatile("s_waitcnt lgkmcnt(" #n ")" ::: "memory")
#define PG8_BAR __builtin_amdgcn_s_barrier()
#define PG8_SCHED __builtin_amdgcn_sched_barrier(0)
    Unit cur, nxt; int ui = 0;
    if (!S.next(0, cur)) return;
    f32x4 acc[2][2][4][2];
#pragma unroll
    for (int a = 0; a < 2; ++a)
#pragma unroll
        for (int b = 0; b < 2; ++b)
#pragma unroll
            for (int m = 0; m < 4; ++m)
#pragma unroll
                for (int n = 0; n < 2; ++n) acc[a][b][m][n] = (f32x4){0.f, 0.f, 0.f, 0.f};
    bf16x8 At[4][2], B0[2][2], B1[2][2];
    const char* cA = (const char*)g.A + (size_t)cur.pm * tstepA; const char* cB = (const char*)g.Bt + (size_t)cur.pn * tstepB;
    PG8_STAGE(PG8_SB(0, 0), cB, voffB); PG8_STAGE(PG8_SB(0, 1), cB + hstepB, voffB); PG8_STAGE(PG8_SA(0, 0), cA, voffA); PG8_STAGE(PG8_SA(0, 1), cA + hstepA, voffA);
    if (wr == 1) PG8_BAR;
    PG8_WAIT_V(2); PG8_BAR;
    PG8_STAGE(PG8_SB(1, 0), cB + kstep, voffB); PG8_STAGE(PG8_SA(1, 0), cA + kstep, voffA); PG8_STAGE(PG8_SB(1, 1), cB + hstepB + kstep, voffB);
    PG8_WAIT_V(6); PG8_BAR;
    for (;;) {
        const bool has_next = S.next(ui + 1, nxt);
        const char* nA = has_next ? (const char*)g.A + (size_t)nxt.pm * tstepA : cA; const char* nB = has_next ? (const char*)g.Bt + (size_t)nxt.pn * tstepB : cB;
#pragma unroll 1
        for (int t = 0; t < nt; t += 2) {
            const bool last = (t == nt - 2);
            const char* a1 = cA + (size_t)(t + 1) * kstep;
            const char* a2 = last ? nA : cA + (size_t)(t + 2) * kstep; const char* b2 = last ? nB : cB + (size_t)(t + 2) * kstep;
            const char* a3 = a2 + kstep; const char* b3 = b2 + kstep;
            PG8_LDB(B0, 0, 0); PG8_LDB(B1, 0, 1); PG8_SCHED; PG8_LDA(At, 0, 0); PG8_STAGE(PG8_SA(1, 1), a1 + hstepA, voffA);
            PG8_WAIT_V(8); PG8_WAIT_L(0); PG8_BAR; PG8_MMA(0, 0, At, B0); PG8_MMA(0, 1, At, B1); PG8_BAR; PG8_SCHED;
            PG8_LDA(At, 0, 1); PG8_STAGE(PG8_SB(0, 0), b2, voffB); PG8_STAGE(PG8_SB(0, 1), b2 + hstepB, voffB); PG8_STAGE(PG8_SA(0, 0), a2, voffA);
            PG8_WAIT_V(8); PG8_WAIT_L(0); PG8_BAR; PG8_MMA(1, 0, At, B0); PG8_MMA(1, 1, At, B1); PG8_BAR; PG8_SCHED;
            PG8_LDB(B0, 1, 0); PG8_LDB(B1, 1, 1); PG8_SCHED; PG8_LDA(At, 1, 0); PG8_STAGE(PG8_SA(0, 1), a2 + hstepA, voffA);
            PG8_WAIT_V(8); PG8_WAIT_L(0); PG8_BAR; PG8_MMA(0, 0, At, B0); PG8_MMA(0, 1, At, B1); PG8_BAR; PG8_SCHED;
            PG8_LDA(At, 1, 1); PG8_STAGE(PG8_SB(1, 0), b3, voffB); PG8_STAGE(PG8_SB(1, 1), b3 + hstepB, voffB); PG8_STAGE(PG8_SA(1, 0), a3, voffA);
            PG8_WAIT_V(8); PG8_WAIT_L(0); PG8_BAR; PG8_MMA(1, 0, At, B0); PG8_MMA(1, 1, At, B1); PG8_BAR; PG8_SCHED;
        }
        if (wr == 0) PG8_BAR;
        E(acc, cur, wr, wc, fr, fq);
        if (!has_next) break;
#pragma unroll
        for (int a = 0; a < 2; ++a)
#pragma unroll
            for (int b = 0; b < 2; ++b)
#pragma unroll
                for (int m = 0; m < 4; ++m)
#pragma unroll
                    for (int n = 0; n < 2; ++n) acc[a][b][m][n] = (f32x4){0.f, 0.f, 0.f, 0.f};
        cur = nxt; cA = nA; cB = nB; ++ui;
        if (wr == 1) PG8_BAR;
    }
    PG8_WAIT_V(0);
    PG8_BAR;
#undef PG8_SA
#undef PG8_SB
#undef PG8_STAGE
#undef PG8_LDA
#undef PG8_LDB
#undef PG8_MMA
#undef PG8_WAIT_V
#undef PG8_WAIT_L
#undef PG8_BAR
#undef PG8_SCHED
}
template <class F>
__device__ __forceinline__ void foreach8(const f32x4 (&acc)[2][2][4][2], const Unit& u, int wr, int wc, int fr, int fq, F&& f) {
#pragma unroll
    for (int ai = 0; ai < 2; ++ai)
#pragma unroll
        for (int m = 0; m < 4; ++m) { const int row = u.pm * 256 + ai * 128 + wr * 64 + m * 16 + fr;
#pragma unroll
            for (int bj = 0; bj < 2; ++bj) { const int col = u.pn * 256 + bj * 128 + wc * 32 + 8 * fq; f(row, col, acc[ai][bj][m][0], acc[ai][bj][m][1]); }
            if (m == 3) asm volatile("" ::: "memory"); }
}
template <int MB, class D, class L, class F>
__device__ __forceinline__ void foreach8_batched(const f32x4 (&acc)[2][2][4][2], const Unit& u, int wr, int wc, int fr, int fq, L&& load, F&& apply) {
#pragma unroll
    for (int ai = 0; ai < 2; ++ai)
#pragma unroll
        for (int m0 = 0; m0 < 4; m0 += MB) {
            D d[MB][2];
#pragma unroll
            for (int mm = 0; mm < MB; ++mm) { const int row = u.pm * 256 + ai * 128 + wr * 64 + (m0 + mm) * 16 + fr;
#pragma unroll
                for (int bj = 0; bj < 2; ++bj) { const int col = u.pn * 256 + bj * 128 + wc * 32 + 8 * fq; d[mm][bj] = load(row, col); } }
#pragma unroll
            for (int mm = 0; mm < MB; ++mm) { const int row = u.pm * 256 + ai * 128 + wr * 64 + (m0 + mm) * 16 + fr;
#pragma unroll
                for (int bj = 0; bj < 2; ++bj) { const int col = u.pn * 256 + bj * 128 + wc * 32 + 8 * fq; apply(row, col, acc[ai][bj][m0 + mm][0], acc[ai][bj][m0 + mm][1], d[mm][bj]); } }
            asm volatile("" ::: "memory");
        }
}
}
constexpr size_t MiB = 1u << 20;
constexpr size_t WS_CTL = 0;
constexpr size_t WS_WIN = 1 * MiB;
constexpr size_t WS_WQB = 12 * MiB;
constexpr size_t WS_WK = 14 * MiB;
constexpr size_t WS_WV = 14 * MiB + 512 * 1024;
constexpr size_t WS_PA = 15 * MiB, WS_PB = 17 * MiB, WS_WOUT = 19 * MiB;
constexpr size_t WS_WPQ = 21 * MiB;
constexpr size_t WS_XN = 26 * MiB;
constexpr size_t WS_BC = 26 * MiB;
constexpr size_t WS_BT = 58 * MiB;
constexpr size_t WS_ACSF = 74 * MiB, WS_DTF = 76 * MiB, WS_RACSB = 78 * MiB, WS_DTB = 80 * MiB;
constexpr size_t WS_RQ = 82 * MiB, WS_RKV = 82 * MiB + 256 * 1024;
constexpr size_t WS_COS = 83 * MiB, WS_SIN = 85 * MiB;
constexpr size_t WS_KR = 508 * MiB;
constexpr size_t WS_YM = 26 * MiB;
constexpr size_t WS_PU = 490 * MiB, WS_PV = 42 * MiB;
constexpr size_t WS_PUS = 506 * MiB, WS_PVS = 59 * MiB;
constexpr size_t WS_Z = 90 * MiB;
constexpr size_t WS_YS = WS_Z;
constexpr size_t WS_G = 154 * MiB;
constexpr size_t WS_QA = 282 * MiB;
constexpr size_t WS_KVA = 314 * MiB;
constexpr size_t WS_XBC = 330 * MiB;
constexpr size_t WS_ST = 330 * MiB;
constexpr size_t WS_K = 330 * MiB;
constexpr size_t WS_VT = 426 * MiB;
constexpr size_t WS_M = 282 * MiB;
constexpr size_t WS_HB = 346 * MiB;
constexpr size_t WS_SSQ = 410 * MiB;
constexpr size_t WS_SC = 90 * MiB;
constexpr size_t WS_END = 510 * MiB;

constexpr int LDS_BYTES = 147456;

struct Args { const float* in[25]; float* out; unsigned char* ws; };
#define KIN(i) (((const float* const*)__builtin_amdgcn_kernarg_segment_ptr())[(i)])
#define KOUT() (((float* const*)__builtin_amdgcn_kernarg_segment_ptr())[25])
#define KWS() (((unsigned char* const*)__builtin_amdgcn_kernarg_segment_ptr())[26])

template <int NB, class MapF>
__device__ __forceinline__ void transpose_w(const float* __restrict__ W, int K, int Nsrc, bf16_t* __restrict__ Wt, int Ndst, const float* __restrict__ scale, float cs, MapF mapf, int gtid, int gn) {
    const int items = Ndst * (K / 8);
    for (int it0 = gtid; it0 < items; it0 += NB * gn) {
        float v[NB][8];
#pragma unroll
        for (int b = 0; b < NB; ++b) { const int it = it0 + b * gn; const bool ok = it < items; const int n = it % Ndst, k0 = (it / Ndst) * 8; const int src = ok ? mapf(n) : -1;
#pragma unroll
            for (int j = 0; j < 8; ++j) { float w = (src >= 0) ? W[(size_t)(k0 + j) * Nsrc + src] : 0.f; if (scale && ok) w *= scale[k0 + j]; v[b][j] = w * cs; } }
#pragma unroll
        for (int b = 0; b < NB; ++b) { const int it = it0 + b * gn; if (it < items) { const int n = it % Ndst, k0 = (it / Ndst) * 8;
            *(u32x4*)(Wt + (size_t)n * K + k0) = (u32x4){pk2(v[b][0], v[b][1]), pk2(v[b][2], v[b][3]), pk2(v[b][4], v[b][5]), pk2(v[b][6], v[b][7])}; } }
    }
}
template <class MapF>
__device__ __forceinline__ void transpose_tile(const float* __restrict__ W, int K, int Nsrc, bf16_t* __restrict__ Wt, const float* __restrict__ scale, float cs, MapF mapf, LAS float* scr, int item, int lane) {
    const int nkb = K >> 6; const int kb = item % nkb, nb = item / nkb, k0 = 64 * kb, n0 = 32 * nb;
    const int sb = mapf(n0);
    const int r = lane >> 3, c = lane & 7;
    f32x4 v[8];
#pragma unroll
    for (int i = 0; i < 8; ++i) v[i] = (sb >= 0) ? *(const f32x4*)(W + (size_t)(k0 + 8 * i + r) * Nsrc + sb + 4 * c) : (f32x4){0.f, 0.f, 0.f, 0.f};
    f32x4 s0 = (f32x4){cs, cs, cs, cs}, s1 = s0;
    if (scale) { s0 = *(const f32x4*)(scale + k0 + 8 * c) * cs; s1 = *(const f32x4*)(scale + k0 + 8 * c + 4) * cs; }
#pragma unroll
    for (int i = 0; i < 8; ++i)
#pragma unroll
        for (int j = 0; j < 4; ++j) scr[(8 * i + r) * 33 + 4 * c + j] = v[i][j];
    asm volatile("s_waitcnt lgkmcnt(0)" ::: "memory");
#pragma unroll
    for (int j = 0; j < 4; ++j) { const int n = r + 8 * j; const int col = (sb >= 0) ? mapf(n0 + n) - sb : 0; const LAS float* sp = scr + (8 * c) * 33 + col;
        const u32x4 o = (u32x4){pk2(sp[0 * 33] * s0[0], sp[1 * 33] * s0[1]), pk2(sp[2 * 33] * s0[2], sp[3 * 33] * s0[3]), pk2(sp[4 * 33] * s1[0], sp[5 * 33] * s1[1]), pk2(sp[6 * 33] * s1[2], sp[7 * 33] * s1[3])};
        *(u32x4*)(Wt + (size_t)(n0 + n) * K + k0 + 8 * c) = o; }
    asm volatile("s_waitcnt lgkmcnt(0)" ::: "memory");
}
struct MapIn { __device__ int operator()(int n) const {
    if (n < 2560) return n;
    if (n < 4608) return 3264 + (n - 2560);
    if (n < 4992) return 2592 + (n - 4608);
    if (n < 5024) return 2560 + (n - 4992);
    if (n < 5056) return 3232 + (n - 5024);
    if (n < 5120) return -1;
    return 2976 + (n - 5120); } };
struct MapQ { __device__ int operator()(int n) const { const int h = n / 96, dd = n % 96; if (dd < 64) return n; const int j = dd - 64, i = j >> 1; return h * 96 + 64 + ((j & 1) ? 16 + i : i); } };
struct MapKn { __device__ int operator()(int n) const { return (n >> 6) * 128 + (n & 63); } };
struct MapV { __device__ int operator()(int n) const { return (n >> 6) * 128 + 64 + (n & 63); } };
struct MapId { __device__ int operator()(int n) const { return n; } };

__device__ __forceinline__ void p0_wpq_item(const float* __restrict__ wq, const float* __restrict__ keys, const float* __restrict__ nw, bf16_t* __restrict__ Wpq, LAS unsigned char* lds, int item) {
    LAS float* kl = (LAS float*)lds;
    LAS float* wl = (LAS float*)(lds + 128 * 132 * 4);
    const int tid = opaque_tid();
    const int hh2 = item >> 4, slab = item & 15, half = hh2 & 1, k0 = slab * 64;
    {
        f32x4 kv[8], wv[4];
#pragma unroll
        for (int it = 0; it < 8; ++it) { const int i = tid + NT * it, key = i & 127, d4 = i >> 7; kv[it] = *(const f32x4*)(keys + (size_t)half * 16384 + key * 128 + d4 * 4); }
#pragma unroll
        for (int it = 0; it < 4; ++it) { const int i = tid + NT * it, kk = i & 63, d4 = i >> 6; wv[it] = *(const f32x4*)(wq + (size_t)(k0 + kk) * 2048 + hh2 * 128 + d4 * 4); }
#pragma unroll
        for (int it = 0; it < 8; ++it) { const int i = tid + NT * it, key = i & 127, d4 = i >> 7;
#pragma unroll
            for (int j = 0; j < 4; ++j) kl[(4 * d4 + j) * 132 + key] = kv[it][j]; }
#pragma unroll
        for (int it = 0; it < 4; ++it) { const int i = tid + NT * it, kk = i & 63, d4 = i >> 6;
#pragma unroll
            for (int j = 0; j < 4; ++j) wl[(4 * d4 + j) * 68 + kk] = wv[it][j]; }
    }
    __syncthreads();
    const int kq = tid & 31, kg = tid >> 5;
    f32x4 acc[4];
#pragma unroll
    for (int i = 0; i < 4; ++i) acc[i] = (f32x4){0.f, 0.f, 0.f, 0.f};
#pragma unroll 8
    for (int d = 0; d < 128; ++d) {
        const f32x4 kv = *(const LAS f32x4*)(kl + d * 132 + 4 * kq), wv = *(const LAS f32x4*)(wl + d * 68 + 4 * kg);
#pragma unroll
        for (int i = 0; i < 4; ++i) acc[i] += kv * wv[i];
    }
    const int kb = k0 + 4 * kg;
    const f32x4 nv = *(const f32x4*)(nw + kb);
#pragma unroll
    for (int j = 0; j < 4; ++j)
        *(u32x2*)(Wpq + (size_t)(hh2 * 128 + 4 * kq + j) * 1024 + kb) = (u32x2){pk2(acc[0][j] * nv[0], acc[1][j] * nv[1]), pk2(acc[2][j] * nv[2], acc[3][j] * nv[3])};
    __syncthreads();
}
__device__ __forceinline__ void rms_row_to_bf16(const float* xrow, bf16_t* orow, int lane) {
    const f32x4* xr = (const f32x4*)xrow + lane;
    f32x4 v[4]; float s = 0.f;
#pragma unroll
    for (int j = 0; j < 4; ++j) { v[j] = xr[64 * j]; s += (v[j].x * v[j].x + v[j].y * v[j].y) + (v[j].z * v[j].z + v[j].w * v[j].w); }
    const float rstd = 1.f / sqrtf(wave_sum(s) * (1.f / DM) + EPS);
    u32x2* o8 = (u32x2*)orow + lane;
#pragma unroll
    for (int j = 0; j < 4; ++j) o8[64 * j] = (u32x2){pk2(v[j].x * rstd, v[j].y * rstd), pk2(v[j].z * rstd, v[j].w * rstd)};
}
template <int NR>
__device__ __forceinline__ void rms_rows_to_bf16(const float* x, bf16_t* o, int m0, int mstride, int lane) {
    f32x4 v[NR][4];
#pragma unroll
    for (int r = 0; r < NR; ++r) { const f32x4* xr = (const f32x4*)(x + (size_t)(m0 + r * mstride) * DM) + lane;
#pragma unroll
        for (int j = 0; j < 4; ++j) v[r][j] = xr[64 * j]; }
#pragma unroll
    for (int r = 0; r < NR; ++r) { float s = 0.f;
#pragma unroll
        for (int j = 0; j < 4; ++j) s += (v[r][j].x * v[r][j].x + v[r][j].y * v[r][j].y) + (v[r][j].z * v[r][j].z + v[r][j].w * v[r][j].w);
        const float rstd = 1.f / sqrtf(wave_sum_fast(s) * (1.f / DM) + EPS);
        u32x2* o8 = (u32x2*)(o + (size_t)(m0 + r * mstride) * DM) + lane;
#pragma unroll
        for (int j = 0; j < 4; ++j) o8[64 * j] = (u32x2){pk2(v[r][j].x * rstd, v[r][j].y * rstd), pk2(v[r][j].z * rstd, v[r][j].w * rstd)}; }
}
__device__ __forceinline__ void p0_prologue(const Args& a, LAS unsigned char* lds) {
    unsigned char* ws = KWS();
    const int gtid = opaque_bx() * NT + opaque_tid(), gn = gridDim.x * NT;
    {
        const int tid0 = opaque_tid(); const int wave0 = tid0 >> 6, lane0 = tid0 & 63;
        LAS float* scr = (LAS float*)lds + wave0 * (64 * 33);
        constexpr int C0 = 16 * (IN_PAD / 32), C1 = C0 + 6 * 48, C2 = C1 + 4 * 32, C3 = C2 + 4 * 32, C4 = C3 + 16 * 32, C5 = C4 + 16 * 32, C6 = C5 + 16 * 32;
        for (int it = opaque_bx() * NW + wave0; it < C6; it += gridDim.x * NW) {
            if (it < C0) transpose_tile(KIN(3), 1024, 5312, (bf16_t*)(ws + WS_WIN), KIN(2), 1.f, MapIn(), scr, it, lane0);
            else if (it < C1) transpose_tile(KIN(13), 384, 1536, (bf16_t*)(ws + WS_WQB), KIN(12), QSCALE, MapQ(), scr, it - C0, lane0);
            else if (it < C2) transpose_tile(KIN(15), 256, 2048, (bf16_t*)(ws + WS_WK), KIN(14), 1.f, MapKn(), scr, it - C1, lane0);
            else if (it < C3) transpose_tile(KIN(15), 256, 2048, (bf16_t*)(ws + WS_WV), KIN(14), 1.f, MapV(), scr, it - C2, lane0);
            else if (it < C4) transpose_tile(KIN(16), 1024, 1024, (bf16_t*)(ws + WS_PA), KIN(11), 1.f, MapId(), scr, it - C3, lane0);
            else if (it < C5) transpose_tile(KIN(17), 1024, 1024, (bf16_t*)(ws + WS_PB), (const float*)nullptr, 1.f, MapId(), scr, it - C4, lane0);
            else transpose_tile(KIN(18), 1024, 1024, (bf16_t*)(ws + WS_WOUT), (const float*)nullptr, 1.f, MapId(), scr, it - C5, lane0);
        }
        __syncthreads();
    }
    for (int it = opaque_bx(); it < 256; it += gridDim.x) p0_wpq_item(KIN(20), KIN(21), KIN(19), (bf16_t*)(ws + WS_WPQ), lds, it);
    const int tid_ = opaque_tid(); const int wave = tid_ >> 6, lane = tid_ & 63;
    const int gw = opaque_bx() * NW + wave, ngw = gridDim.x * NW;
    for (int m = gw; m < TOK; m += 4 * ngw) rms_rows_to_bf16<4>(KIN(0), (bf16_t*)(ws + WS_XN), m, ngw, lane);
}

struct EpiInProj {
    bf16_t *Z, *XBC, *G, *QA, *KVA;
    __device__ __forceinline__ void operator()(const f32x4 (&acc)[2][2][4][2], const pg8::Unit& u, int wr, int wc, int fr, int fq) const {
        const int pn = u.pn; bf16_t* base; int ldc, cb, act;
        if (pn < 4) { base = Z; ldc = 1024; cb = pn * 256; act = 1; }
        else if (pn < 10) { base = XBC; ldc = 1536; cb = (pn - 4) * 256; act = 0; }
        else if (pn < 18) { base = G; ldc = 2048; cb = (pn - 10) * 256; act = 2; }
        else if (pn < 20) { base = QA; ldc = 512; cb = (pn - 18) * 256; act = 0; }
        else { base = KVA; ldc = 256; cb = 0; act = 0; }
        pg8::foreach8(acc, u, wr, wc, fr, fq, [&](int row, int col, f32x4 v0, f32x4 v1) {
            const int c = cb + (col - pn * 256);
            if (act == 1) {
#pragma unroll
                for (int j = 0; j < 4; ++j) { v0[j] = siluf_(v0[j]); v1[j] = siluf_(v1[j]); }
            } else if (act == 2) {
                unsigned q[8];
#pragma unroll
                for (int j = 0; j < 4; ++j) { q[j] = (unsigned)(sigmoidf_(v0[j]) * 255.f + 0.5f); q[4 + j] = (unsigned)(sigmoidf_(v1[j]) * 255.f + 0.5f); }
                *(u32x2*)((unsigned char*)base + (size_t)row * 2048 + c) = (u32x2){q[0] | (q[1] << 8) | (q[2] << 16) | (q[3] << 24), q[4] | (q[5] << 8) | (q[6] << 16) | (q[7] << 24)};
                return;
            }
            *(u32x4*)(base + (size_t)row * ldc + c) = (u32x4){pk2(v0[0], v0[1]), pk2(v0[2], v0[3]), pk2(v1[0], v1[1]), pk2(v1[2], v1[3])};
        });
    }
};
constexpr int CONV_ITEMS = (TOK / 64) * 6;
struct ConvRaw { u32x4 v[5]; };
__device__ __forceinline__ void p2_conv_load(const bf16_t* __restrict__ XBC, int item, int tid, ConvRaw& R) {
    const int slab = item / 6, grp = item % 6, t0 = slab * 64, b = t0 / SEQ, s0 = t0 % SEQ, c0 = grp * 256;
#pragma unroll
    for (int i = 0; i < 5; ++i) { const int ci = tid + NT * i, r = ci >> 5, ch = ci & 31, tok = s0 - 1 + r;
        R.v[i] = (u32x4){0u, 0u, 0u, 0u};
        if (ci < 66 * 32 && tok >= 0 && tok < SEQ) R.v[i] = *(const u32x4*)(XBC + (size_t)(b * SEQ + tok) * 1536 + c0 + ch * 8); }
}
__device__ __forceinline__ void p2_conv_item(const ConvRaw& R, const float* __restrict__ conv_w, const float* __restrict__ conv_b,
                                             bf16_t* __restrict__ XS, bf16_t* __restrict__ XST, bf16_t* __restrict__ BC, bf16_t* __restrict__ BT, LAS unsigned char* lds, int item, int tid) {
    const int slab = item / 6, grp = item % 6, t0 = slab * 64, b = t0 / SEQ, s0 = t0 % SEQ, c0 = grp * 256;
    LAS unsigned char* rawl = lds;
    LAS unsigned char* outl = lds + 66 * 528;
#pragma unroll
    for (int i = 0; i < 5; ++i) { const int ci = tid + NT * i, r = ci >> 5, ch = ci & 31; if (ci < 66 * 32) *(LAS u32x4*)(rawl + r * 528 + ch * 16) = R.v[i]; }
    __syncthreads();
    {
        const int ch = tid & 31, tk = tid >> 5;
        float w0[8], w1[8], w2[8], bb[8];
#pragma unroll
        for (int j = 0; j < 8; ++j) { const int c = c0 + ch * 8 + j; w0[j] = conv_w[c]; w1[j] = conv_w[1536 + c]; w2[j] = conv_w[3072 + c]; bb[j] = conv_b[c]; }
#pragma unroll
        for (int i = 0; i < 4; ++i) {
            const int tt = tk + 16 * i;
            const u32x4 xa = *(const LAS u32x4*)(rawl + tt * 528 + ch * 16), xb = *(const LAS u32x4*)(rawl + (tt + 1) * 528 + ch * 16), xc = *(const LAS u32x4*)(rawl + (tt + 2) * 528 + ch * 16);
            float y[8];
#pragma unroll
            for (int q = 0; q < 4; ++q) {
                y[2 * q] = bb[2 * q] + w0[2 * q] * bflo(xa[q]) + w1[2 * q] * bflo(xb[q]) + w2[2 * q] * bflo(xc[q]);
                y[2 * q + 1] = bb[2 * q + 1] + w0[2 * q + 1] * bfhi(xa[q]) + w1[2 * q + 1] * bfhi(xb[q]) + w2[2 * q + 1] * bfhi(xc[q]);
            }
#pragma unroll
            for (int j = 0; j < 8; ++j) y[j] = siluf_(y[j]);
            const u32x4 o = (u32x4){pk2(y[0], y[1]), pk2(y[2], y[3]), pk2(y[4], y[5]), pk2(y[6], y[7])};
            if (grp >= 4) *(u32x4*)(BC + (size_t)(t0 + tt) * 512 + (grp - 4) * 256 + ch * 8) = o;
            *(LAS u32x4*)(outl + tt * 528 + ch * 16) = o;
        }
    }
    __syncthreads();
    if (grp < 5) {
        bf16_t* dstT = (grp < 4) ? XST + ((size_t)b * 1024 + c0) * SEQ : BT + (size_t)b * 256 * SEQ;
#pragma unroll
        for (int i = 0; i < 4; ++i) {
            const int idx = tid + NT * i, tch = idx & 7, c = idx >> 3;
            unsigned short v[8];
#pragma unroll
            for (int j = 0; j < 8; ++j) v[j] = *(const LAS unsigned short*)(outl + (tch * 8 + j) * 528 + c * 2);
            const u32x4 o = (u32x4){(unsigned)v[0] | ((unsigned)v[1] << 16), (unsigned)v[2] | ((unsigned)v[3] << 16), (unsigned)v[4] | ((unsigned)v[5] << 16), (unsigned)v[6] | ((unsigned)v[7] << 16)};
            *(u32x4*)(dstT + (size_t)c * SEQ + s0 + tch * 8) = o;
        }
    }
    __syncthreads();
}
__device__ __forceinline__ float softplusf_(float x) { return fmaxf(x, 0.f) + log1pf(__expf(-fabsf(x))); }
__device__ __forceinline__ void p2_dt_item(const Args& a, int item, int lane) {
    unsigned char* ws = KWS();
    const bf16_t* QA = (const bf16_t*)(ws + WS_QA);
    const int hh = item & 15, bc = item >> 4, b = bc >> 5, c = bc & 31;
    const int t0 = b * SEQ + c * CHUNK, s = 2 * lane;
    const float bf = KIN(6)[hh], bbw = KIN(7)[hh], Af = -__expf(KIN(8)[hh]), Ab = -__expf(KIN(9)[hh]);
    const float dtf0 = softplusf_(bf1(QA[(size_t)(t0 + s) * 512 + 384 + hh]) + bf), dtf1 = softplusf_(bf1(QA[(size_t)(t0 + s + 1) * 512 + 384 + hh]) + bf);
    const float dtb0 = softplusf_(bf1(QA[(size_t)(t0 + s) * 512 + 400 + hh]) + bbw), dtb1 = softplusf_(bf1(QA[(size_t)(t0 + s + 1) * 512 + 400 + hh]) + bbw);
    const float af0 = dtf0 * Af, af1 = dtf1 * Af, ab0 = dtb0 * Ab, ab1 = dtb1 * Ab;
    float sf = af0 + af1, sb = ab0 + ab1;
#pragma unroll
    for (int o = 1; o < 64; o <<= 1) { const float uf = __shfl_up(sf, o), ub = __shfl_up(sb, o); if (lane >= o) { sf += uf; sb += ub; } }
    const float totb = __shfl(sb, 63);
    const float pref = sf - (af0 + af1), preb = sb - (ab0 + ab1);
    const size_t idx = ((size_t)(b * 16 + hh)) * SEQ + c * CHUNK + s;
    *(f32x2*)((float*)(ws + WS_ACSF) + idx) = (f32x2){pref + af0, pref + af0 + af1};
    *(f32x2*)((float*)(ws + WS_DTF) + idx) = (f32x2){dtf0, dtf1};
    *(f32x2*)((float*)(ws + WS_RACSB) + idx) = (f32x2){totb - preb, totb - preb - ab0};
    *(f32x2*)((float*)(ws + WS_DTB) + idx) = (f32x2){dtb0, dtb1};
}
template <int NTK>
__device__ __forceinline__ void p2_tok_items(const Args& a, int t0, int tstride, int lane) {
    unsigned char* ws = KWS();
    const bf16_t* QA = (const bf16_t*)(ws + WS_QA); const bf16_t* KVA = (const bf16_t*)(ws + WS_KVA);
    u32x4 qv[NTK], kv[NTK]; float pos[NTK], x1[NTK], x2[NTK];
#pragma unroll
    for (int k = 0; k < NTK; ++k) {
        const int t = t0 + k * tstride;
        qv[k] = (u32x4){0u, 0u, 0u, 0u}; kv[k] = (u32x4){0u, 0u, 0u, 0u}; pos[k] = 0.f; x1[k] = 0.f; x2[k] = 0.f;
        if (lane < 48) qv[k] = *(const u32x4*)(QA + (size_t)t * 512 + lane * 8);
        if (lane < 32) kv[k] = *(const u32x4*)(KVA + (size_t)t * 256 + lane * 8);
        if (lane < 16) { pos[k] = (float)((const int*)KIN(1))[t]; x1[k] = bf1(QA[(size_t)t * 512 + 416 + lane]); x2[k] = bf1(QA[(size_t)t * 512 + 432 + lane]); }
    }
#pragma unroll
    for (int k = 0; k < NTK; ++k) {
        const int t = t0 + k * tstride;
        float sq = 0.f, sk = 0.f;
#pragma unroll
        for (int q = 0; q < 4; ++q) { const float x = bflo(qv[k][q]), y = bfhi(qv[k][q]); sq += x * x + y * y; const float z = bflo(kv[k][q]), w = bfhi(kv[k][q]); sk += z * z + w * w; }
        sq = wave_sum_fast(sq); sk = wave_sum_fast(sk);
        if (lane == 0) { ((float*)(ws + WS_RQ))[t] = 1.f / sqrtf(sq * (1.f / 384.f) + EPS); ((float*)(ws + WS_RKV))[t] = 1.f / sqrtf(sk * (1.f / 256.f) + EPS); }
        if (lane < 16) {
            const int i = lane;
            const float inv = exp2f(-(float)i * (13.287712379549449f / 16.f));
            const float ang = pos[k] * inv;
            const float kk = rintf(ang * 0.15915494309189535f);
            float r = fmaf(-kk, 6.28318548202514648f, ang); r = fmaf(-kk, -1.7484555e-7f, r);
            const float sn = __sinf(r), cs = __cosf(r);
            ((unsigned*)(ws + WS_KR))[(size_t)t * 16 + i] = pk2(x1[k] * cs - x2[k] * sn, x1[k] * sn + x2[k] * cs);
            ((float*)(ws + WS_COS))[(size_t)t * 16 + i] = cs; ((float*)(ws + WS_SIN))[(size_t)t * 16 + i] = sn;
        }
    }
}
__device__ __forceinline__ void p2_prep(const Args& a, LAS unsigned char* lds) {
    unsigned char* ws = KWS();
    const int tid_ = opaque_tid(); const int wave = tid_ >> 6, lane = tid_ & 63;
    {
        const bf16_t* XBC = (const bf16_t*)(ws + WS_XBC); const int G = gridDim.x;
        int it = opaque_bx();
        ConvRaw Ra, Rb;
        if (it < CONV_ITEMS) p2_conv_load(XBC, it, tid_, Ra);
        for (; it < CONV_ITEMS; it += 2 * G) {
            if (it + G < CONV_ITEMS) p2_conv_load(XBC, it + G, tid_, Rb);
            p2_conv_item(Ra, KIN(4), KIN(5), (bf16_t*)KOUT(), (bf16_t*)KOUT() + (size_t)TOK * 1024, (bf16_t*)(ws + WS_BC), (bf16_t*)(ws + WS_BT), lds, it, tid_);
            if (it + G < CONV_ITEMS) {
                if (it + 2 * G < CONV_ITEMS) p2_conv_load(XBC, it + 2 * G, tid_, Ra);
                p2_conv_item(Rb, KIN(4), KIN(5), (bf16_t*)KOUT(), (bf16_t*)KOUT() + (size_t)TOK * 1024, (bf16_t*)(ws + WS_BC), (bf16_t*)(ws + WS_BT), lds, it + G, tid_);
            }
        }
    }
    const int gw = opaque_bx() * NW + wave, ngw = gridDim.x * NW;
    for (int it = gw; it < BATCH * NCHUNK * 16; it += ngw) p2_dt_item(a, it, lane);
    for (int t = gw; t < TOK; t += 4 * ngw) p2_tok_items<4>(a, t, ngw, lane);
}

__device__ __forceinline__ bf16x8 ld8(const bf16_t* p) { return *(const bf16x8*)p; }
__device__ __forceinline__ bf16x8 scale8(bf16x8 v, const float (&w)[8]) {
    const u32x4 u = __builtin_bit_cast(u32x4, v); u32x4 o;
#pragma unroll
    for (int q = 0; q < 4; ++q) o[q] = pk2(bflo(u[q]) * w[2 * q], bfhi(u[q]) * w[2 * q + 1]);
    return __builtin_bit_cast(bf16x8, o);
}
__device__ __forceinline__ bf16x8 scale8a(bf16x8 v, const float (&w)[8], const float (&ad)[8]) {
    const u32x4 u = __builtin_bit_cast(u32x4, v); u32x4 o;
#pragma unroll
    for (int q = 0; q < 4; ++q) o[q] = pk2(bflo(u[q]) * w[2 * q] + ad[2 * q], bfhi(u[q]) * w[2 * q + 1] + ad[2 * q + 1]);
    return __builtin_bit_cast(bf16x8, o);
}
__device__ __forceinline__ bf16x8 scale8s(bf16x8 v, float w) {
    const u32x4 u = __builtin_bit_cast(u32x4, v); u32x4 o;
#pragma unroll
    for (int q = 0; q < 4; ++q) o[q] = pk2(bflo(u[q]) * w, bfhi(u[q]) * w);
    return __builtin_bit_cast(bf16x8, o);
}
#define MFMA32(a, b, c) __builtin_amdgcn_mfma_f32_32x32x16_bf16((a), (b), (c), 0, 0, 0)

__device__ __forceinline__ void p3_states_unit(const Args& a, LAS unsigned char* lds, int unit) {
    unsigned char* ws = KWS();
    const int tid_ = opaque_tid(); const int lane = tid_ & 63, wave = tid_ >> 6, r32 = lane & 31, hi = lane >> 5;
    const int g = unit & 1, bc = unit >> 1, b = bc >> 5, c = bc & 31, hh = g * 8 + wave;
    const bf16_t* XST = (const bf16_t*)KOUT() + (size_t)TOK * 1024;
    const bf16_t* BT = (const bf16_t*)(ws + WS_BT);
    const size_t hbase = (size_t)(b * 16 + hh) * SEQ + c * CHUNK;
    LAS float* wl = (LAS float*)(lds + wave * 1024);
    {
        const float* ACSF = (const float*)(ws + WS_ACSF) + hbase; const float* DTF = (const float*)(ws + WS_DTF) + hbase;
        const float* RACSB = (const float*)(ws + WS_RACSB) + hbase; const float* DTB = (const float*)(ws + WS_DTB) + hbase;
        const float cendf = ACSF[CHUNK - 1], cendb = RACSB[0];
        const f32x2 cf = *(const f32x2*)(ACSF + 2 * lane), df = *(const f32x2*)(DTF + 2 * lane), cb = *(const f32x2*)(RACSB + 2 * lane), db = *(const f32x2*)(DTB + 2 * lane);
        *(LAS f32x2*)(wl + 2 * lane) = (f32x2){df.x * __expf(cendf - cf.x), df.y * __expf(cendf - cf.y)};
        *(LAS f32x2*)(wl + 128 + 2 * lane) = (f32x2){db.x * __expf(cendb - cb.x), db.y * __expf(cendb - cb.y)};
    }
    const bf16_t* xrow0 = XST + ((size_t)b * 1024 + hh * 64 + r32) * SEQ + c * CHUNK + 8 * hi;
    const bf16_t* brow0 = BT + ((size_t)b * 256 + g * 128 + r32) * SEQ + c * CHUNK + 8 * hi;
    bf16x8 xf[2][8];
#pragma unroll
    for (int pb = 0; pb < 2; ++pb)
#pragma unroll
        for (int ks = 0; ks < 8; ++ks) xf[pb][ks] = ld8(xrow0 + (size_t)(32 * pb) * SEQ + 16 * ks);
    asm volatile("s_waitcnt lgkmcnt(0)" ::: "memory");
#pragma unroll 1
    for (int nh = 0; nh < 2; ++nh) {
        bf16x8 bfr[2][8];
#pragma unroll
        for (int nb = 0; nb < 2; ++nb)
#pragma unroll
            for (int ks = 0; ks < 8; ++ks) bfr[nb][ks] = ld8(brow0 + (size_t)(32 * (2 * nh + nb)) * SEQ + 16 * ks);
#pragma unroll 1
        for (int dir = 0; dir < 2; ++dir) {
            f32x16 acc[2][2];
#pragma unroll
            for (int i = 0; i < 2; ++i)
#pragma unroll
                for (int j = 0; j < 2; ++j) acc[i][j] = f32x16{};
#pragma unroll
            for (int ks = 0; ks < 8; ++ks) {
                const f32x4 w0 = *(const volatile LAS f32x4*)(wl + dir * 128 + 16 * ks + 8 * hi), w1 = *(const volatile LAS f32x4*)(wl + dir * 128 + 16 * ks + 8 * hi + 4);
                const float w[8] = {w0[0], w0[1], w0[2], w0[3], w1[0], w1[1], w1[2], w1[3]};
#pragma unroll
                for (int pb = 0; pb < 2; ++pb) { u32x4 xr = __builtin_bit_cast(u32x4, xf[pb][ks]); asm volatile("" : "+v"(xr));
                    const bf16x8 xs = scale8(__builtin_bit_cast(bf16x8, xr), w);
#pragma unroll
                    for (int nb = 0; nb < 2; ++nb) acc[nb][pb] = MFMA32(bfr[nb][ks], xs, acc[nb][pb]); }
                __builtin_amdgcn_sched_barrier(0);
            }
            bf16_t* STo = (bf16_t*)(ws + WS_ST) + ((((size_t)(dir * BATCH + b) * NCHUNK + c) * 16 + hh) * 64 + r32) * 128 + 64 * nh + 4 * hi;
#pragma unroll
            for (int nb = 0; nb < 2; ++nb)
#pragma unroll
                for (int pb = 0; pb < 2; ++pb)
#pragma unroll
                    for (int q = 0; q < 4; ++q) {
                        const f32x16& v = acc[nb][pb];
                        *(u32x2*)(STo + (size_t)(32 * pb) * 128 + 32 * nb + 8 * q) = (u32x2){pk2(v[4 * q], v[4 * q + 1]), pk2(v[4 * q + 2], v[4 * q + 3])};
                    }
            __builtin_amdgcn_sched_barrier(0);
        }
    }
}
constexpr int P34_XT = 8192, P34_XROW = 272, P34_XDIR = 32 * P34_XROW, P34_XBUF = 2 * P34_XDIR;
constexpr int P34_BT = P34_XT + 2 * P34_XBUF, P34_BDIR = 128 * P34_XROW;
__device__ __forceinline__ void p34_chain(const Args& a, LAS unsigned char* lds, int unit) {
    unsigned char* ws = KWS();
    const int tid_ = opaque_tid(); const int lane = tid_ & 63, wave = tid_ >> 6, r32 = lane & 31, hi = lane >> 5;
    const int pb = unit & 1, bh = unit >> 1, b = bh >> 4, hh = bh & 15, g = hh >> 3;
    const int dir = wave >> 2, nbq = wave & 3;
    const float* CS = (const float*)(ws + (dir ? WS_RACSB : WS_ACSF)) + (size_t)(b * 16 + hh) * SEQ;
    const float* DT = (const float*)(ws + (dir ? WS_DTB : WS_DTF)) + (size_t)(b * 16 + hh) * SEQ;
    const int cendo = dir ? 0 : CHUNK - 1;
    bf16_t* STo = (bf16_t*)(ws + WS_ST) + ((((size_t)(dir * BATCH + b) * NCHUNK) * 16 + hh) * 64 + 32 * pb + r32) * 128 + 32 * nbq + 4 * hi;
    LAS float* wl = (LAS float*)(lds + wave * 1024);
    const int srow = tid_ >> 4, spc = tid_ & 15;
    const bf16_t* xg = (const bf16_t*)KOUT() + (size_t)TOK * 1024 + ((size_t)b * 1024 + hh * 64 + 32 * pb + srow) * SEQ + spc * 8;
    const bf16_t* bg = (const bf16_t*)(ws + WS_BT) + ((size_t)b * 256 + g * 128 + srow) * SEQ + spc * 8;
    const int sl = srow * P34_XROW + spc * 16;
    const int xfo = P34_XT + dir * P34_XDIR + r32 * P34_XROW + hi * 16, bfo = P34_BT + dir * P34_BDIR + (32 * nbq + r32) * P34_XROW + hi * 16;
    f32x16 P = f32x16{};
    const int c0 = dir ? NCHUNK - 1 : 0, cstep = dir ? -1 : 1;
    u32x4 sb0[8], sb1[8], sx0[2], sx1[2]; f32x2 cs0, dt0, cs1, dt1; float ce0, ce1;
#define P34_LOAD(SB, SX, CSv, DTv, CEv, idx) do { const int cf_ = (idx) * CHUNK, cb_ = (NCHUNK - 1 - (idx)) * CHUNK; \
        _Pragma("unroll") for (int k = 0; k < 4; ++k) { SB[k] = *(const u32x4*)(bg + (size_t)(32 * k) * SEQ + cf_); SB[4 + k] = *(const u32x4*)(bg + (size_t)(32 * k) * SEQ + cb_); } \
        SX[0] = *(const u32x4*)(xg + cf_); SX[1] = *(const u32x4*)(xg + cb_); \
        { const int t0_ = (c0 + (idx) * cstep) * CHUNK; CSv = *(const f32x2*)(CS + t0_ + 2 * lane); DTv = *(const f32x2*)(DT + t0_ + 2 * lane); CEv = CS[t0_ + cendo]; } } while (0)
#define P34_PUT(SB, SX, idx) do { \
        _Pragma("unroll") for (int k = 0; k < 4; ++k) { *(LAS u32x4*)(lds + P34_BT + sl + 32 * k * P34_XROW) = SB[k]; *(LAS u32x4*)(lds + P34_BT + P34_BDIR + sl + 32 * k * P34_XROW) = SB[4 + k]; } \
        LAS unsigned char* xb_ = lds + P34_XT + ((idx) & 1) * P34_XBUF + sl; *(LAS u32x4*)xb_ = SX[0]; *(LAS u32x4*)(xb_ + P34_XDIR) = SX[1]; } while (0)
#define P34_STEP(SB, SX, CSv, DTv, CEv, CSc, DTc, CEc, idx) do { \
        *(LAS f32x2*)(wl + 2 * lane) = (f32x2){DTc.x * __expf(CEc - CSc.x), DTc.y * __expf(CEc - CSc.y)}; \
        bf16x8 xf[8], bfr[8]; \
        _Pragma("unroll") for (int ks = 0; ks < 8; ++ks) { xf[ks] = *(const LAS bf16x8*)(lds + xfo + ((idx) & 1) * P34_XBUF + 32 * ks); bfr[ks] = *(const LAS bf16x8*)(lds + bfo + 32 * ks); } \
        const float dk = __expf(CEc); \
        asm volatile("s_waitcnt lgkmcnt(0)" ::: "memory"); \
        __syncthreads(); \
        if ((idx) + 1 < NCHUNK) P34_PUT(SB, SX, (idx) + 1); \
        if ((idx) + 3 < NCHUNK) P34_LOAD(SB, SX, CSv, DTv, CEv, (idx) + 3); \
        f32x16 acc = f32x16{}; \
        _Pragma("unroll") for (int ks = 0; ks < 8; ++ks) { \
            const f32x4 w0 = *(const volatile LAS f32x4*)(wl + 16 * ks + 8 * hi), w1 = *(const volatile LAS f32x4*)(wl + 16 * ks + 8 * hi + 4); \
            const float w[8] = {w0[0], w0[1], w0[2], w0[3], w1[0], w1[1], w1[2], w1[3]}; \
            acc = MFMA32(bfr[ks], scale8(xf[ks], w), acc); } \
        bf16_t* so = STo + (size_t)(c0 + (idx) * cstep) * 16 * 8192; \
        _Pragma("unroll") for (int q = 0; q < 4; ++q) *(u32x2*)(so + 8 * q) = (u32x2){pk2(P[4 * q], P[4 * q + 1]), pk2(P[4 * q + 2], P[4 * q + 3])}; \
        _Pragma("unroll") for (int r = 0; r < 16; ++r) P[r] = P[r] * dk + acc[r]; \
        asm volatile("s_waitcnt lgkmcnt(0)" ::: "memory"); \
        __syncthreads(); } while (0)
    P34_LOAD(sb0, sx0, cs0, dt0, ce0, 0); P34_LOAD(sb1, sx1, cs1, dt1, ce1, 1);
    __syncthreads();
    P34_PUT(sb0, sx0, 0);
    f32x2 csc = cs0, dtc = dt0; float cec = ce0;
    P34_LOAD(sb0, sx0, cs0, dt0, ce0, 2);
    asm volatile("s_waitcnt lgkmcnt(0)" ::: "memory");
    __syncthreads();
#pragma unroll 1
    for (int i = 0; i < NCHUNK; i += 2) {
        { const f32x2 csn = cs1, dtn = dt1; const float cen = ce1;
          P34_STEP(sb1, sx1, cs1, dt1, ce1, csc, dtc, cec, i);
          csc = csn; dtc = dtn; cec = cen; }
        { const f32x2 csn = cs0, dtn = dt0; const float cen = ce0;
          P34_STEP(sb0, sx0, cs0, dt0, ce0, csc, dtc, cec, i + 1);
          csc = csn; dtc = dtn; cec = cen; }
    }
#undef P34_STEP
#undef P34_PUT
#undef P34_LOAD
}
__device__ __forceinline__ void p4_scan(const Args& a) {
    unsigned char* ws = KWS();
    const int gtid = opaque_bx() * NT + opaque_tid(), gn = gridDim.x * NT;
    for (int it = gtid; it < 2 * BATCH * 16 * 1024; it += gn) {
        const int e8 = it & 1023, hh = (it >> 10) & 15, b = (it >> 14) & 7, dir = it >> 17;
        const float* CS = (const float*)(ws + (dir ? WS_RACSB : WS_ACSF)) + (size_t)(b * 16 + hh) * SEQ + (dir ? 0 : CHUNK - 1);
        bf16_t* base = (bf16_t*)(ws + WS_ST) + (((size_t)(dir * BATCH + b) * NCHUNK) * 16 + hh) * 8192 + e8 * 8;
        const long cstep = dir ? -(long)16 * 8192 : (long)16 * 8192; const int dstep = dir ? -CHUNK : CHUNK;
        bf16_t* p = base + (dir ? (size_t)(NCHUNK - 1) * 16 * 8192 : 0); const float* cp = CS + (dir ? (NCHUNK - 1) * CHUNK : 0);
        float prev[8];
#pragma unroll
        for (int j = 0; j < 8; ++j) prev[j] = 0.f;
#pragma unroll 1
        for (int c0 = 0; c0 < NCHUNK; c0 += 8) {
            u32x4 sv[8]; float dec[8];
#pragma unroll
            for (int k = 0; k < 8; ++k) { sv[k] = *(const u32x4*)(p + k * cstep); dec[k] = cp[k * dstep]; }
#pragma unroll
            for (int k = 0; k < 8; ++k) {
                *(u32x4*)(p + k * cstep) = (u32x4){pk2(prev[0], prev[1]), pk2(prev[2], prev[3]), pk2(prev[4], prev[5]), pk2(prev[6], prev[7])};
                const float dk = __expf(dec[k]);
#pragma unroll
                for (int q = 0; q < 4; ++q) { prev[2 * q] = prev[2 * q] * dk + bflo(sv[k][q]); prev[2 * q + 1] = prev[2 * q + 1] * dk + bfhi(sv[k][q]); }
            }
            p += 8 * cstep; cp += 8 * dstep;
        }
    }
}
constexpr int P5_G = 0, P5_B = 128 * 272, P5_C = 2 * 128 * 272, P5_ARR = 3 * 128 * 272, P5_RED = P5_ARR + 8 * 2048, P5_END = P5_RED + 64 * 8 * 4;
__device__ __forceinline__ bf16x8 opaque8(bf16x8 v) { u32x4 r = __builtin_bit_cast(u32x4, v); asm volatile("" : "+v"(r)); return __builtin_bit_cast(bf16x8, r); }
__device__ __forceinline__ void p5_out_unit(const Args& a, LAS unsigned char* lds, int unit) {
    unsigned char* ws = KWS();
    const int tid = opaque_tid(); const int lane = tid & 63, wave = tid >> 6, r32 = lane & 31, hi = lane >> 5;
    const int g = unit & 1, bc = unit >> 1, b = bc >> 5, c = bc & 31, hh = g * 8 + wave;
    const int t0 = b * SEQ + c * CHUNK;
    const bf16_t* XS = (const bf16_t*)KOUT(); const bf16_t* XST = XS + (size_t)TOK * 1024;
    const bf16_t* BC = (const bf16_t*)(ws + WS_BC);
    bf16_t* ZY = (bf16_t*)(ws + WS_Z);
    const size_t hbase = (size_t)(b * 16 + hh) * SEQ + c * CHUNK;
    LAS float* arr = (LAS float*)(lds + P5_ARR + wave * 2048);
    LAS float* red = (LAS float*)(lds + P5_RED);
    {
        u32x4 tb[4], tc[4];
#pragma unroll
        for (int i = 0; i < 4; ++i) { const int ci = tid + NT * i, r = ci >> 4, ch = ci & 15;
            tb[i] = *(const u32x4*)(BC + (size_t)(t0 + r) * 512 + g * 128 + ch * 8); tc[i] = *(const u32x4*)(BC + (size_t)(t0 + r) * 512 + 256 + g * 128 + ch * 8); }
        const float* src[4] = {(const float*)(ws + WS_ACSF) + hbase, (const float*)(ws + WS_RACSB) + hbase, (const float*)(ws + WS_DTF) + hbase, (const float*)(ws + WS_DTB) + hbase};
        f32x2 av[4];
#pragma unroll
        for (int k = 0; k < 4; ++k) av[k] = *(const f32x2*)(src[k] + 2 * lane);
#pragma unroll
        for (int i = 0; i < 4; ++i) { const int ci = tid + NT * i, r = ci >> 4, ch = ci & 15;
            *(LAS u32x4*)(lds + P5_B + r * 272 + ch * 16) = tb[i]; *(LAS u32x4*)(lds + P5_C + r * 272 + ch * 16) = tc[i]; }
#pragma unroll
        for (int k = 0; k < 4; ++k) { arr[k * 128 + 2 * lane] = av[k].x; arr[k * 128 + 2 * lane + 1] = av[k].y; }
    }
    __syncthreads();
    {
        const int lb = wave >> 1;
        LAS unsigned char* crow = lds + P5_C + (32 * lb + r32) * 272 + 16 * hi;
#pragma unroll
        for (int sbi = 0; sbi < 2; ++sbi) {
            const int sb = 2 * (wave & 1) + sbi;
            LAS unsigned char* brow = lds + P5_B + (32 * sb + r32) * 272 + 16 * hi;
            f32x16 acc = f32x16{};
#pragma unroll
            for (int ks = 0; ks < 8; ++ks) acc = MFMA32(*(const LAS bf16x8*)(brow + 32 * ks), *(const LAS bf16x8*)(crow + 32 * ks), acc);
#pragma unroll
            for (int q = 0; q < 4; ++q)
                *(LAS u32x2*)(lds + P5_G + (32 * lb + r32) * 272 + (32 * sb + 8 * q + 4 * hi) * 2) = (u32x2){pk2(acc[4 * q], acc[4 * q + 1]), pk2(acc[4 * q + 2], acc[4 * q + 3])};
        }
    }
    __syncthreads();
    const float dsk = KIN(10)[hh];
    const bf16_t* xrow0 = XST + ((size_t)b * 1024 + hh * 64 + r32) * SEQ + c * CHUNK + 8 * hi;
#pragma unroll 1
    for (int lh = 0; lh < 2; ++lh) {
        f32x16 acc[2][2];
#pragma unroll
        for (int i = 0; i < 2; ++i)
#pragma unroll
            for (int j = 0; j < 2; ++j) acc[i][j] = f32x16{};
#pragma unroll 1
        for (int kh = 0; kh < 2; ++kh) {
            bf16x8 xf[2][4];
            int kho = kh * 64; asm volatile("" : "+s"(kho));
            const bf16_t* xr = xrow0 + kho;
#pragma unroll
            for (int pb = 0; pb < 2; ++pb)
#pragma unroll
                for (int k4 = 0; k4 < 4; ++k4) xf[pb][k4] = ld8(xr + (size_t)(32 * pb) * SEQ + 16 * k4);
#pragma unroll
            for (int lb2 = 0; lb2 < 2; ++lb2) {
                const int l = 64 * lh + 32 * lb2 + r32;
                const float afl = arr[l], rbl = arr[128 + l];
#pragma unroll
                for (int k4 = 0; k4 < 4; ++k4) {
                    const int s8 = kho + 16 * k4 + 8 * hi;
                    const bf16x8 gv = *(const LAS bf16x8*)(lds + P5_G + l * 272 + s8 * 2);
                    float w[8]; bf16x8 mf;
                    const int sblk = kho + 16 * k4, lblk = 64 * lh + 32 * lb2;
                    if (sblk + 16 <= lblk) {
#pragma unroll
                        for (int j = 0; j < 8; ++j) w[j] = __expf(afl - arr[s8 + j]) * arr[256 + s8 + j];
                        mf = scale8(gv, w);
                    } else if (sblk >= lblk + 32) {
#pragma unroll
                        for (int j = 0; j < 8; ++j) w[j] = __expf(rbl - arr[128 + s8 + j]) * arr[384 + s8 + j];
                        mf = scale8(gv, w);
                    } else {
                        float ad[8];
#pragma unroll
                        for (int j = 0; j < 8; ++j) {
                            const int s = s8 + j;
                            const float afs = arr[s], rbs = arr[128 + s], dfs = arr[256 + s], dbs = arr[384 + s];
                            const bool fw = s < l;
                            const float e = __expf(fminf(fw ? (afl - afs) : (rbl - rbs), 0.f)) * (fw ? dfs : dbs);
                            w[j] = (s == l) ? (dfs + dbs) : e; ad[j] = (s == l) ? dsk : 0.f;
                        }
                        mf = scale8a(gv, w, ad);
                    }
#pragma unroll
                    for (int pb = 0; pb < 2; ++pb) acc[pb][lb2] = MFMA32(opaque8(xf[pb][k4]), mf, acc[pb][lb2]);
                    __builtin_amdgcn_sched_barrier(0);
                }
            }
        }
#pragma unroll 1
        for (int dir = 0; dir < 2; ++dir) {
            f32x16 tacc[2][2];
#pragma unroll
            for (int i = 0; i < 2; ++i)
#pragma unroll
                for (int j = 0; j < 2; ++j) tacc[i][j] = f32x16{};
            int diro = dir; asm volatile("" : "+s"(diro));
            const bf16_t* sp = (const bf16_t*)(ws + WS_ST) + ((((size_t)(diro * BATCH + b) * NCHUNK + c) * 16 + hh) * 64 + r32) * 128 + 8 * hi;
            bf16x8 pf[2][8];
#pragma unroll
            for (int pb = 0; pb < 2; ++pb)
#pragma unroll
                for (int ks = 0; ks < 8; ++ks) pf[pb][ks] = ld8(sp + (size_t)(32 * pb) * 128 + 16 * ks);
#pragma unroll
            for (int ks = 0; ks < 8; ++ks) {
#pragma unroll
                for (int lb2 = 0; lb2 < 2; ++lb2) {
                    const int l = 64 * lh + 32 * lb2 + r32;
                    const bf16x8 cv = *(const LAS bf16x8*)(lds + P5_C + l * 272 + (16 * ks + 8 * hi) * 2);
#pragma unroll
                    for (int pb = 0; pb < 2; ++pb) tacc[pb][lb2] = MFMA32(pf[pb][ks], cv, tacc[pb][lb2]);
                }
            }
#pragma unroll
            for (int lb2 = 0; lb2 < 2; ++lb2) {
                const int l = 64 * lh + 32 * lb2 + r32;
                const float e = __expf(arr[(dir ? 128 : 0) + l]);
#pragma unroll
                for (int pb = 0; pb < 2; ++pb)
#pragma unroll
                    for (int r = 0; r < 16; ++r) acc[pb][lb2][r] += e * tacc[pb][lb2][r];
            }
        }
        float ssq[2] = {0.f, 0.f};
#pragma unroll
        for (int lb2 = 0; lb2 < 2; ++lb2) {
            const int t = t0 + 64 * lh + 32 * lb2 + r32;
#pragma unroll
            for (int pb = 0; pb < 2; ++pb)
#pragma unroll
                for (int q = 0; q < 4; ++q) {
                    const int ch = hh * 64 + 32 * pb + 8 * q + 4 * hi;
                    const u32x2 zv = *(const u32x2*)(ZY + (size_t)t * 1024 + ch);
                    f32x16& v = acc[pb][lb2];
                    v[4 * q] *= bflo(zv.x); v[4 * q + 1] *= bfhi(zv.x); v[4 * q + 2] *= bflo(zv.y); v[4 * q + 3] *= bfhi(zv.y);
                    ssq[lb2] += (v[4 * q] * v[4 * q] + v[4 * q + 1] * v[4 * q + 1]) + (v[4 * q + 2] * v[4 * q + 2] + v[4 * q + 3] * v[4 * q + 3]);
                }
        }
#pragma unroll
        for (int lb2 = 0; lb2 < 2; ++lb2) { ssq[lb2] += __shfl_xor(ssq[lb2], 32); if (hi == 0) red[(32 * lb2 + r32) * 8 + wave] = ssq[lb2]; }
        __syncthreads();
#pragma unroll
        for (int lb2 = 0; lb2 < 2; ++lb2) {
            const f32x4 r0 = *(const LAS f32x4*)(red + (32 * lb2 + r32) * 8), r1 = *(const LAS f32x4*)(red + (32 * lb2 + r32) * 8 + 4);
            const float tot = ((r0.x + r0.y) + (r0.z + r0.w)) + ((r1.x + r1.y) + (r1.z + r1.w));
            const float rstd = 1.f / sqrtf(tot * (1.f / 512.f) + EPS);
            const int t = t0 + 64 * lh + 32 * lb2 + r32;
#pragma unroll
            for (int pb = 0; pb < 2; ++pb)
#pragma unroll
                for (int q = 0; q < 4; ++q) {
                    const int ch = hh * 64 + 32 * pb + 8 * q + 4 * hi; const f32x16& v = acc[pb][lb2];
                    *(u32x2*)(ZY + (size_t)t * 1024 + ch) = (u32x2){pk2(v[4 * q] * rstd, v[4 * q + 1] * rstd), pk2(v[4 * q + 2] * rstd, v[4 * q + 3] * rstd)};
                }
        }
        __syncthreads();
    }
}
#define PK8(v0, v1) (u32x4){pk2((v0)[0], (v0)[1]), pk2((v0)[2], (v0)[3]), pk2((v1)[0], (v1)[1]), pk2((v1)[2], (v1)[3])}
struct DQ { float rs; f32x4 cs, sn; };
struct EpiQ {
    bf16_t* __restrict__ Q; const float* __restrict__ RQ; const float* __restrict__ COS; const float* __restrict__ SIN;
    __device__ __forceinline__ void operator()(const f32x4 (&acc)[2][2][4][2], const pg8::Unit& u, int wr, int wc, int fr, int fq) const {
        pg8::foreach8_batched<4, DQ>(acc, u, wr, wc, fr, fq,
            [&](int row, int col) { DQ d; d.rs = RQ[row]; const int dd = col % 96; const int i0 = (dd >= 64) ? ((dd - 64) >> 1) : 0;
                d.cs = *(const f32x4*)(COS + (size_t)row * 16 + i0); d.sn = *(const f32x4*)(SIN + (size_t)row * 16 + i0); return d; },
            [&](int row, int col, f32x4 v0, f32x4 v1, const DQ& d) {
                v0 = v0 * d.rs; v1 = v1 * d.rs;
                if (col % 96 >= 64) { const f32x4 cs = d.cs, sn = d.sn; const f32x4 a0 = v0, a1 = v1;
                    v0[0] = a0[0] * cs[0] - a0[1] * sn[0]; v0[1] = a0[0] * sn[0] + a0[1] * cs[0]; v0[2] = a0[2] * cs[1] - a0[3] * sn[1]; v0[3] = a0[2] * sn[1] + a0[3] * cs[1];
                    v1[0] = a1[0] * cs[2] - a1[1] * sn[2]; v1[1] = a1[0] * sn[2] + a1[1] * cs[2]; v1[2] = a1[2] * cs[3] - a1[3] * sn[3]; v1[3] = a1[2] * sn[3] + a1[3] * cs[3]; }
                *(u32x4*)(Q + (size_t)row * QW + col) = PK8(v0, v1); });
    }
};
struct DR { float rs; };
struct EpiK {
    bf16_t* __restrict__ K; const float* __restrict__ RKV;
    __device__ __forceinline__ void operator()(const f32x4 (&acc)[2][2][4][2], const pg8::Unit& u, int wr, int wc, int fr, int fq) const {
        pg8::foreach8_batched<4, DR>(acc, u, wr, wc, fr, fq,
            [&](int row, int col) { DR d; d.rs = RKV[row]; return d; },
            [&](int row, int col, f32x4 v0, f32x4 v1, const DR& d) { v0 = v0 * d.rs; v1 = v1 * d.rs;
                *(u32x4*)(K + (size_t)row * KW + col) = PK8(v0, v1); });
    }
};
struct EpiVT {
    bf16_t* VT; const float* RKV;
    __device__ __forceinline__ void operator()(const f32x4 (&acc)[2][2][4][2], const pg8::Unit& u, int wr, int wc, int fr, int fq) const {
        pg8::foreach8(acc, u, wr, wc, fr, fq, [&](int row, int col, f32x4 v0, f32x4 v1) {
            const f32x4 r0 = *(const f32x4*)(RKV + col), r1 = *(const f32x4*)(RKV + col + 4); v0 = v0 * r0; v1 = v1 * r1;
            const int m16 = col & ~15, g = (col >> 3) & 1;
            *(u32x2*)(VT + (size_t)row * TOK + m16 + 4 * g) = (u32x2){pk2(v0[0], v0[1]), pk2(v0[2], v0[3])};
            *(u32x2*)(VT + (size_t)row * TOK + m16 + 8 + 4 * g) = (u32x2){pk2(v1[0], v1[1]), pk2(v1[2], v1[3])};
        });
    }
};
constexpr int AT_KS = 208, AT_VS = 144;
constexpr int AT_KB = 64 * AT_KS, AT_VB = 64 * AT_VS;
constexpr int AT_K0 = 0, AT_V0 = 2 * AT_KB, AT_WS = AT_V0 + 2 * AT_VB, AT_END = AT_WS + 8 * 256;
constexpr float AT_THR = 8.f;
__device__ __forceinline__ unsigned cvtpk(float lo, float hi) { f32x2 v = {lo, hi}; bf16x2_t b = __builtin_convertvector(v, bf16x2_t); return __builtin_bit_cast(unsigned, b); }
#define MX3(a, b, c) __builtin_fmaxf(__builtin_fmaxf((a), (b)), (c))
__device__ __forceinline__ void p7_attn_unit(const Args& a, LAS unsigned char* lds, int b, int h, int qb) {
    unsigned char* ws = KWS();
    const int tid = opaque_tid(), lane = tid & 63, wave = tid >> 6, r32 = lane & 31, hi = lane >> 5;
    const bf16_t* Q = (const bf16_t*)KOUT(); const bf16_t* K = (const bf16_t*)(ws + WS_K); const bf16_t* VT = (const bf16_t*)(ws + WS_VT);
    bf16_t* YM = (bf16_t*)(ws + WS_YM);
    const int q0 = qb * 256 + wave * 32;
    bf16x8 qf[6];
    { const bf16_t* qp = Q + (size_t)(b * SEQ + q0 + r32) * QW + h * 96 + 8 * hi;
#pragma unroll
      for (int st = 0; st < 6; ++st) qf[st] = ld8(qp + 16 * st); }
    const int kr0 = tid / 12, kc0 = tid % 12, kr1 = (512 + tid) / 12, kc1 = (512 + tid) % 12;
    const int vd = tid >> 3, vc = tid & 7;
    const bf16_t* KRp = (const bf16_t*)(ws + WS_KR);
    const unsigned ks0 = kc0 < 8 ? KW : 32, ks1 = kc1 < 8 ? KW : 32;
    const bf16_t* kg0 = kc0 < 8 ? K + (size_t)(b * SEQ + kr0) * KW + h * 64 + kc0 * 8 : KRp + (size_t)(b * SEQ + kr0) * 32 + (kc0 - 8) * 8;
    const bf16_t* kg1 = kc1 < 8 ? K + (size_t)(b * SEQ + kr1) * KW + h * 64 + kc1 * 8 : KRp + (size_t)(b * SEQ + kr1) * 32 + (kc1 - 8) * 8;
    const bf16_t* vg = VT + (size_t)(h * 64 + vd) * TOK + b * SEQ + vc * 8;
    const int kl0 = kr0 * AT_KS + kc0 * 16, kl1 = kr1 * AT_KS + kc1 * 16, vl = vd * AT_VS + vc * 16;
    LAS float* wsf = (LAS float*)(lds + AT_WS + wave * 256);
    u32x4 skA0, skA1 = (u32x4){0u, 0u, 0u, 0u}, svA, skB0, skB1 = (u32x4){0u, 0u, 0u, 0u}, svB;
    skA0 = *(const u32x4*)kg0; if (tid < 256) skA1 = *(const u32x4*)kg1; svA = *(const u32x4*)vg;
    { skB0 = *(const u32x4*)(kg0 + 64u * ks0); if (tid < 256) skB1 = *(const u32x4*)(kg1 + 64u * ks1); svB = *(const u32x4*)(vg + 64); }
    __syncthreads();
    *(LAS u32x4*)(lds + AT_K0 + kl0) = skA0; if (tid < 256) *(LAS u32x4*)(lds + AT_K0 + kl1) = skA1; *(LAS u32x4*)(lds + AT_V0 + vl) = svA;
    __syncthreads();
    f32x16 o0 = f32x16{}, o1 = f32x16{};
    float mref = 0.f, lrun = 0.f;
    f32x16 negm;
#pragma unroll
    for (int r = 0; r < 16; ++r) negm[r] = 0.f;
    constexpr int NTILE = SEQ / 64;
    const int koff = r32 * AT_KS + hi * 16, voff = r32 * AT_VS + hi * 16;
#define AT_BODY(t, RK0, RK1, RV, WK0, WK1, WV) do { \
        const int buf = (t) & 1; \
        if ((t) + 2 < NTILE) { const unsigned kt_ = (unsigned)((t) + 2) * 64u; RK0 = *(const u32x4*)(kg0 + kt_ * ks0); if (tid < 256) RK1 = *(const u32x4*)(kg1 + kt_ * ks1); RV = *(const u32x4*)(vg + ((t) + 2) * 64); } \
        LAS unsigned char* kb = lds + AT_K0 + buf * AT_KB + koff; LAS unsigned char* vb = lds + AT_V0 + buf * AT_VB + voff; \
        f32x16 p0 = negm, p1 = negm; \
        { bf16x8 kf0[6], kf1[6]; \
          _Pragma("unroll") for (int st = 0; st < 6; ++st) { kf0[st] = *(const LAS bf16x8*)(kb + st * 32); kf1[st] = *(const LAS bf16x8*)(kb + 32 * AT_KS + st * 32); } \
          __builtin_amdgcn_sched_barrier(0); \
          __builtin_amdgcn_s_setprio(1); \
          _Pragma("unroll") for (int st = 0; st < 6; ++st) { p0 = MFMA32(kf0[st], qf[st], p0); p1 = MFMA32(kf1[st], qf[st], p1); } \
          __builtin_amdgcn_s_setprio(0); \
          __builtin_amdgcn_sched_barrier(0); } \
        bf16x8 va[2][2], vb2[2][2]; \
        _Pragma("unroll") for (int kbk = 0; kbk < 2; ++kbk) \
            _Pragma("unroll") for (int s = 0; s < 2; ++s) { const int off = (32 * kbk + 16 * s) * 2; \
                va[kbk][s] = *(const LAS bf16x8*)(vb + off); vb2[kbk][s] = *(const LAS bf16x8*)(vb + 32 * AT_VS + off); } \
        __builtin_amdgcn_sched_barrier(0); \
        float ma = MX3(p0[0], p0[1], p1[0]), mb = MX3(p0[2], p0[3], p1[1]); ma = MX3(ma, p1[2], p1[3]); \
        _Pragma("unroll") for (int r = 4; r < 16; r += 4) { ma = MX3(ma, p0[r], p0[r + 1]); mb = MX3(mb, p0[r + 2], p0[r + 3]); ma = MX3(ma, p1[r], p1[r + 1]); mb = MX3(mb, p1[r + 2], p1[r + 3]); } \
        float mx = fmaxf(ma, mb); \
        { SWAP_PAIR(__builtin_amdgcn_permlane32_swap, mx, x0, x1); mx = fmaxf(__builtin_bit_cast(float, x0), __builtin_bit_cast(float, x1)); } \
        if ((t) == 0 || __any(mx > AT_THR)) { \
            const float dl = ((t) == 0) ? mx : fmaxf(mx, 0.f); mref += dl; \
            const float f = ((t) == 0) ? 1.f : __builtin_amdgcn_exp2f(-dl); lrun *= f; \
            _Pragma("unroll") for (int r = 0; r < 16; ++r) { p0[r] -= dl; p1[r] -= dl; negm[r] = -mref; } \
            if (hi == 0) wsf[r32] = f; \
            asm volatile("s_waitcnt lgkmcnt(0)" ::: "memory"); \
            _Pragma("unroll") for (int q = 0; q < 4; ++q) { const f32x4 al = *(const volatile LAS f32x4*)(wsf + 8 * q + 4 * hi); \
                _Pragma("unroll") for (int i = 0; i < 4; ++i) { o0[4 * q + i] *= al[i]; o1[4 * q + i] *= al[i]; } } \
        } \
        float ls = 0.f; \
        _Pragma("unroll") for (int r = 0; r < 16; ++r) { p0[r] = __builtin_amdgcn_exp2f(p0[r]); p1[r] = __builtin_amdgcn_exp2f(p1[r]); ls += p0[r] + p1[r]; } \
        lrun += ls; \
        bf16x8 pf[2][2]; \
        pf[0][0] = __builtin_bit_cast(bf16x8, (u32x4){cvtpk(p0[0], p0[1]), cvtpk(p0[2], p0[3]), cvtpk(p0[4], p0[5]), cvtpk(p0[6], p0[7])}); \
        pf[0][1] = __builtin_bit_cast(bf16x8, (u32x4){cvtpk(p0[8], p0[9]), cvtpk(p0[10], p0[11]), cvtpk(p0[12], p0[13]), cvtpk(p0[14], p0[15])}); \
        pf[1][0] = __builtin_bit_cast(bf16x8, (u32x4){cvtpk(p1[0], p1[1]), cvtpk(p1[2], p1[3]), cvtpk(p1[4], p1[5]), cvtpk(p1[6], p1[7])}); \
        pf[1][1] = __builtin_bit_cast(bf16x8, (u32x4){cvtpk(p1[8], p1[9]), cvtpk(p1[10], p1[11]), cvtpk(p1[12], p1[13]), cvtpk(p1[14], p1[15])}); \
        __builtin_amdgcn_sched_barrier(0); \
        __builtin_amdgcn_s_setprio(1); \
        _Pragma("unroll") for (int kbk = 0; kbk < 2; ++kbk) \
            _Pragma("unroll") for (int s = 0; s < 2; ++s) { \
                o0 = MFMA32(pf[kbk][s], va[kbk][s], o0); \
                o1 = MFMA32(pf[kbk][s], vb2[kbk][s], o1); } \
        __builtin_amdgcn_s_setprio(0); \
        __builtin_amdgcn_sched_barrier(0); \
        if ((t) + 1 < NTILE) { LAS unsigned char* kn = lds + AT_K0 + (buf ^ 1) * AT_KB; LAS unsigned char* vn = lds + AT_V0 + (buf ^ 1) * AT_VB; \
            *(LAS u32x4*)(kn + kl0) = WK0; if (tid < 256) *(LAS u32x4*)(kn + kl1) = WK1; *(LAS u32x4*)(vn + vl) = WV; } \
        __syncthreads(); } while (0)
#pragma unroll 1
    for (int t = 0; t < NTILE; t += 2) {
        AT_BODY(t, skA0, skA1, svA, skB0, skB1, svB);
        AT_BODY(t + 1, skB0, skB1, svB, skA0, skA1, svA);
    }
#undef AT_BODY
    { SWAP_PAIR(__builtin_amdgcn_permlane32_swap, lrun, x0, x1); lrun = __builtin_bit_cast(float, x0) + __builtin_bit_cast(float, x1); }
    if (hi == 0) wsf[32 + r32] = 1.f / lrun;
    asm volatile("s_waitcnt lgkmcnt(0)" ::: "memory");
#pragma unroll
    for (int q = 0; q < 4; ++q) { const f32x4 il = *(const volatile LAS f32x4*)(wsf + 32 + 8 * q + 4 * hi);
#pragma unroll
        for (int i = 0; i < 4; ++i) { const int row = q0 + 8 * q + 4 * hi + i; bf16_t* yp = YM + (size_t)(b * SEQ + row) * 1024 + h * 64 + r32;
            yp[0] = (bf16_t)f2bf(o0[4 * q + i] * il[i]); yp[32] = (bf16_t)f2bf(o1[4 * q + i] * il[i]); } }
}
__device__ __forceinline__ void p7_attention(const Args& a, LAS unsigned char* lds) {
    const int G = gridDim.x, bx = opaque_bx();
    const int vcu = (G % 8 == 0) ? (bx % 8) * (G / 8) + bx / 8 : bx;
    for (int u = vcu; u < BATCH * 16 * 16; u += G) {
        const int qb = u & 15, bh = u >> 4;
        p7_attn_unit(a, lds, bh >> 4, bh & 15, qb);
    }
}

struct DG { u32x2 g; };
struct DGM { u32x2 g; u32x4 m; };
#define GATE8(gv, g) float g[8]; { const float c_ = 1.f / 255.f; g[0] = (float)((gv.x >> 0) & 0xffu) * c_; g[1] = (float)((gv.x >> 8) & 0xffu) * c_; g[2] = (float)((gv.x >> 16) & 0xffu) * c_; g[3] = (float)((gv.x >> 24) & 0xffu) * c_; \
    g[4] = (float)((gv.y >> 0) & 0xffu) * c_; g[5] = (float)((gv.y >> 8) & 0xffu) * c_; g[6] = (float)((gv.y >> 16) & 0xffu) * c_; g[7] = (float)((gv.y >> 24) & 0xffu) * c_; }
struct EpiMerge1 {
    bf16_t* __restrict__ M; const unsigned char* __restrict__ G;
    __device__ __forceinline__ void operator()(const f32x4 (&acc)[2][2][4][2], const pg8::Unit& u, int wr, int wc, int fr, int fq) const {
        pg8::foreach8_batched<4, DG>(acc, u, wr, wc, fr, fq,
            [&](int row, int col) { DG d; d.g = *(const u32x2*)(G + (size_t)row * 2048 + col); return d; },
            [&](int row, int col, f32x4 v0, f32x4 v1, const DG& d) { const u32x2 gv = d.g; GATE8(gv, g);
#pragma unroll
                for (int j = 0; j < 4; ++j) { v0[j] *= g[j]; v1[j] *= g[4 + j]; }
                *(u32x4*)(M + (size_t)row * 1024 + col) = PK8(v0, v1); });
    }
};
struct EpiMerge2 {
    bf16_t* M; const unsigned char* G;
    __device__ __forceinline__ void operator()(const f32x4 (&acc)[2][2][4][2], const pg8::Unit& u, int wr, int wc, int fr, int fq) const {
        pg8::foreach8_batched<4, DGM>(acc, u, wr, wc, fr, fq,
            [&](int row, int col) { DGM d; d.g = *(const u32x2*)(G + (size_t)row * 2048 + 1024 + col); d.m = *(const u32x4*)(M + (size_t)row * 1024 + col); return d; },
            [&](int row, int col, f32x4 v0, f32x4 v1, const DGM& d) { const u32x2 gv = d.g; const u32x4 mv = d.m; GATE8(gv, g);
                v0[0] = bflo(mv.x) + v0[0] * g[0]; v0[1] = bfhi(mv.x) + v0[1] * g[1]; v0[2] = bflo(mv.y) + v0[2] * g[2]; v0[3] = bfhi(mv.y) + v0[3] * g[3];
                v1[0] = bflo(mv.z) + v1[0] * g[4]; v1[1] = bfhi(mv.z) + v1[1] * g[5]; v1[2] = bflo(mv.w) + v1[2] * g[6]; v1[3] = bfhi(mv.w) + v1[3] * g[7];
                *(u32x4*)(M + (size_t)row * 1024 + col) = PK8(v0, v1); });
    }
};
struct DX { f32x4 x0, x1; };
struct EpiOut {
    const float* __restrict__ X; bf16_t* __restrict__ HB; float* __restrict__ SSQ;
    __device__ __forceinline__ void operator()(const f32x4 (&acc)[2][2][4][2], const pg8::Unit& u, int wr, int wc, int fr, int fq) const {
#pragma unroll
        for (int ai = 0; ai < 2; ++ai)
#pragma unroll
            for (int m0 = 0; m0 < 4; m0 += 2) {
                DX d[2][2];
#pragma unroll
                for (int mm = 0; mm < 2; ++mm) { const int row = u.pm * 256 + ai * 128 + wr * 64 + (m0 + mm) * 16 + fr;
#pragma unroll
                    for (int bj = 0; bj < 2; ++bj) { const int col = u.pn * 256 + bj * 128 + wc * 32 + 8 * fq;
                        d[mm][bj].x0 = *(const f32x4*)(X + (size_t)row * 1024 + col); d[mm][bj].x1 = *(const f32x4*)(X + (size_t)row * 1024 + col + 4); } }
#pragma unroll
                for (int mm = 0; mm < 2; ++mm) { const int m = m0 + mm; const int row = u.pm * 256 + ai * 128 + wr * 64 + m * 16 + fr; float s = 0.f;
#pragma unroll
                    for (int bj = 0; bj < 2; ++bj) { const int col = u.pn * 256 + bj * 128 + wc * 32 + 8 * fq;
                        const f32x4 v0 = acc[ai][bj][m][0] + d[mm][bj].x0, v1 = acc[ai][bj][m][1] + d[mm][bj].x1;
                        *(u32x4*)(HB + (size_t)row * 1024 + col) = PK8(v0, v1);
                        s += (v0[0] * v0[0] + v0[1] * v0[1]) + (v0[2] * v0[2] + v0[3] * v0[3]) + (v1[0] * v1[0] + v1[1] * v1[1]) + (v1[2] * v1[2] + v1[3] * v1[3]); }
                    s += __shfl_xor(s, 16); s += __shfl_xor(s, 32);
                    if (fq == 0) SSQ[(size_t)row * 16 + u.pn * 4 + wc] = s; }
                asm volatile("" ::: "memory");
            }
    }
};
struct EpiScore {
    float* __restrict__ SC; const float* __restrict__ SSQ;
    __device__ __forceinline__ void operator()(const f32x4 (&acc)[2][2][4][2], const pg8::Unit& u, int wr, int wc, int fr, int fq) const {
        float rs[2][4];
#pragma unroll
        for (int ai = 0; ai < 2; ++ai)
#pragma unroll
            for (int m = 0; m < 4; ++m) {
                const int row = u.pm * 256 + ai * 128 + wr * 64 + m * 16 + fr;
                const f32x4* sp = (const f32x4*)(SSQ + (size_t)row * 16);
                const f32x4 s0 = sp[0], s1 = sp[1], s2 = sp[2], s3 = sp[3];
                const float tot = (((s0[0] + s0[1]) + (s0[2] + s0[3])) + ((s1[0] + s1[1]) + (s1[2] + s1[3]))) + (((s2[0] + s2[1]) + (s2[2] + s2[3])) + ((s3[0] + s3[1]) + (s3[2] + s3[3])));
                rs[ai][m] = 1.f / sqrtf(tot * (1.f / 1024.f) + EPS);
            }
#pragma unroll
        for (int ai = 0; ai < 2; ++ai)
#pragma unroll
            for (int m = 0; m < 4; ++m) {
                const int row = u.pm * 256 + ai * 128 + wr * 64 + m * 16 + fr;
#pragma unroll
                for (int bj = 0; bj < 2; ++bj) {
                    const int col = u.pn * 256 + bj * 128 + wc * 32 + 8 * fq;
                    const f32x4 a0 = acc[ai][bj][m][0] * rs[ai][m], a1 = acc[ai][bj][m][1] * rs[ai][m];
                    unsigned w[4];
#pragma unroll
                    for (int i = 0; i < 2; ++i) {
                        w[i] = (unsigned)__builtin_bit_cast(unsigned short, (_Float16)a0[2 * i]) | ((unsigned)__builtin_bit_cast(unsigned short, (_Float16)a0[2 * i + 1]) << 16);
                        w[2 + i] = (unsigned)__builtin_bit_cast(unsigned short, (_Float16)a1[2 * i]) | ((unsigned)__builtin_bit_cast(unsigned short, (_Float16)a1[2 * i + 1]) << 16); }
                    *(u32x4*)((unsigned short*)SC + (size_t)row * 2048 + col) = (u32x4){w[0], w[1], w[2], w[3]};
                }
            }
    }
};
__device__ __forceinline__ unsigned pack_fp8x4(float a, float b, float c, float d) {
    int p = __builtin_amdgcn_cvt_pk_fp8_f32(a, b, 0, false); p = __builtin_amdgcn_cvt_pk_fp8_f32(c, d, p, true); return (unsigned)p;
}
__device__ __forceinline__ unsigned pack_i8x4(float a, float b, float c, float d) {
    const int qa = (int)__builtin_rintf(a), qb = (int)__builtin_rintf(b), qc = (int)__builtin_rintf(c), qd = (int)__builtin_rintf(d);
    return ((unsigned)qa & 0xffu) | (((unsigned)qb & 0xffu) << 8) | (((unsigned)qc & 0xffu) << 16) | ((unsigned)qd << 24);
}
__device__ __forceinline__ void p9_peer_tables(const Args& a, int rbeg, int rend, int blk, int nblk) {
    unsigned char* ws = KWS();
    const int tid_ = opaque_tid(); const int wave = tid_ >> 6, lane = tid_ & 63;
    const int gw = blk * NW + wave, ngw = nblk * NW;
    const f32x4* NWv = (const f32x4*)KIN(19) + 4 * lane;
    const f32x4 n0 = NWv[0], n1 = NWv[1], n2 = NWv[2], n3 = NWv[3];
    constexpr int RB = 4;
    for (int r0 = rbeg + gw * RB; r0 < rend; r0 += ngw * RB) {
        f32x4 v[RB][4];
#pragma unroll
        for (int k = 0; k < RB; ++k) { const int r = r0 + k; const bool isv = r >= 16384; const int row = isv ? r - 16384 : r;
            const f32x4* src = (const f32x4*)(isv ? KIN(23) : KIN(22)) + (size_t)row * 256 + 4 * lane;
#pragma unroll
            for (int q = 0; q < 4; ++q) v[k][q] = __builtin_nontemporal_load(src + q); }
#pragma unroll
        for (int k = 0; k < RB; ++k) { const int r = r0 + k; const bool isv = r >= 16384; const int row = isv ? r - 16384 : r;
            f32x4 v0 = v[k][0], v1 = v[k][1], v2 = v[k][2], v3 = v[k][3];
            if (!isv) { v0 = v0 * n0; v1 = v1 * n1; v2 = v2 * n2; v3 = v3 * n3; }
            float m = 0.f;
#pragma unroll
            for (int j = 0; j < 4; ++j) m = fmaxf(m, fmaxf(fmaxf(fabsf(v0[j]), fabsf(v1[j])), fmaxf(fabsf(v2[j]), fabsf(v3[j]))));
            m = fmaxf(wave_max(m), 1e-30f);
            const float sc = 127.f / m;
            v0 = v0 * sc; v1 = v1 * sc; v2 = v2 * sc; v3 = v3 * sc;
            const u32x4 o = (u32x4){pack_i8x4(v0[0], v0[1], v0[2], v0[3]), pack_i8x4(v1[0], v1[1], v1[2], v1[3]), pack_i8x4(v2[0], v2[1], v2[2], v2[3]), pack_i8x4(v3[0], v3[1], v3[2], v3[3])};
            *(u32x4*)(ws + (isv ? WS_PV : WS_PU) + (size_t)row * 1024 + 16 * lane) = o;
            if (lane == 0) ((float*)(ws + (isv ? WS_PVS : WS_PUS)))[row] = m * (1.f / 127.f);
        }
    }
}
typedef unsigned int gu32_t;
#define XB_TMO      128
#define XB_XCNT(j)  (256  + 64 * (j))
#define XB_XSUB(j)  (1280 + 64 * (j))
#define XB_XGEN(j)  (2304 + 64 * (j))
#define XB_TOP      3328
#define XB_TOPGEN   3392
#define XCD_BAR_WORDS 3456
#define XB_SPIN_CAP (1u << 18)

__device__ __forceinline__ unsigned xb_ld(unsigned* p)              { return __hip_atomic_load(p, __ATOMIC_RELAXED, __HIP_MEMORY_SCOPE_AGENT); }
__device__ __forceinline__ unsigned xb_add(unsigned* p, unsigned v) { return __hip_atomic_fetch_add(p, v, __ATOMIC_RELAXED, __HIP_MEMORY_SCOPE_AGENT); }
__device__ __forceinline__ unsigned xb_xcc_id() { return (unsigned)__builtin_amdgcn_s_getreg((3 << 11) | 20) & 0xFu; }
#define XB_SPIN(cond, bar) do { unsigned _sp = 0; while (cond) { __builtin_amdgcn_s_sleep(1); \
    if ((++_sp & 255u) == 0u) { if (xb_ld(&(bar)[XB_TMO])) break; if (_sp > XB_SPIN_CAP) { atomicAdd(&(bar)[XB_TMO], 1u); break; } } } } while (0)

struct XcdBarrier {
    unsigned* bar; unsigned x;
    volatile LAS unsigned* st;
};

__device__ __forceinline__ XcdBarrier xcd_barrier_post(unsigned* bar, volatile LAS unsigned* st) {
    XcdBarrier b; b.bar = bar; b.x = xb_xcc_id(); b.st = st;
    if (threadIdx.x == 0) (void)xb_add(&bar[XB_XCNT(b.x)], 1u);
    return b;
}
__device__ __forceinline__ void xcd_barrier_complete(unsigned* bar, unsigned x, unsigned& nloc, unsigned& nx) {
    const unsigned G = gridDim.x * gridDim.y * gridDim.z;
    unsigned sum, cnt, mine, sp = 0u;
    for (;;) {
        sum = 0u; cnt = 0u; mine = 0u;
#pragma unroll
        for (unsigned j = 0; j < 16; ++j) { const unsigned c = xb_ld(&bar[XB_XCNT(j)]); sum += c; cnt += (c > 0u) ? 1u : 0u; mine = (j == x) ? c : mine; }
        if (sum == G) break;
        __builtin_amdgcn_s_sleep(1);
        if ((++sp & 255u) == 0u) { if (xb_ld(&bar[XB_TMO])) break; if (sp > XB_SPIN_CAP) { atomicAdd(&bar[XB_TMO], 1u); break; } }
    }
    nloc = mine > 0u ? mine : 1u; nx = cnt > 0u ? cnt : 1u;
}

__device__ __forceinline__ void xcd_barrier(const XcdBarrier& b) {
    asm volatile("s_waitcnt vmcnt(0)" ::: "memory");
    __syncthreads();
    if (threadIdx.x == 0) {
        unsigned* bar = b.bar;
        __builtin_amdgcn_s_waitcnt(0);
        unsigned nloc = b.st[0], nx = b.st[1];
        if (nloc == 0u) { xcd_barrier_complete(bar, b.x, nloc, nx); b.st[0] = nloc; b.st[1] = nx; }
        const unsigned old = xb_add(&bar[XB_XSUB(b.x)], 1u);
        const unsigned gen = old / nloc;
        if (old + 1u == (gen + 1u) * nloc) {
            __builtin_amdgcn_fence(__ATOMIC_RELEASE, "agent");
            asm volatile("s_waitcnt vmcnt(0)" ::: "memory");
            const unsigned og = xb_add(&bar[XB_TOP], 1u);
            const unsigned tg = og / nx;
            if (og + 1u == (tg + 1u) * nx) xb_add(&bar[XB_TOPGEN], 1u);
            else XB_SPIN(xb_ld(&bar[XB_TOPGEN]) == tg, bar);
            __builtin_amdgcn_fence(__ATOMIC_ACQUIRE, "agent");
            xb_add(&bar[XB_XGEN(b.x)], 1u);
            asm volatile("s_waitcnt vmcnt(0)" ::: "memory");
        } else {
            XB_SPIN(xb_ld(&bar[XB_XGEN(b.x)]) == gen, bar);
            __builtin_amdgcn_fence(__ATOMIC_ACQUIRE, "agent");
            asm volatile("s_waitcnt vmcnt(0)" ::: "memory");
        }
    }
    __syncthreads();
}

__device__ __forceinline__ float xor4f(float x) {
    int t = __builtin_amdgcn_update_dpp(0, __builtin_bit_cast(int, x), 0x104, 0xF, 0x5, false);
    t = __builtin_amdgcn_update_dpp(t, __builtin_bit_cast(int, x), 0x114, 0xF, 0xA, false);
    return __builtin_bit_cast(float, t);
}
__device__ __forceinline__ unsigned okey(unsigned b) { return b ^ ((unsigned)((int)b >> 31) | 0x80000000u); }
__device__ __forceinline__ unsigned okey_inv(unsigned u) { return (u & 0x80000000u) ? (u ^ 0x80000000u) : ~u; }
__device__ __forceinline__ unsigned umax_(unsigned a, unsigned b) { return a > b ? a : b; }
__device__ __forceinline__ unsigned umin_(unsigned a, unsigned b) { return a < b ? a : b; }
template <int CTRL> __device__ __forceinline__ unsigned dppu(unsigned x) { return (unsigned)__builtin_amdgcn_update_dpp(0, (int)x, CTRL, 0xF, 0xF, true); }
__device__ __forceinline__ unsigned xor4u(unsigned x) {
    int t = __builtin_amdgcn_update_dpp(0, (int)x, 0x104, 0xF, 0x5, false); t = __builtin_amdgcn_update_dpp(t, (int)x, 0x114, 0xF, 0xA, false); return (unsigned)t;
}
template <int N> __device__ __forceinline__ void bitonic_merge_desc(unsigned (&a)[N]) {
#pragma unroll
    for (int j = N >> 1; j > 0; j >>= 1)
#pragma unroll
        for (int i = 0; i < N; ++i) { const int l = i ^ j; if (l > i) { const unsigned hi = umax_(a[i], a[l]), lo = umin_(a[i], a[l]); a[i] = hi; a[l] = lo; } }
}
template <int N> __device__ __forceinline__ void bitonic_sort_desc(unsigned (&a)[N]) {
#pragma unroll
    for (int k = 2; k <= N; k <<= 1)
#pragma unroll
        for (int j = k >> 1; j > 0; j >>= 1)
#pragma unroll
            for (int i = 0; i < N; ++i) { const int l = i ^ j; if (l > i) { const bool asc = (k < N) && ((i & k) != 0);
                const unsigned hi = umax_(a[i], a[l]), lo = umin_(a[i], a[l]); a[i] = asc ? lo : hi; a[l] = asc ? hi : lo; } }
}
__device__ __forceinline__ float row_max16(float x) { x = fmaxf(x, dppf<0xB1>(x)); x = fmaxf(x, dppf<0x4E>(x)); x = fmaxf(x, dppf<0x141>(x)); x = fmaxf(x, dppf<0x140>(x)); return x; }
constexpr int P11_LISTS = 0, P11_TOPK = 1024, P11_TAB = 1536, P11_RES = 2048, P11_WAVE_LDS = 2048 + 8 * 1536;
__device__ __forceinline__ void p11_load_scores(u32x4 (&sc)[8], int t, int lane) {
    const u32x4* SC = (const u32x4*)((const unsigned short*)(KWS() + WS_SC) + (size_t)t * 2048 + 32 * lane);
    u32x4 raw[4];
#pragma unroll
    for (int i = 0; i < 4; ++i) raw[i] = SC[i];
#pragma unroll
    for (int i = 0; i < 4; ++i)
#pragma unroll
        for (int c = 0; c < 4; ++c) { const unsigned w = raw[i][c];
            const float fx = (float)__builtin_bit_cast(_Float16, (unsigned short)(w & 0xFFFFu)), fy = (float)__builtin_bit_cast(_Float16, (unsigned short)(w >> 16));
            sc[2 * i + (c >> 1)][2 * (c & 1)] = __builtin_bit_cast(unsigned, fx); sc[2 * i + (c >> 1)][2 * (c & 1) + 1] = __builtin_bit_cast(unsigned, fy); }
}
__device__ __forceinline__ void p11_setup(LAS unsigned char* wl, int lane, unsigned (&lut)[7]) {
    int c = lane, ti = 0, tj = 0, valid = 0;
#pragma unroll 1
    for (int i = 0; i < 16; ++i) { const int n = 16 / (i + 1); if (c < n) { ti = i; tj = c; valid = 1; break; } c -= n; }
    ((LAS unsigned*)(wl + P11_TAB))[lane] = (unsigned)(ti | (tj << 4) | (valid << 8));
    asm volatile("s_waitcnt lgkmcnt(0)" ::: "memory");
#pragma unroll
    for (int m = 0; m < 7; ++m) lut[m] = ((volatile LAS unsigned*)(wl + P11_TAB))[(lane & 7) + 8 * m];
}
#ifndef P11_NTG
#define P11_NTG 4
#endif
__device__ __forceinline__ void p11_topk(const u32x4 (&sc)[8], const unsigned (&lut)[7], LAS unsigned char* wl, int lane, unsigned (&e_slot)[2], float (&g_slot)[2]) {
    {
        unsigned h0[16], h1[16];
        const unsigned pbase = (unsigned)((lane & 3) * 32);
#pragma unroll
        for (int i = 0; i < 4; ++i)
#pragma unroll
            for (int c = 0; c < 4; ++c) { h0[4 * i + c] = okey((sc[i][c] & ~0x7Fu) | (pbase + 4 * i + c)); h1[4 * i + c] = okey((sc[4 + i][c] & ~0x7Fu) | (pbase + 16 + 4 * i + c)); }
        bitonic_sort_desc<16>(h0); bitonic_sort_desc<16>(h1);
        unsigned s16[16];
#pragma unroll
        for (int i = 0; i < 16; ++i) s16[i] = umax_(h0[i], h1[15 - i]);
        bitonic_merge_desc<16>(s16);
        { unsigned d[16];
#pragma unroll
          for (int i = 0; i < 16; ++i) d[i] = umax_(s16[i], dppu<0xB1>(s16[15 - i]));
          bitonic_merge_desc<16>(d);
#pragma unroll
          for (int i = 0; i < 16; ++i) s16[i] = umax_(d[i], dppu<0x4E>(d[15 - i]));
          bitonic_merge_desc<16>(s16); }
        if ((lane & 3) == 0) { LAS u32x4* lp = (LAS u32x4*)(wl + P11_LISTS + (lane >> 2) * 64);
            lp[0] = (u32x4){s16[0], s16[1], s16[2], s16[3]}; lp[1] = (u32x4){s16[4], s16[5], s16[6], s16[7]}; lp[2] = (u32x4){s16[8], s16[9], s16[10], s16[11]}; lp[3] = (u32x4){s16[12], s16[13], s16[14], s16[15]}; }
        asm volatile("s_waitcnt lgkmcnt(0)" ::: "memory");
        const int hd = lane >> 3, e = lane & 7;
        volatile LAS unsigned* la = (volatile LAS unsigned*)(wl + P11_LISTS + (2 * hd) * 64);
        volatile LAS unsigned* lb = (volatile LAS unsigned*)(wl + P11_LISTS + (2 * hd + 1) * 64);
        unsigned cand[8];
#pragma unroll
        for (int m = 0; m < 7; ++m) {
            const unsigned ij = lut[m];
            const float av = __builtin_bit_cast(float, okey_inv(la[ij & 15u]) & ~0x7Fu), bv = __builtin_bit_cast(float, okey_inv(lb[(ij >> 4) & 15u]) & ~0x7Fu);
            const unsigned kk = okey((__builtin_bit_cast(unsigned, av + bv) & ~0x3Fu) | (unsigned)(e + 8 * m));
            cand[m] = (ij & 0x100u) ? kk : 0u;
        }
        cand[7] = 0u;
        bitonic_sort_desc<8>(cand);
        unsigned t16[16];
#pragma unroll
        for (int i = 0; i < 8; ++i) { t16[i] = cand[i]; t16[15 - i] = dppu<0xB1>(cand[i]); }
        bitonic_merge_desc<16>(t16);
        { unsigned d[16];
#pragma unroll
          for (int i = 0; i < 16; ++i) d[i] = umax_(t16[i], dppu<0x4E>(t16[15 - i]));
          bitonic_merge_desc<16>(d);
#pragma unroll
          for (int i = 0; i < 16; ++i) t16[i] = umax_(d[i], xor4u(d[15 - i]));
          bitonic_merge_desc<16>(t16); }
        if (e == 0) { LAS u32x4* tp = (LAS u32x4*)(wl + P11_TOPK + hd * 64);
            tp[0] = (u32x4){t16[0], t16[1], t16[2], t16[3]}; tp[1] = (u32x4){t16[4], t16[5], t16[6], t16[7]}; tp[2] = (u32x4){t16[8], t16[9], t16[10], t16[11]}; tp[3] = (u32x4){t16[12], t16[13], t16[14], t16[15]}; }
        asm volatile("s_waitcnt lgkmcnt(0)" ::: "memory");
#pragma unroll
        for (int sl = 0; sl < 2; ++sl) {
            const int hd2 = 4 * sl + (lane >> 4);
            const unsigned kb = okey_inv(((volatile LAS unsigned*)(wl + P11_TOPK))[hd2 * 16 + (lane & 15)]);
            const unsigned ij = ((volatile LAS unsigned*)(wl + P11_TAB))[kb & 0x3Fu];
            const unsigned ka = okey_inv(((volatile LAS unsigned*)(wl + P11_LISTS))[(2 * hd2) * 16 + (ij & 15u)]);
            const unsigned kq = okey_inv(((volatile LAS unsigned*)(wl + P11_LISTS))[(2 * hd2 + 1) * 16 + ((ij >> 4) & 15u)]);
            e_slot[sl] = (ka & 0x7Fu) * 128u + (kq & 0x7Fu);
            const float sv = __builtin_bit_cast(float, kb & ~0x3Fu);
            const float ex = __expf(sv - row_max16(sv));
            g_slot[sl] = ex / row_sum16(ex);
        }
    }
#pragma unroll
    for (int sl = 0; sl < 2; ++sl) {
        unsigned key = (e_slot[sl] << 6) | (unsigned)lane;
#pragma unroll
        for (int k = 2; k <= 64; k <<= 1)
#pragma unroll
            for (int j = k >> 1; j > 0; j >>= 1) {
                const unsigned other = (unsigned)__shfl_xor((int)key, j);
                const bool up = (k == 64) || ((lane & k) == 0), lower = (lane & j) == 0;
                const unsigned mn = umin_(key, other), mx = umax_(key, other);
                key = (lower == up) ? mn : mx;
            }
        e_slot[sl] = key >> 6;
        g_slot[sl] = __shfl(g_slot[sl], (int)(key & 63u));
    }
    {
        unsigned k0 = (e_slot[0] << 7) | (unsigned)lane, k1 = (e_slot[1] << 7) | 64u | (unsigned)lane;
        const unsigned r1 = (unsigned)__shfl((int)k1, 63 - lane);
        unsigned lo = umin_(k0, r1), hi = umax_(k0, r1);
#pragma unroll
        for (int j = 32; j > 0; j >>= 1) {
            const unsigned ol = (unsigned)__shfl_xor((int)lo, j), oh = (unsigned)__shfl_xor((int)hi, j);
            const bool lower = (lane & j) == 0;
            lo = lower ? umin_(lo, ol) : umax_(lo, ol); hi = lower ? umin_(hi, oh) : umax_(hi, oh);
        }
        const float g0 = g_slot[0], g1 = g_slot[1];
        const float a0 = __shfl(g0, (int)(lo & 63u)), a1 = __shfl(g1, (int)(lo & 63u)), b0 = __shfl(g0, (int)(hi & 63u)), b1 = __shfl(g1, (int)(hi & 63u));
        e_slot[0] = lo >> 7; g_slot[0] = (lo & 64u) ? a1 : a0;
        e_slot[1] = hi >> 7; g_slot[1] = (hi & 64u) ? b1 : b0;
    }
}
typedef __bf16 bf16x2_t __attribute__((ext_vector_type(2)));
template <int NTG>
__device__ __forceinline__ void p11_group(const Args& a, int t0, int tstride, const unsigned (&lut)[7], LAS unsigned char* wl, int lane) {
    unsigned char* ws = KWS();
    unsigned es[NTG][2]; float cu[NTG][2], cv[NTG][2];
    {
        u32x4 sc[8];
#pragma unroll 1
        for (int j0 = 0; j0 < NTG; j0 += 2) {
#pragma unroll
            for (int jj = 0; jj < 2; ++jj) {
                const int j = j0 + jj, t = t0 + j * tstride;
                int lo_ = lane; asm volatile("" : "+v"(lo_));
                p11_load_scores(sc, t, lo_);
                unsigned e2[2]; float g_slot[2];
                p11_topk(sc, lut, wl, lo_, e2, g_slot);
                const f32x4* sp = (const f32x4*)((const float*)(ws + WS_SSQ) + (size_t)t * 16);
                const f32x4 s0 = sp[0], s1 = sp[1], s2 = sp[2], s3 = sp[3];
                const float tot = (((s0[0] + s0[1]) + (s0[2] + s0[3])) + ((s1[0] + s1[1]) + (s1[2] + s1[3]))) + (((s2[0] + s2[1]) + (s2[2] + s2[3])) + ((s3[0] + s3[1]) + (s3[2] + s3[3])));
                const float rs = 1.f / sqrtf(tot * (1.f / 1024.f) + EPS);
                volatile LAS unsigned* res = (volatile LAS unsigned*)(wl + P11_RES) + j * 384;
#pragma unroll
                for (int sl = 0; sl < 2; ++sl) {
                    res[sl * 64 + lo_] = e2[sl];
                    res[128 + sl * 64 + lo_] = __builtin_bit_cast(unsigned, rs * ((const float*)(ws + WS_PUS))[e2[sl]]);
                    res[256 + sl * 64 + lo_] = __builtin_bit_cast(unsigned, g_slot[sl] * ((const float*)(ws + WS_PVS))[e2[sl]]);
                }
            }
        }
        asm volatile("s_waitcnt lgkmcnt(0)" ::: "memory");
#pragma unroll
        for (int j = 0; j < NTG; ++j) { volatile LAS unsigned* res = (volatile LAS unsigned*)(wl + P11_RES) + j * 384;
#pragma unroll
            for (int sl = 0; sl < 2; ++sl) { es[j][sl] = res[sl * 64 + lane]; cu[j][sl] = __builtin_bit_cast(float, res[128 + sl * 64 + lane]); cv[j][sl] = __builtin_bit_cast(float, res[256 + sl * 64 + lane]); } }
    }
    const int loff = 16 * lane;
    u32x4 rr[2][4];
#define P11_LOADR(TAB, B, l, sl, k) do { const int es_ = (int)es[l][sl]; const int p0_ = (k) * 4; \
        _Pragma("unroll") for (int jj = 0; jj < 4; ++jj) { const size_t eo_ = (size_t)(unsigned)__builtin_amdgcn_readlane(es_, p0_ + jj) * 1024; rr[B][jj] = *(const u32x4*)(((TAB) + eo_) + loff); } } while (0)
    float wgt[NTG][2];
    {
        const unsigned char* PU = ws + WS_PU;
        u32x4 hh_[NTG], hl_[NTG]; float hsc[NTG];
#pragma unroll
        for (int j = 0; j < NTG; ++j) { const int t = t0 + j * tstride;
            const u32x4 h0 = *(const u32x4*)((const bf16_t*)(ws + WS_HB) + (size_t)t * 1024 + 16 * lane), h1 = *(const u32x4*)((const bf16_t*)(ws + WS_HB) + (size_t)t * 1024 + 16 * lane + 8);
            float f[16]; float am = 0.f;
#pragma unroll
            for (int q = 0; q < 4; ++q) { f[2 * q] = bflo(h0[q]); f[2 * q + 1] = bfhi(h0[q]); f[8 + 2 * q] = bflo(h1[q]); f[8 + 2 * q + 1] = bfhi(h1[q]); }
#pragma unroll
            for (int i = 0; i < 16; ++i) am = fmaxf(am, fabsf(f[i]));
            am = fmaxf(wave_max(am), 1e-30f);
            const float sh = 127.f / am; hsc[j] = am * (1.f / (127.f * 254.f));
            unsigned wh[4], wl_[4];
#pragma unroll
            for (int q = 0; q < 4; ++q) { float a_[4], r_[4];
#pragma unroll
                for (int i = 0; i < 4; ++i) { a_[i] = __builtin_rintf(f[4 * q + i] * sh); r_[i] = (f[4 * q + i] * sh - a_[i]) * 254.f; }
                wh[q] = pack_i8x4(a_[0], a_[1], a_[2], a_[3]); wl_[q] = pack_i8x4(r_[0], r_[1], r_[2], r_[3]); }
            hh_[j] = (u32x4){wh[0], wh[1], wh[2], wh[3]}; hl_[j] = (u32x4){wl_[0], wl_[1], wl_[2], wl_[3]}; }
        float dots[NTG][2];
#pragma unroll
        for (int j = 0; j < NTG; ++j) { dots[j][0] = 0.f; dots[j][1] = 0.f; }
#define P11_COMPU(B, l, sl, k) do { float part[4]; \
        u32x4 h0_ = hh_[l], h1_ = hl_[l]; asm volatile("" : "+v"(h0_), "+v"(h1_)); \
        _Pragma("unroll") for (int jj = 0; jj < 4; ++jj) { int ah_ = 0, al_ = 0; \
            _Pragma("unroll") for (int q = 0; q < 4; ++q) { ah_ = __builtin_amdgcn_sdot4((int)rr[B][jj][q], (int)h0_[q], ah_, false); al_ = __builtin_amdgcn_sdot4((int)rr[B][jj][q], (int)h1_[q], al_, false); } \
            part[jj] = (float)(ah_ * 254 + al_); } \
        float q2[2]; \
        _Pragma("unroll") for (int kk = 0; kk < 2; ++kk) { const float keep = (lane & 1) ? part[2 * kk + 1] : part[2 * kk], send = (lane & 1) ? part[2 * kk] : part[2 * kk + 1]; q2[kk] = keep + dppf<0xB1>(send); } \
        float d_ = ((lane & 2) ? q2[1] : q2[0]) + dppf<0x4E>((lane & 2) ? q2[0] : q2[1]); \
        d_ += xor4f(d_); d_ += dppf<0x128>(d_); d_ = swap32_sum(swap16_sum(d_));                       \
        if ((lane >> 2) == (k)) dots[l][sl] = d_; } while (0)
        constexpr int L = NTG;
        P11_LOADR(PU, 0, 0, 0, 0);
#pragma unroll
        for (int sl = 0; sl < 2; ++sl) {
#pragma unroll 1
            for (int k = 0; k < 16; ++k) {
#pragma unroll
                for (int l = 0; l < L; ++l) {
                    if (l + 1 < L) { if ((l & 1) == 0) P11_LOADR(PU, 1, l + 1, sl, k); else P11_LOADR(PU, 0, l + 1, sl, k); }
                    else if (k + 1 < 16) P11_LOADR(PU, 0, 0, sl, k + 1);
                    else if (sl == 0) P11_LOADR(PU, 0, 0, 1, 0);
                    if ((l & 1) == 0) P11_COMPU(0, l, sl, k); else P11_COMPU(1, l, sl, k);
                }
            }
        }
#undef P11_COMPU
#pragma unroll
        for (int j = 0; j < NTG; ++j)
#pragma unroll
            for (int sl = 0; sl < 2; ++sl) { const float z = dots[j][sl] * hsc[j] * cu[j][sl]; wgt[j][sl] = cv[j][sl] * (0.5f * z * (1.f + erff(z * 0.70710678118654752f))); }
    }
    int o[NTG][16]; float wsc[NTG]; unsigned wpk[NTG][2];
#pragma unroll
    for (int j = 0; j < NTG; ++j) {
#pragma unroll
        for (int i = 0; i < 16; ++i) o[j][i] = 0;
        const float am = fmaxf(wave_max(fmaxf(fabsf(wgt[j][0]), fabsf(wgt[j][1]))), 1e-30f);
        const float sw = 127.f / am; wsc[j] = am * (1.f / 127.f);
#pragma unroll
        for (int sl = 0; sl < 2; ++sl) { const unsigned wq_ = (unsigned)(int)__builtin_rintf(wgt[j][sl] * sw) & 0xffu;
            wpk[j][sl] = dppu<0x00>(wq_) | (dppu<0x55>(wq_) << 8) | (dppu<0xAA>(wq_) << 16) | (dppu<0xFF>(wq_) << 24); }
    }
    {
        const unsigned char* PV = ws + WS_PV;
#define P11_COMPV(B, l, sl, k) do { const unsigned w4_ = (unsigned)__builtin_amdgcn_readlane((int)wpk[l][sl], (k) * 4); \
        _Pragma("unroll") for (int q = 0; q < 4; ++q) { const unsigned r0_ = rr[B][0][q], r1_ = rr[B][1][q], r2_ = rr[B][2][q], r3_ = rr[B][3][q]; \
            const unsigned a_ = __builtin_amdgcn_perm(r1_, r0_, 0x05010400u), b_ = __builtin_amdgcn_perm(r1_, r0_, 0x07030602u); \
            const unsigned c_ = __builtin_amdgcn_perm(r3_, r2_, 0x05010400u), d_ = __builtin_amdgcn_perm(r3_, r2_, 0x07030602u); \
            o[l][4 * q] = __builtin_amdgcn_sdot4((int)__builtin_amdgcn_perm(c_, a_, 0x05040100u), (int)w4_, o[l][4 * q], false); \
            o[l][4 * q + 1] = __builtin_amdgcn_sdot4((int)__builtin_amdgcn_perm(c_, a_, 0x07060302u), (int)w4_, o[l][4 * q + 1], false); \
            o[l][4 * q + 2] = __builtin_amdgcn_sdot4((int)__builtin_amdgcn_perm(d_, b_, 0x05040100u), (int)w4_, o[l][4 * q + 2], false); \
            o[l][4 * q + 3] = __builtin_amdgcn_sdot4((int)__builtin_amdgcn_perm(d_, b_, 0x07060302u), (int)w4_, o[l][4 * q + 3], false); } } while (0)
        constexpr int L = NTG;
        P11_LOADR(PV, 0, 0, 0, 0);
#pragma unroll
        for (int sl = 0; sl < 2; ++sl) {
#pragma unroll 1
            for (int k = 0; k < 16; ++k) {
#pragma unroll
                for (int l = 0; l < L; ++l) {
                    if (l + 1 < L) { if ((l & 1) == 0) P11_LOADR(PV, 1, l + 1, sl, k); else P11_LOADR(PV, 0, l + 1, sl, k); }
                    else if (k + 1 < 16) P11_LOADR(PV, 0, 0, sl, k + 1);
                    else if (sl == 0) P11_LOADR(PV, 0, 0, 1, 0);
                    if ((l & 1) == 0) P11_COMPV(0, l, sl, k); else P11_COMPV(1, l, sl, k);
                }
            }
        }
#undef P11_COMPV
    }
#undef P11_LOADR
    const float* NF = KIN(24) + 16 * lane;
#pragma unroll
    for (int j = 0; j < NTG; ++j) {
        float* H = KOUT() + (size_t)(t0 + j * tstride) * 1024 + 16 * lane;
        const u32x4* hb = (const u32x4*)((const bf16_t*)(ws + WS_HB) + (size_t)(t0 + j * tstride) * 1024 + 16 * lane);
        const u32x4 hb0 = hb[0], hb1 = hb[1];
        float y[16]; float ss = 0.f;
#pragma unroll
        for (int q = 0; q < 4; ++q) { y[2 * q] = bflo(hb0[q]); y[2 * q + 1] = bfhi(hb0[q]); y[8 + 2 * q] = bflo(hb1[q]); y[8 + 2 * q + 1] = bfhi(hb1[q]); }
#pragma unroll
        for (int i = 0; i < 16; ++i) { y[i] += (float)o[j][i] * wsc[j]; ss += y[i] * y[i]; }
        const float rf = 1.f / sqrtf(wave_sum_fast(ss) * (1.f / 1024.f) + EPS);
#pragma unroll
        for (int q = 0; q < 4; ++q) { const f32x4 nv = *(const f32x4*)(NF + 4 * q);
            *(f32x4*)(H + 4 * q) = (f32x4){y[4 * q] * rf * nv[0], y[4 * q + 1] * rf * nv[1], y[4 * q + 2] * rf * nv[2], y[4 * q + 3] * rf * nv[3]}; }
    }
}

__global__ void __launch_bounds__(NT, 2) mega(Args a) {
    extern __shared__ __attribute__((aligned(16))) unsigned char lds_raw[];
    LAS unsigned char* lds = (LAS unsigned char*)lds_raw;
    volatile LAS unsigned* MISC = (volatile LAS unsigned*)(lds + 131072 + 320);
    if (threadIdx.x < 32) MISC[threadIdx.x] = 0u;
    __syncthreads();
    XcdBarrier xbar = xcd_barrier_post((unsigned*)(KWS() + WS_CTL) + 4096, MISC + 8);
#define GSYNC() xcd_barrier(xbar)
#ifndef PH_LO
#define PH_LO 0
#endif
#ifndef PH_HI
#define PH_HI 99
#endif
#define IN(k) (PH_LO <= (k) && (k) <= PH_HI)
    if (IN(0)) { p0_prologue(a, lds); GSYNC(); }
    if (IN(1)) {
        unsigned char* ws = KWS(); const int G = gridDim.x, bx = opaque_bx(); pg8::StaticOrder S;
        pg8::Gemm g{(const bf16_t*)(ws + WS_XN), (const bf16_t*)(ws + WS_WIN), TOK, IN_PAD, 1024, 1024, 1024}; S.init(TOK, IN_PAD, G, bx);
        EpiInProj E{(bf16_t*)(ws + WS_Z), (bf16_t*)(ws + WS_XBC), (bf16_t*)(ws + WS_G), (bf16_t*)(ws + WS_QA), (bf16_t*)(ws + WS_KVA)};
        { const int rem = S.nwg % G; if (rem == 0) p9_peer_tables(a, 0, 16384, bx, G); else if (bx >= rem) p9_peer_tables(a, 0, 16384, bx - rem, G - rem); }
        pg8::gemm_phase(lds, g, S, E); GSYNC();
    }
    if (IN(2)) { p2_prep(a, lds); GSYNC(); }
    if (IN(3)) { const int G = gridDim.x; for (int u = opaque_bx(); u < BATCH * 16 * 2; u += G) p34_chain(a, lds, u); GSYNC(); }
    if (IN(5)) { const int G = gridDim.x; for (int u = opaque_bx(); u < BATCH * NCHUNK * 2; u += G) p5_out_unit(a, lds, u); GSYNC(); }
    if (IN(6)) {
        unsigned char* ws = KWS(); const int G = gridDim.x, bx = opaque_bx(); pg8::StaticOrder S;
        const int rot = (bx >> 3) % 3;
#pragma unroll 1
        for (int s_ = 0; s_ < 3; ++s_) {
            int ph_ = s_ + rot; if (ph_ >= 3) ph_ -= 3; asm volatile("" : "+s"(ph_));
            if (ph_ == 0) {
        { pg8::Gemm g{(const bf16_t*)(ws + WS_QA), (const bf16_t*)(ws + WS_WQB), TOK, 1536, 384, 512, 384}; S.init(TOK, 1536, G, bx);
          EpiQ E{(bf16_t*)KOUT(), (const float*)(ws + WS_RQ), (const float*)(ws + WS_COS), (const float*)(ws + WS_SIN)}; pg8::gemm_phase(lds, g, S, E); }
            } else if (ph_ == 1) {
        { pg8::Gemm g{(const bf16_t*)(ws + WS_KVA), (const bf16_t*)(ws + WS_WK), TOK, 1024, 256, 256, 256}; S.init(TOK, 1024, G, bx);
          EpiK E{(bf16_t*)(ws + WS_K), (const float*)(ws + WS_RKV)}; pg8::gemm_phase(lds, g, S, E); }
            } else {
        { pg8::Gemm g{(const bf16_t*)(ws + WS_WV), (const bf16_t*)(ws + WS_KVA), 1024, TOK, 256, 256, 256}; S.init(1024, TOK, G, bx);
          EpiVT E{(bf16_t*)(ws + WS_VT), (const float*)(ws + WS_RKV)}; pg8::gemm_phase(lds, g, S, E); }
            }
        }
        GSYNC();
    }
    if (IN(7)) { p7_attention(a, lds); GSYNC(); }
    if (IN(8)) {
        unsigned char* ws = KWS(); const int G = gridDim.x, bx = opaque_bx(); pg8::StaticOrder S;
        { pg8::Gemm g{(const bf16_t*)(ws + WS_YS), (const bf16_t*)(ws + WS_PA), TOK, 1024, 1024, 1024, 1024}; S.init(TOK, 1024, G, bx);
          EpiMerge1 E{(bf16_t*)(ws + WS_M), (const unsigned char*)(ws + WS_G)}; pg8::gemm_phase(lds, g, S, E); }
        { pg8::Gemm g{(const bf16_t*)(ws + WS_YM), (const bf16_t*)(ws + WS_PB), TOK, 1024, 1024, 1024, 1024}; S.init(TOK, 1024, G, bx);
          EpiMerge2 E{(bf16_t*)(ws + WS_M), (const unsigned char*)(ws + WS_G)}; pg8::gemm_phase(lds, g, S, E); }
        GSYNC();
    }
    if (IN(9)) {
        unsigned char* ws = KWS(); const int G = gridDim.x, bx = opaque_bx(); pg8::StaticOrder S;
        { pg8::Gemm g{(const bf16_t*)(ws + WS_M), (const bf16_t*)(ws + WS_WOUT), TOK, 1024, 1024, 1024, 1024}; S.init(TOK, 1024, G, bx);
          EpiOut E{KIN(0), (bf16_t*)(ws + WS_HB), (float*)(ws + WS_SSQ)};
          const bool first = (bx >> 3) & 1;
          if (first) p9_peer_tables(a, 16384, 32768, bx, G);
          pg8::gemm_phase(lds, g, S, E);
          if (!first) p9_peer_tables(a, 16384, 32768, bx, G); }
        GSYNC();
    }
    if (IN(10)) {
        unsigned char* ws = KWS(); const int G = gridDim.x, bx = opaque_bx(); pg8::StaticOrder S;
        pg8::Gemm g{(const bf16_t*)(ws + WS_HB), (const bf16_t*)(ws + WS_WPQ), TOK, 2048, 1024, 1024, 1024}; S.init(TOK, 2048, G, bx);
        EpiScore E{(float*)(ws + WS_SC), (const float*)(ws + WS_SSQ)}; pg8::gemm_phase(lds, g, S, E);
        GSYNC();
    }
    if (IN(11)) { const int tid_ = opaque_tid(); const int wave = tid_ >> 6, lane = tid_ & 63; const int gw = opaque_bx() * NW + wave, ngw = gridDim.x * NW; LAS unsigned char* wl = lds + wave * P11_WAVE_LDS; unsigned lut[7]; p11_setup(wl, lane, lut); for (int t = gw; t < TOK; t += P11_NTG * ngw) p11_group<P11_NTG>(a, t, ngw, lut, wl, lane); }
}

extern "C" void kernel_launch(void* const* d_in, const int* in_sizes, int n_in, void* d_out, int out_size, void* d_ws, size_t ws_size, hipStream_t stream) {
    static int grid = 0;
    if (grid == 0) {
        if (n_in != 25 || out_size != TOK * DM || ws_size < WS_END) { fprintf(stderr, "kernel_launch: unexpected sizes n_in %d out %d ws %zu\n", n_in, out_size, ws_size); grid = -1; return; }
        int dev = 0, cus = 0, per_cu = 0;
        (void)hipGetDevice(&dev);
        (void)hipDeviceGetAttribute(&cus, hipDeviceAttributeMultiprocessorCount, dev);
        (void)hipFuncSetAttribute((const void*)mega, hipFuncAttributeMaxDynamicSharedMemorySize, LDS_BYTES);
        (void)hipOccupancyMaxActiveBlocksPerMultiprocessor(&per_cu, (const void*)mega, NT, LDS_BYTES);
        if (per_cu < 1) { fprintf(stderr, "kernel_launch: occupancy query reports %d\n", per_cu); grid = -1; return; }
        grid = cus;
    }
    if (grid < 0) return;
    if (hipMemsetAsync((char*)d_ws + WS_CTL, 0, 1 * MiB, stream) != hipSuccess) { fprintf(stderr, "kernel_launch: hipMemsetAsync failed\n"); return; }
    Args a{};
    for (int i = 0; i < 25; ++i) a.in[i] = (const float*)d_in[i];
    a.out = (float*)d_out; a.ws = (unsigned char*)d_ws;
    void* args[] = {&a};
    hipError_t e = hipLaunchCooperativeKernel((const void*)mega, dim3(grid), dim3(NT), args, LDS_BYTES, stream);
    if (e != hipSuccess) fprintf(stderr, "kernel_launch: cooperative launch failed: %s (grid %d)\n", hipGetErrorString(e), grid);
}
```

```cpp
#include <hip/hip_runtime.h>
#include <hip/hip_cooperative_groups.h>
#include <cstdio>
#include <cstdint>
namespace cg = cooperative_groups;

#define LAS __attribute__((address_space(3)))
typedef unsigned short bf16_t;
typedef short bf16x8 __attribute__((ext_vector_type(8)));
typedef float f32x4 __attribute__((ext_vector_type(4)));
typedef float f32x2 __attribute__((ext_vector_type(2)));
typedef float f32x16 __attribute__((ext_vector_type(16)));
typedef unsigned u32x4 __attribute__((ext_vector_type(4)));
typedef unsigned u32x2 __attribute__((ext_vector_type(2)));

constexpr int BATCH = 8, SEQ = 4096, TOK = BATCH * SEQ, DM = 1024;
constexpr int NW = 8, NT = NW * 64;
constexpr int CHUNK = 128, NCHUNK = SEQ / CHUNK;
constexpr int IN_PAD = 5376;
constexpr int QW = 1536, KW = 1024;
constexpr float EPS = 1e-6f;
constexpr float QSCALE = 0.10206207261596577f * 1.4426950408889634f;

__device__ __forceinline__ unsigned f2bf(float f) { unsigned u = __builtin_bit_cast(unsigned, f); return (u + 0x7fffu + ((u >> 16) & 1u)) >> 16; }
typedef __bf16 bf16x2_t __attribute__((ext_vector_type(2)));
__device__ __forceinline__ unsigned pk2(float lo, float hi) { f32x2 v = {lo, hi}; bf16x2_t b = __builtin_convertvector(v, bf16x2_t); return __builtin_bit_cast(unsigned, b); }
__device__ __forceinline__ float bflo(unsigned u) { return __builtin_bit_cast(float, u << 16); }
__device__ __forceinline__ float bfhi(unsigned u) { return __builtin_bit_cast(float, u & 0xffff0000u); }
__device__ __forceinline__ float bf1(bf16_t u) { return __builtin_bit_cast(float, (unsigned)u << 16); }
__device__ __forceinline__ float wave_sum(float v) {
#pragma unroll
    for (int o = 1; o < 64; o <<= 1) v += __shfl_xor(v, o);
    return v;
}
__device__ __forceinline__ int opaque_bx() { int b = blockIdx.x; asm volatile("" : "+s"(b)); return b; }
__device__ __forceinline__ int opaque_tid() { int t = threadIdx.x; asm volatile("" : "+v"(t)); return t; }
__device__ __forceinline__ float fast_rcp(float x) { return __builtin_amdgcn_rcpf(x); }
__device__ __forceinline__ float sigmoidf_(float x) { return fast_rcp(1.f + __expf(-x)); }
__device__ __forceinline__ float siluf_(float x) { return x * sigmoidf_(x); }

#define SWAP_PAIR(BUILTIN, x, r0, r1) unsigned r0, r1; { unsigned a_ = __builtin_bit_cast(unsigned, x), b_ = a_; asm volatile("" : "+v"(b_)); auto r_ = BUILTIN(a_, b_, false, false); r0 = r_[0]; r1 = r_[1]; asm volatile("" : "+v"(r0), "+v"(r1)); }

template <int CTRL> __device__ __forceinline__ float dppf(float x) { return __builtin_bit_cast(float, __builtin_amdgcn_update_dpp(0, __builtin_bit_cast(int, x), CTRL, 0xF, 0xF, true)); }
__device__ __forceinline__ float swap16_max(float x) { SWAP_PAIR(__builtin_amdgcn_permlane16_swap, x, r0, r1); return fmaxf(__builtin_bit_cast(float, r0), __builtin_bit_cast(float, r1)); }
__device__ __forceinline__ float swap32_max(float x) { SWAP_PAIR(__builtin_amdgcn_permlane32_swap, x, r0, r1); return fmaxf(__builtin_bit_cast(float, r0), __builtin_bit_cast(float, r1)); }
__device__ __forceinline__ float swap16_sum(float x) { SWAP_PAIR(__builtin_amdgcn_permlane16_swap, x, r0, r1); return __builtin_bit_cast(float, r0) + __builtin_bit_cast(float, r1); }
__device__ __forceinline__ float swap32_sum(float x) { SWAP_PAIR(__builtin_amdgcn_permlane32_swap, x, r0, r1); return __builtin_bit_cast(float, r0) + __builtin_bit_cast(float, r1); }
__device__ __forceinline__ float wave_max(float x) {
    x = fmaxf(x, dppf<0xB1>(x)); x = fmaxf(x, dppf<0x4E>(x)); x = fmaxf(x, dppf<0x141>(x)); x = fmaxf(x, dppf<0x140>(x));
    return swap32_max(swap16_max(x));
}
__device__ __forceinline__ float row_sum16(float x) {
    x += dppf<0xB1>(x); x += dppf<0x4E>(x); x += dppf<0x141>(x); x += dppf<0x140>(x); return x;
}
__device__ __forceinline__ float wave_sum_fast(float x) { return swap32_sum(swap16_sum(row_sum16(x))); }

namespace pg8 {
constexpr int BM = 256, BK = 64, HALF = 128, HTB = HALF * BK * 2, STAGE_BYTES = 8 * HTB, NXCD = 8, WGM = 8;
__host__ __device__ __forceinline__ int lds_byte(int r, int c) { const int st = (r >> 4) * 2 + (c >> 5), rr = r & 15, cc = c & 31, ob = rr * 64 + cc * 2; return st * 1024 + (ob ^ (((ob >> 9) & 1) << 5)); }
__host__ __device__ __forceinline__ void stage_rc(int b, int& R, int& C) { const int st = b / 1024, sb = b % 1024, swz = sb ^ (((sb >> 9) & 1) << 5); R = (st >> 1) * 16 + swz / 64; C = (st & 1) * 32 + (swz % 64) / 2; }
__host__ __device__ __forceinline__ int perm32(int rho) { const int n = rho >> 4, i = rho & 15; return 8 * (i >> 2) + 4 * n + (i & 3); }
struct Unit { int pm, pn; };
struct Gemm { const bf16_t* A; const bf16_t* Bt; int M, N, K, lda, ldb; };
struct StaticOrder {
    int nM, nN, nwg, G, c;
    __device__ void init(int M, int N, int G_, int c_) { nM = M / BM; nN = N / BM; nwg = nM * nN; G = G_; c = c_; }
    __device__ bool next(int i, Unit& u) const {
        const long L = (long)i * G + c; if (L >= nwg) return false;
        int wgid = (int)L; { const int q = nwg / NXCD, r = nwg % NXCD, xcd = wgid % NXCD, off = wgid / NXCD; wgid = (xcd < r ? xcd * (q + 1) : r * (q + 1) + (xcd - r) * q) + off; }
        const int nig = WGM * nN, gid = wgid / nig, fm = gid * WGM, gsz = (nM - fm) < WGM ? (nM - fm) : WGM;
        u.pm = fm + ((wgid % nig) % gsz); u.pn = (wgid % nig) / gsz; return true;
    }
};
template <class Epi>
__device__ __forceinline__ void gemm_phase(LAS unsigned char* lds, const Gemm g, const StaticOrder& S, const Epi& E) {
    const int tid = opaque_tid(), wid = __builtin_amdgcn_readfirstlane(tid >> 6), lane = tid & 63, wr = wid >> 2, wc = wid & 3, fr = lane & 15, fq = lane >> 4;
    const int K = g.K, nt = K / BK;
    unsigned voffA[2], voffB[2];
#pragma unroll
    for (int i = 0; i < 2; ++i) { int R, C; stage_rc(tid * 16 + i * 8192, R, C); const int Rb = (R & ~31) + perm32(R & 31);
        voffA[i] = (unsigned)(R * g.lda + C) * 2u; voffB[i] = (unsigned)(Rb * g.ldb + C) * 2u; }
    const size_t kstep = (size_t)(BK * 2);
    const size_t hstepA = (size_t)HALF * g.lda * 2, hstepB = (size_t)HALF * g.ldb * 2;
    const size_t tstepA = 2 * hstepA, tstepB = 2 * hstepB;
    const unsigned ldsw = (unsigned)wid * 1024u;
    const int aoff = lds_byte(wr * 64 + fr, fq * 8), boff = lds_byte(wc * 32 + fr, fq * 8);
#define PG8_SA(b, h) (((b) * 2 + (h)) * HTB)
#define PG8_SB(b, h) ((4 + (b) * 2 + (h)) * HTB)
#define PG8_STAGE(bufoff, gbase, voff) do { _Pragma("unroll") for (int _i = 0; _i < 2; ++_i) \
        __builtin_amdgcn_global_load_lds((const unsigned*)((const char*)(gbase) + (voff)[_i]), (LAS unsigned*)(lds + (bufoff) + ldsw + _i * 8192), 16, 0, 0); } while (0)
#define PG8_LDA(dst, b, h) do { _Pragma("unroll") for (int m = 0; m < 4; ++m) _Pragma("unroll") for (int k = 0; k < 2; ++k) dst[m][k] = *(const LAS bf16x8*)(lds + PG8_SA(b, h) + aoff + m * 2048 + k * 1024); } while (0)
#define PG8_LDB(dst, b, h) do { _Pragma("unroll") for (int n = 0; n < 2; ++n) _Pragma("unroll") for (int k = 0; k < 2; ++k) dst[n][k] = *(const LAS bf16x8*)(lds + PG8_SB(b, h) + boff + n * 2048 + k * 1024); } while (0)
#define PG8_MMA(ai, bj, At, Bt) do { __builtin_amdgcn_s_setprio(1); _Pragma("unroll") for (int m = 0; m < 4; ++m) _Pragma("unroll") for (int n = 0; n < 2; ++n) _Pragma("unroll") for (int k = 0; k < 2; ++k) \
        acc[ai][bj][m][n] = __builtin_amdgcn_mfma_f32_16x16x32_bf16(Bt[n][k], At[m][k], acc[ai][bj][m][n], 0, 0, 0); __builtin_amdgcn_s_setprio(0); } while (0)
#define PG8_WAIT_V(n) asm volatile("s_waitcnt vmcnt(" #n ")" ::: "memory")
#define PG8_WAIT_L(n) asm volatile("s_waitcnt lgkmcnt(" #n ")" ::: "memory")
#define PG8_BAR __builtin_amdgcn_s_barrier()
#define PG8_SCHED __builtin_amdgcn_sched_barrier(0)
    Unit cur, nxt; int ui = 0;
    if (!S.next(0, cur)) return;
    f32x4 acc[2][2][4][2];
#pragma unroll
    for (int a = 0; a < 2; ++a)
#pragma unroll
        for (int b = 0; b < 2; ++b)
#pragma unroll
            for (int m = 0; m < 4; ++m)
#pragma unroll
                for (int n = 0; n < 2; ++n) acc[a][b][m][n] = (f32x4){0.f, 0.f, 0.f, 0.f};
    bf16x8 At[4][2], B0[2][2], B1[2][2];
    const char* cA = (const char*)g.A + (size_t)cur.pm * tstepA; const char* cB = (const char*)g.Bt + (size_t)cur.pn * tstepB;
    PG8_STAGE(PG8_SB(0, 0), cB, voffB); PG8_STAGE(PG8_SB(0, 1), cB + hstepB, voffB); PG8_STAGE(PG8_SA(0, 0), cA, voffA); PG8_STAGE(PG8_SA(0, 1), cA + hstepA, voffA);
    if (wr == 1) PG8_BAR;
    PG8_WAIT_V(2); PG8_BAR;
    PG8_STAGE(PG8_SB(1, 0), cB + kstep, voffB); PG8_STAGE(PG8_SA(1, 0), cA + kstep, voffA); PG8_STAGE(PG8_SB(1, 1), cB + hstepB + kstep, voffB);
    PG8_WAIT_V(6); PG8_BAR;
    for (;;) {
        const bool has_next = S.next(ui + 1, nxt);
        const char* nA = has_next ? (const char*)g.A + (size_t)nxt.pm * tstepA : cA; const char* nB = has_next ? (const char*)g.Bt + (size_t)nxt.pn * tstepB : cB;
#pragma unroll 1
        for (int t = 0; t < nt; t += 2) {
            const bool last = (t == nt - 2);
            const char* a1 = cA + (size_t)(t + 1) * kstep;
            const char* a2 = last ? nA : cA + (size_t)(t + 2) * kstep; const char* b2 = last ? nB : cB + (size_t)(t + 2) * kstep;
            const char* a3 = a2 + kstep; const char* b3 = b2 + kstep;
            PG8_LDB(B0, 0, 0); PG8_LDB(B1, 0, 1); PG8_SCHED; PG8_LDA(At, 0, 0); PG8_STAGE(PG8_SA(1, 1), a1 + hstepA, voffA);
            PG8_WAIT_V(8); PG8_WAIT_L(0); PG8_BAR; PG8_MMA(0, 0, At, B0); PG8_MMA(0, 1, At, B1); PG8_BAR; PG8_SCHED;
            PG8_LDA(At, 0, 1); PG8_STAGE(PG8_SB(0, 0), b2, voffB); PG8_STAGE(PG8_SB(0, 1), b2 + hstepB, voffB); PG8_STAGE(PG8_SA(0, 0), a2, voffA);
            PG8_WAIT_V(8); PG8_WAIT_L(0); PG8_BAR; PG8_MMA(1, 0, At, B0); PG8_MMA(1, 1, At, B1); PG8_BAR; PG8_SCHED;
            PG8_LDB(B0, 1, 0); PG8_LDB(B1, 1, 1); PG8_SCHED; PG8_LDA(At, 1, 0); PG8_STAGE(PG8_SA(0, 1), a2 + hstepA, voffA);
            PG8_WAIT_V(8); PG8_WAIT_L(0); PG8_BAR; PG8_MMA(0, 0, At, B0); PG8_MMA(0, 1, At, B1); PG8_BAR; PG8_SCHED;
            PG8_LDA(At, 1, 1); PG8_STAGE(PG8_SB(1, 0), b3, voffB); PG8_STAGE(PG8_SB(1, 1), b3 + hstepB, voffB); PG8_STAGE(PG8_SA(1, 0), a3, voffA);
            PG8_WAIT_V(8); PG8_WAIT_L(0); PG8_BAR; PG8_MMA(1, 0, At, B0); PG8_MMA(1, 1, At, B1); PG8_BAR; PG8_SCHED;
        }
        if (wr == 0) PG8_BAR;
        E(acc, cur, wr, wc, fr, fq);
        if (!has_next) break;
#pragma unroll
        for (int a = 0; a < 2; ++a)
#pragma unroll
            for (int b = 0; b < 2; ++b)
#pragma unroll
                for (int m = 0; m < 4; ++m)
#pragma unroll
                    for (int n = 0; n < 2; ++n) acc[a][b][m][n] = (f32x4){0.f, 0.f, 0.f, 0.f};
        cur = nxt; cA = nA; cB = nB; ++ui;
        if (wr == 1) PG8_BAR;
    }
    PG8_WAIT_V(0);
    PG8_BAR;
#undef PG8_SA
#undef PG8_SB
#undef PG8_STAGE
#undef PG8_LDA
#undef PG8_LDB
#undef PG8_MMA
#undef PG8_WAIT_V
#undef PG8_WAIT_L
#undef PG8_BAR
#undef PG8_SCHED
}
template <class F>
__device__ __forceinline__ void foreach8(const f32x4 (&acc)[2][2][4][2], const Unit& u, int wr, int wc, int fr, int fq, F&& f) {
#pragma unroll
    for (int ai = 0; ai < 2; ++ai)
#pragma unroll
        for (int m = 0; m < 4; ++m) { const int row = u.pm * 256 + ai * 128 + wr * 64 + m * 16 + fr;
#pragma unroll
            for (int bj = 0; bj < 2; ++bj) { const int col = u.pn * 256 + bj * 128 + wc * 32 + 8 * fq; f(row, col, acc[ai][bj][m][0], acc[ai][bj][m][1]); }
            if (m == 3) asm volatile("" ::: "memory"); }
}
template <int MB, class D, class L, class F>
__device__ __forceinline__ void foreach8_batched(const f32x4 (&acc)[2][2][4][2], const Unit& u, int wr, int wc, int fr, int fq, L&& load, F&& apply) {
#pragma unroll
    for (int ai = 0; ai < 2; ++ai)
#pragma unroll
        for (int m0 = 0; m0 < 4; m0 += MB) {
            D d[MB][2];
#pragma unroll
            for (int mm = 0; mm < MB; ++mm) { const int row = u.pm * 256 + ai * 128 + wr * 64 + (m0 + mm) * 16 + fr;
#pragma unroll
                for (int bj = 0; bj < 2; ++bj) { const int col = u.pn * 256 + bj * 128 + wc * 32 + 8 * fq; d[mm][bj] = load(row, col); } }
#pragma unroll
            for (int mm = 0; mm < MB; ++mm) { const int row = u.pm * 256 + ai * 128 + wr * 64 + (m0 + mm) * 16 + fr;
#pragma unroll
                for (int bj = 0; bj < 2; ++bj) { const int col = u.pn * 256 + bj * 128 + wc * 32 + 8 * fq; apply(row, col, acc[ai][bj][m0 + mm][0], acc[ai][bj][m0 + mm][1], d[mm][bj]); } }
            asm volatile("" ::: "memory");
        }
}
}
constexpr size_t MiB = 1u << 20;
constexpr size_t WS_CTL = 0;
constexpr size_t WS_WIN = 1 * MiB;
constexpr size_t WS_WQB = 12 * MiB;
constexpr size_t WS_WK = 14 * MiB;
constexpr size_t WS_WV = 14 * MiB + 512 * 1024;
constexpr size_t WS_PA = 15 * MiB, WS_PB = 17 * MiB, WS_WOUT = 19 * MiB;
constexpr size_t WS_WPQ = 21 * MiB;
constexpr size_t WS_XN = 26 * MiB;
constexpr size_t WS_BC = 26 * MiB;
constexpr size_t WS_BT = 58 * MiB;
constexpr size_t WS_ACSF = 74 * MiB, WS_DTF = 76 * MiB, WS_RACSB = 78 * MiB, WS_DTB = 80 * MiB;
constexpr size_t WS_RQ = 82 * MiB, WS_RKV = 82 * MiB + 256 * 1024;
constexpr size_t WS_COS = 83 * MiB, WS_SIN = 85 * MiB;
constexpr size_t WS_KR = 508 * MiB;
constexpr size_t WS_YM = 26 * MiB;
constexpr size_t WS_PU = 490 * MiB, WS_PV = 42 * MiB;
constexpr size_t WS_PUS = 506 * MiB, WS_PVS = 59 * MiB;
constexpr size_t WS_Z = 90 * MiB;
constexpr size_t WS_YS = WS_Z;
constexpr size_t WS_G = 154 * MiB;
constexpr size_t WS_QA = 282 * MiB;
constexpr size_t WS_KVA = 314 * MiB;
constexpr size_t WS_XBC = 330 * MiB;
constexpr size_t WS_ST = 330 * MiB;
constexpr size_t WS_K = 330 * MiB;
constexpr size_t WS_VT = 426 * MiB;
constexpr size_t WS_M = 282 * MiB;
constexpr size_t WS_HB = 346 * MiB;
constexpr size_t WS_SSQ = 410 * MiB;
constexpr size_t WS_SC = 90 * MiB;
constexpr size_t WS_END = 510 * MiB;

constexpr int LDS_BYTES = 147456;

struct Args { const float* in[25]; float* out; unsigned char* ws; };
#define KIN(i) (((const float* const*)__builtin_amdgcn_kernarg_segment_ptr())[(i)])
#define KOUT() (((float* const*)__builtin_amdgcn_kernarg_segment_ptr())[25])
#define KWS() (((unsigned char* const*)__builtin_amdgcn_kernarg_segment_ptr())[26])

template <int NB, class MapF>
__device__ __forceinline__ void transpose_w(const float* __restrict__ W, int K, int Nsrc, bf16_t* __restrict__ Wt, int Ndst, const float* __restrict__ scale, float cs, MapF mapf, int gtid, int gn) {
    const int items = Ndst * (K / 8);
    for (int it0 = gtid; it0 < items; it0 += NB * gn) {
        float v[NB][8];
#pragma unroll
        for (int b = 0; b < NB; ++b) { const int it = it0 + b * gn; const bool ok = it < items; const int n = it % Ndst, k0 = (it / Ndst) * 8; const int src = ok ? mapf(n) : -1;
#pragma unroll
            for (int j = 0; j < 8; ++j) { float w = (src >= 0) ? W[(size_t)(k0 + j) * Nsrc + src] : 0.f; if (scale && ok) w *= scale[k0 + j]; v[b][j] = w * cs; } }
#pragma unroll
        for (int b = 0; b < NB; ++b) { const int it = it0 + b * gn; if (it < items) { const int n = it % Ndst, k0 = (it / Ndst) * 8;
            *(u32x4*)(Wt + (size_t)n * K + k0) = (u32x4){pk2(v[b][0], v[b][1]), pk2(v[b][2], v[b][3]), pk2(v[b][4], v[b][5]), pk2(v[b][6], v[b][7])}; } }
    }
}
template <class MapF>
__device__ __forceinline__ void transpose_tile(const float* __restrict__ W, int K, int Nsrc, bf16_t* __restrict__ Wt, const float* __restrict__ scale, float cs, MapF mapf, LAS float* scr, int item, int lane) {
    const int nkb = K >> 6; const int kb = item % nkb, nb = item / nkb, k0 = 64 * kb, n0 = 32 * nb;
    const int sb = mapf(n0);
    const int r = lane >> 3, c = lane & 7;
    f32x4 v[8];
#pragma unroll
    for (int i = 0; i < 8; ++i) v[i] = (sb >= 0) ? *(const f32x4*)(W + (size_t)(k0 + 8 * i + r) * Nsrc + sb + 4 * c) : (f32x4){0.f, 0.f, 0.f, 0.f};
    f32x4 s0 = (f32x4){cs, cs, cs, cs}, s1 = s0;
    if (scale) { s0 = *(const f32x4*)(scale + k0 + 8 * c) * cs; s1 = *(const f32x4*)(scale + k0 + 8 * c + 4) * cs; }
#pragma unroll
    for (int i = 0; i < 8; ++i)
#pragma unroll
        for (int j = 0; j < 4; ++j) scr[(8 * i + r) * 33 + 4 * c + j] = v[i][j];
    asm volatile("s_waitcnt lgkmcnt(0)" ::: "memory");
#pragma unroll
    for (int j = 0; j < 4; ++j) { const int n = r + 8 * j; const int col = (sb >= 0) ? mapf(n0 + n) - sb : 0; const LAS float* sp = scr + (8 * c) * 33 + col;
        const u32x4 o = (u32x4){pk2(sp[0 * 33] * s0[0], sp[1 * 33] * s0[1]), pk2(sp[2 * 33] * s0[2], sp[3 * 33] * s0[3]), pk2(sp[4 * 33] * s1[0], sp[5 * 33] * s1[1]), pk2(sp[6 * 33] * s1[2], sp[7 * 33] * s1[3])};
        *(u32x4*)(Wt + (size_t)(n0 + n) * K + k0 + 8 * c) = o; }
    asm volatile("s_waitcnt lgkmcnt(0)" ::: "memory");
}
struct MapIn { __device__ int operator()(int n) const {
    if (n < 2560) return n;
    if (n < 4608) return 3264 + (n - 2560);
    if (n < 4992) return 2592 + (n - 4608);
    if (n < 5024) return 2560 + (n - 4992);
    if (n < 5056) return 3232 + (n - 5024);
    if (n < 5120) return -1;
    return 2976 + (n - 5120); } };
struct MapQ { __device__ int operator()(int n) const { const int h = n / 96, dd = n % 96; if (dd < 64) return n; const int j = dd - 64, i = j >> 1; return h * 96 + 64 + ((j & 1) ? 16 + i : i); } };
struct MapKn { __device__ int operator()(int n) const { return (n >> 6) * 128 + (n & 63); } };
struct MapV { __device__ int operator()(int n) const { return (n >> 6) * 128 + 64 + (n & 63); } };
struct MapId { __device__ int operator()(int n) const { return n; } };

__device__ __forceinline__ void p0_wpq_item(const float* __restrict__ wq, const float* __restrict__ keys, const float* __restrict__ nw, bf16_t* __restrict__ Wpq, LAS unsigned char* lds, int item) {
    LAS float* kl = (LAS float*)lds;
    LAS float* wl = (LAS float*)(lds + 128 * 132 * 4);
    const int tid = opaque_tid();
    const int hh2 = item >> 4, slab = item & 15, half = hh2 & 1, k0 = slab * 64;
    {
        f32x4 kv[8], wv[4];
#pragma unroll
        for (int it = 0; it < 8; ++it) { const int i = tid + NT * it, key = i & 127, d4 = i >> 7; kv[it] = *(const f32x4*)(keys + (size_t)half * 16384 + key * 128 + d4 * 4); }
#pragma unroll
        for (int it = 0; it < 4; ++it) { const int i = tid + NT * it, kk = i & 63, d4 = i >> 6; wv[it] = *(const f32x4*)(wq + (size_t)(k0 + kk) * 2048 + hh2 * 128 + d4 * 4); }
#pragma unroll
        for (int it = 0; it < 8; ++it) { const int i = tid + NT * it, key = i & 127, d4 = i >> 7;
#pragma unroll
            for (int j = 0; j < 4; ++j) kl[(4 * d4 + j) * 132 + key] = kv[it][j]; }
#pragma unroll
        for (int it = 0; it < 4; ++it) { const int i = tid + NT * it, kk = i & 63, d4 = i >> 6;
#pragma unroll
            for (int j = 0; j < 4; ++j) wl[(4 * d4 + j) * 68 + kk] = wv[it][j]; }
    }
    __syncthreads();
    const int kq = tid & 31, kg = tid >> 5;
    f32x4 acc[4];
#pragma unroll
    for (int i = 0; i < 4; ++i) acc[i] = (f32x4){0.f, 0.f, 0.f, 0.f};
#pragma unroll 8
    for (int d = 0; d < 128; ++d) {
        const f32x4 kv = *(const LAS f32x4*)(kl + d * 132 + 4 * kq), wv = *(const LAS f32x4*)(wl + d * 68 + 4 * kg);
#pragma unroll
        for (int i = 0; i < 4; ++i) acc[i] += kv * wv[i];
    }
    const int kb = k0 + 4 * kg;
    const f32x4 nv = *(const f32x4*)(nw + kb);
#pragma unroll
    for (int j = 0; j < 4; ++j)
        *(u32x2*)(Wpq + (size_t)(hh2 * 128 + 4 * kq + j) * 1024 + kb) = (u32x2){pk2(acc[0][j] * nv[0], acc[1][j] * nv[1]), pk2(acc[2][j] * nv[2], acc[3][j] * nv[3])};
    __syncthreads();
}
__device__ __forceinline__ void rms_row_to_bf16(const float* xrow, bf16_t* orow, int lane) {
    const f32x4* xr = (const f32x4*)xrow + lane;
    f32x4 v[4]; float s = 0.f;
#pragma unroll
    for (int j = 0; j < 4; ++j) { v[j] = xr[64 * j]; s += (v[j].x * v[j].x + v[j].y * v[j].y) + (v[j].z * v[j].z + v[j].w * v[j].w); }
    const float rstd = 1.f / sqrtf(wave_sum(s) * (1.f / DM) + EPS);
    u32x2* o8 = (u32x2*)orow + lane;
#pragma unroll
    for (int j = 0; j < 4; ++j) o8[64 * j] = (u32x2){pk2(v[j].x * rstd, v[j].y * rstd), pk2(v[j].z * rstd, v[j].w * rstd)};
}
template <int NR>
__device__ __forceinline__ void rms_rows_to_bf16(const float* x, bf16_t* o, int m0, int mstride, int lane) {
    f32x4 v[NR][4];
#pragma unroll
    for (int r = 0; r < NR; ++r) { const f32x4* xr = (const f32x4*)(x + (size_t)(m0 + r * mstride) * DM) + lane;
#pragma unroll
        for (int j = 0; j < 4; ++j) v[r][j] = xr[64 * j]; }
#pragma unroll
    for (int r = 0; r < NR; ++r) { float s = 0.f;
#pragma unroll
        for (int j = 0; j < 4; ++j) s += (v[r][j].x * v[r][j].x + v[r][j].y * v[r][j].y) + (v[r][j].z * v[r][j].z + v[r][j].w * v[r][j].w);
        const float rstd = 1.f / sqrtf(wave_sum_fast(s) * (1.f / DM) + EPS);
        u32x2* o8 = (u32x2*)(o + (size_t)(m0 + r * mstride) * DM) + lane;
#pragma unroll
        for (int j = 0; j < 4; ++j) o8[64 * j] = (u32x2){pk2(v[r][j].x * rstd, v[r][j].y * rstd), pk2(v[r][j].z * rstd, v[r][j].w * rstd)}; }
}
__device__ __forceinline__ void p0_prologue(const Args& a, LAS unsigned char* lds) {
    unsigned char* ws = KWS();
    const int gtid = opaque_bx() * NT + opaque_tid(), gn = gridDim.x * NT;
    {
        const int tid0 = opaque_tid(); const int wave0 = tid0 >> 6, lane0 = tid0 & 63;
        LAS float* scr = (LAS float*)lds + wave0 * (64 * 33);
        constexpr int C0 = 16 * (IN_PAD / 32), C1 = C0 + 6 * 48, C2 = C1 + 4 * 32, C3 = C2 + 4 * 32, C4 = C3 + 16 * 32, C5 = C4 + 16 * 32, C6 = C5 + 16 * 32;
        for (int it = opaque_bx() * NW + wave0; it < C6; it += gridDim.x * NW) {
            if (it < C0) transpose_tile(KIN(3), 1024, 5312, (bf16_t*)(ws + WS_WIN), KIN(2), 1.f, MapIn(), scr, it, lane0);
            else if (it < C1) transpose_tile(KIN(13), 384, 1536, (bf16_t*)(ws + WS_WQB), KIN(12), QSCALE, MapQ(), scr, it - C0, lane0);
            else if (it < C2) transpose_tile(KIN(15), 256, 2048, (bf16_t*)(ws + WS_WK), KIN(14), 1.f, MapKn(), scr, it - C1, lane0);
            else if (it < C3) transpose_tile(KIN(15), 256, 2048, (bf16_t*)(ws + WS_WV), KIN(14), 1.f, MapV(), scr, it - C2, lane0);
            else if (it < C4) transpose_tile(KIN(16), 1024, 1024, (bf16_t*)(ws + WS_PA), KIN(11), 1.f, MapId(), scr, it - C3, lane0);
            else if (it < C5) transpose_tile(KIN(17), 1024, 1024, (bf16_t*)(ws + WS_PB), (const float*)nullptr, 1.f, MapId(), scr, it - C4, lane0);
            else transpose_tile(KIN(18), 1024, 1024, (bf16_t*)(ws + WS_WOUT), (const float*)nullptr, 1.f, MapId(), scr, it - C5, lane0);
        }
        __syncthreads();
    }
    for (int it = opaque_bx(); it < 256; it += gridDim.x) p0_wpq_item(KIN(20), KIN(21), KIN(19), (bf16_t*)(ws + WS_WPQ), lds, it);
    const int tid_ = opaque_tid(); const int wave = tid_ >> 6, lane = tid_ & 63;
    const int gw = opaque_bx() * NW + wave, ngw = gridDim.x * NW;
    for (int m = gw; m < TOK; m += 4 * ngw) rms_rows_to_bf16<4>(KIN(0), (bf16_t*)(ws + WS_XN), m, ngw, lane);
}

struct EpiInProj {
    bf16_t *Z, *XBC, *G, *QA, *KVA;
    __device__ __forceinline__ void operator()(const f32x4 (&acc)[2][2][4][2], const pg8::Unit& u, int wr, int wc, int fr, int fq) const {
        const int pn = u.pn; bf16_t* base; int ldc, cb, act;
        if (pn < 4) { base = Z; ldc = 1024; cb = pn * 256; act = 1; }
        else if (pn < 10) { base = XBC; ldc = 1536; cb = (pn - 4) * 256; act = 0; }
        else if (pn < 18) { base = G; ldc = 2048; cb = (pn - 10) * 256; act = 2; }
        else if (pn < 20) { base = QA; ldc = 512; cb = (pn - 18) * 256; act = 0; }
        else { base = KVA; ldc = 256; cb = 0; act = 0; }
        pg8::foreach8(acc, u, wr, wc, fr, fq, [&](int row, int col, f32x4 v0, f32x4 v1) {
            const int c = cb + (col - pn * 256);
            if (act == 1) {
#pragma unroll
                for (int j = 0; j < 4; ++j) { v0[j] = siluf_(v0[j]); v1[j] = siluf_(v1[j]); }
            } else if (act == 2) {
                unsigned q[8];
#pragma unroll
                for (int j = 0; j < 4; ++j) { q[j] = (unsigned)(sigmoidf_(v0[j]) * 255.f + 0.5f); q[4 + j] = (unsigned)(sigmoidf_(v1[j]) * 255.f + 0.5f); }
                *(u32x2*)((unsigned char*)base + (size_t)row * 2048 + c) = (u32x2){q[0] | (q[1] << 8) | (q[2] << 16) | (q[3] << 24), q[4] | (q[5] << 8) | (q[6] << 16) | (q[7] << 24)};
                return;
            }
            *(u32x4*)(base + (size_t)row * ldc + c) = (u32x4){pk2(v0[0], v0[1]), pk2(v0[2], v0[3]), pk2(v1[0], v1[1]), pk2(v1[2], v1[3])};
        });
    }
};
constexpr int CONV_ITEMS = (TOK / 64) * 6;
struct ConvRaw { u32x4 v[5]; };
__device__ __forceinline__ void p2_conv_load(const bf16_t* __restrict__ XBC, int item, int tid, ConvRaw& R) {
    const int slab = item / 6, grp = item % 6, t0 = slab * 64, b = t0 / SEQ, s0 = t0 % SEQ, c0 = grp * 256;
#pragma unroll
    for (int i = 0; i < 5; ++i) { const int ci = tid + NT * i, r = ci >> 5, ch = ci & 31, tok = s0 - 1 + r;
        R.v[i] = (u32x4){0u, 0u, 0u, 0u};
        if (ci < 66 * 32 && tok >= 0 && tok < SEQ) R.v[i] = *(const u32x4*)(XBC + (size_t)(b * SEQ + tok) * 1536 + c0 + ch * 8); }
}
__device__ __forceinline__ void p2_conv_item(const ConvRaw& R, const float* __restrict__ conv_w, const float* __restrict__ conv_b,
                                             bf16_t* __restrict__ XS, bf16_t* __restrict__ XST, bf16_t* __restrict__ BC, bf16_t* __restrict__ BT, LAS unsigned char* lds, int item, int tid) {
    const int slab = item / 6, grp = item % 6, t0 = slab * 64, b = t0 / SEQ, s0 = t0 % SEQ, c0 = grp * 256;
    LAS unsigned char* rawl = lds;
    LAS unsigned char* outl = lds + 66 * 528;
#pragma unroll
    for (int i = 0; i < 5; ++i) { const int ci = tid + NT * i, r = ci >> 5, ch = ci & 31; if (ci < 66 * 32) *(LAS u32x4*)(rawl + r * 528 + ch * 16) = R.v[i]; }
    __syncthreads();
    {
        const int ch = tid & 31, tk = tid >> 5;
        float w0[8], w1[8], w2[8], bb[8];
#pragma unroll
        for (int j = 0; j < 8; ++j) { const int c = c0 + ch * 8 + j; w0[j] = conv_w[c]; w1[j] = conv_w[1536 + c]; w2[j] = conv_w[3072 + c]; bb[j] = conv_b[c]; }
#pragma unroll
        for (int i = 0; i < 4; ++i) {
            const int tt = tk + 16 * i;
            const u32x4 xa = *(const LAS u32x4*)(rawl + tt * 528 + ch * 16), xb = *(const LAS u32x4*)(rawl + (tt + 1) * 528 + ch * 16), xc = *(const LAS u32x4*)(rawl + (tt + 2) * 528 + ch * 16);
            float y[8];
#pragma unroll
            for (int q = 0; q < 4; ++q) {
                y[2 * q] = bb[2 * q] + w0[2 * q] * bflo(xa[q]) + w1[2 * q] * bflo(xb[q]) + w2[2 * q] * bflo(xc[q]);
                y[2 * q + 1] = bb[2 * q + 1] + w0[2 * q + 1] * bfhi(xa[q]) + w1[2 * q + 1] * bfhi(xb[q]) + w2[2 * q + 1] * bfhi(xc[q]);
            }
#pragma unroll
            for (int j = 0; j < 8; ++j) y[j] = siluf_(y[j]);
            const u32x4 o = (u32x4){pk2(y[0], y[1]), pk2(y[2], y[3]), pk2(y[4], y[5]), pk2(y[6], y[7])};
            if (grp >= 4) *(u32x4*)(BC + (size_t)(t0 + tt) * 512 + (grp - 4) * 256 + ch * 8) = o;
            *(LAS u32x4*)(outl + tt * 528 + ch * 16) = o;
        }
    }
    __syncthreads();
    if (grp < 5) {
        bf16_t* dstT = (grp < 4) ? XST + ((size_t)b * 1024 + c0) * SEQ : BT + (size_t)b * 256 * SEQ;
#pragma unroll
        for (int i = 0; i < 4; ++i) {
            const int idx = tid + NT * i, tch = idx & 7, c = idx >> 3;
            unsigned short v[8];
#pragma unroll
            for (int j = 0; j < 8; ++j) v[j] = *(const LAS unsigned short*)(outl + (tch * 8 + j) * 528 + c * 2);
            const u32x4 o = (u32x4){(unsigned)v[0] | ((unsigned)v[1] << 16), (unsigned)v[2] | ((unsigned)v[3] << 16), (unsigned)v[4] | ((unsigned)v[5] << 16), (unsigned)v[6] | ((unsigned)v[7] << 16)};
            *(u32x4*)(dstT + (size_t)c * SEQ + s0 + tch * 8) = o;
        }
    }
    __syncthreads();
}
__device__ __forceinline__ float softplusf_(float x) { return fmaxf(x, 0.f) + log1pf(__expf(-fabsf(x))); }
__device__ __forceinline__ void p2_dt_item(const Args& a, int item, int lane) {
    unsigned char* ws = KWS();
    const bf16_t* QA = (const bf16_t*)(ws + WS_QA);
    const int hh = item & 15, bc = item >> 4, b = bc >> 5, c = bc & 31;
    const int t0 = b * SEQ + c * CHUNK, s = 2 * lane;
    const float bf = KIN(6)[hh], bbw = KIN(7)[hh], Af = -__expf(KIN(8)[hh]), Ab = -__expf(KIN(9)[hh]);
    const float dtf0 = softplusf_(bf1(QA[(size_t)(t0 + s) * 512 + 384 + hh]) + bf), dtf1 = softplusf_(bf1(QA[(size_t)(t0 + s + 1) * 512 + 384 + hh]) + bf);
    const float dtb0 = softplusf_(bf1(QA[(size_t)(t0 + s) * 512 + 400 + hh]) + bbw), dtb1 = softplusf_(bf1(QA[(size_t)(t0 + s + 1) * 512 + 400 + hh]) + bbw);
    const float af0 = dtf0 * Af, af1 = dtf1 * Af, ab0 = dtb0 * Ab, ab1 = dtb1 * Ab;
    float sf = af0 + af1, sb = ab0 + ab1;
#pragma unroll
    for (int o = 1; o < 64; o <<= 1) { const float uf = __shfl_up(sf, o), ub = __shfl_up(sb, o); if (lane >= o) { sf += uf; sb += ub; } }
    const float totb = __shfl(sb, 63);
    const float pref = sf - (af0 + af1), preb = sb - (ab0 + ab1);
    const size_t idx = ((size_t)(b * 16 + hh)) * SEQ + c * CHUNK + s;
    *(f32x2*)((float*)(ws + WS_ACSF) + idx) = (f32x2){pref + af0, pref + af0 + af1};
    *(f32x2*)((float*)(ws + WS_DTF) + idx) = (f32x2){dtf0, dtf1};
    *(f32x2*)((float*)(ws + WS_RACSB) + idx) = (f32x2){totb - preb, totb - preb - ab0};
    *(f32x2*)((float*)(ws + WS_DTB) + idx) = (f32x2){dtb0, dtb1};
}
template <int NTK>
__device__ __forceinline__ void p2_tok_items(const Args& a, int t0, int tstride, int lane) {
    unsigned char* ws = KWS();
    const bf16_t* QA = (const bf16_t*)(ws + WS_QA); const bf16_t* KVA = (const bf16_t*)(ws + WS_KVA);
    u32x4 qv[NTK], kv[NTK]; float pos[NTK], x1[NTK], x2[NTK];
#pragma unroll
    for (int k = 0; k < NTK; ++k) {
        const int t = t0 + k * tstride;
        qv[k] = (u32x4){0u, 0u, 0u, 0u}; kv[k] = (u32x4){0u, 0u, 0u, 0u}; pos[k] = 0.f; x1[k] = 0.f; x2[k] = 0.f;
        if (lane < 48) qv[k] = *(const u32x4*)(QA + (size_t)t * 512 + lane * 8);
        if (lane < 32) kv[k] = *(const u32x4*)(KVA + (size_t)t * 256 + lane * 8);
        if (lane < 16) { pos[k] = (float)((const int*)KIN(1))[t]; x1[k] = bf1(QA[(size_t)t * 512 + 416 + lane]); x2[k] = bf1(QA[(size_t)t * 512 + 432 + lane]); }
    }
#pragma unroll
    for (int k = 0; k < NTK; ++k) {
        const int t = t0 + k * tstride;
        float sq = 0.f, sk = 0.f;
#pragma unroll
        for (int q = 0; q < 4; ++q) { const float x = bflo(qv[k][q]), y = bfhi(qv[k][q]); sq += x * x + y * y; const float z = bflo(kv[k][q]), w = bfhi(kv[k][q]); sk += z * z + w * w; }
        sq = wave_sum_fast(sq); sk = wave_sum_fast(sk);
        if (lane == 0) { ((float*)(ws + WS_RQ))[t] = 1.f / sqrtf(sq * (1.f / 384.f) + EPS); ((float*)(ws + WS_RKV))[t] = 1.f / sqrtf(sk * (1.f / 256.f) + EPS); }
        if (lane < 16) {
            const int i = lane;
            const float inv = exp2f(-(float)i * (13.287712379549449f / 16.f));
            const float ang = pos[k] * inv;
            const float kk = rintf(ang * 0.15915494309189535f);
            float r = fmaf(-kk, 6.28318548202514648f, ang); r = fmaf(-kk, -1.7484555e-7f, r);
            const float sn = __sinf(r), cs = __cosf(r);
            ((unsigned*)(ws + WS_KR))[(size_t)t * 16 + i] = pk2(x1[k] * cs - x2[k] * sn, x1[k] * sn + x2[k] * cs);
            ((float*)(ws + WS_COS))[(size_t)t * 16 + i] = cs; ((float*)(ws + WS_SIN))[(size_t)t * 16 + i] = sn;
        }
    }
}
__device__ __forceinline__ void p2_prep(const Args& a, LAS unsigned char* lds) {
    unsigned char* ws = KWS();
    const int tid_ = opaque_tid(); const int wave = tid_ >> 6, lane = tid_ & 63;
    {
        const bf16_t* XBC = (const bf16_t*)(ws + WS_XBC); const int G = gridDim.x;
        int it = opaque_bx();
        ConvRaw Ra, Rb;
        if (it < CONV_ITEMS) p2_conv_load(XBC, it, tid_, Ra);
        for (; it < CONV_ITEMS; it += 2 * G) {
            if (it + G < CONV_ITEMS) p2_conv_load(XBC, it + G, tid_, Rb);
            p2_conv_item(Ra, KIN(4), KIN(5), (bf16_t*)KOUT(), (bf16_t*)KOUT() + (size_t)TOK * 1024, (bf16_t*)(ws + WS_BC), (bf16_t*)(ws + WS_BT), lds, it, tid_);
            if (it + G < CONV_ITEMS) {
                if (it + 2 * G < CONV_ITEMS) p2_conv_load(XBC, it + 2 * G, tid_, Ra);
                p2_conv_item(Rb, KIN(4), KIN(5), (bf16_t*)KOUT(), (bf16_t*)KOUT() + (size_t)TOK * 1024, (bf16_t*)(ws + WS_BC), (bf16_t*)(ws + WS_BT), lds, it + G, tid_);
            }
        }
    }
    const int gw = opaque_bx() * NW + wave, ngw = gridDim.x * NW;
    for (int it = gw; it < BATCH * NCHUNK * 16; it += ngw) p2_dt_item(a, it, lane);
    for (int t = gw; t < TOK; t += 4 * ngw) p2_tok_items<4>(a, t, ngw, lane);
}

__device__ __forceinline__ bf16x8 ld8(const bf16_t* p) { return *(const bf16x8*)p; }
__device__ __forceinline__ bf16x8 scale8(bf16x8 v, const float (&w)[8]) {
    const u32x4 u = __builtin_bit_cast(u32x4, v); u32x4 o;
#pragma unroll
    for (int q = 0; q < 4; ++q) o[q] = pk2(bflo(u[q]) * w[2 * q], bfhi(u[q]) * w[2 * q + 1]);
    return __builtin_bit_cast(bf16x8, o);
}
__device__ __forceinline__ bf16x8 scale8a(bf16x8 v, const float (&w)[8], const float (&ad)[8]) {
    const u32x4 u = __builtin_bit_cast(u32x4, v); u32x4 o;
#pragma unroll
    for (int q = 0; q < 4; ++q) o[q] = pk2(bflo(u[q]) * w[2 * q] + ad[2 * q], bfhi(u[q]) * w[2 * q + 1] + ad[2 * q + 1]);
    return __builtin_bit_cast(bf16x8, o);
}
__device__ __forceinline__ bf16x8 scale8s(bf16x8 v, float w) {
    const u32x4 u = __builtin_bit_cast(u32x4, v); u32x4 o;
#pragma unroll
    for (int q = 0; q < 4; ++q) o[q] = pk2(bflo(u[q]) * w, bfhi(u[q]) * w);
    return __builtin_bit_cast(bf16x8, o);
}
#define MFMA32(a, b, c) __builtin_amdgcn_mfma_f32_32x32x16_bf16((a), (b), (c), 0, 0, 0)

__device__ __forceinline__ void p3_states_unit(const Args& a, LAS unsigned char* lds, int unit) {
    unsigned char* ws = KWS();
    const int tid_ = opaque_tid(); const int lane = tid_ & 63, wave = tid_ >> 6, r32 = lane & 31, hi = lane >> 5;
    const int g = unit & 1, bc = unit >> 1, b = bc >> 5, c = bc & 31, hh = g * 8 + wave;
    const bf16_t* XST = (const bf16_t*)KOUT() + (size_t)TOK * 1024;
    const bf16_t* BT = (const bf16_t*)(ws + WS_BT);
    const size_t hbase = (size_t)(b * 16 + hh) * SEQ + c * CHUNK;
    LAS float* wl = (LAS float*)(lds + wave * 1024);
    {
        const float* ACSF = (const float*)(ws + WS_ACSF) + hbase; const float* DTF = (const float*)(ws + WS_DTF) + hbase;
        const float* RACSB = (const float*)(ws + WS_RACSB) + hbase; const float* DTB = (const float*)(ws + WS_DTB) + hbase;
        const float cendf = ACSF[CHUNK - 1], cendb = RACSB[0];
        const f32x2 cf = *(const f32x2*)(ACSF + 2 * lane), df = *(const f32x2*)(DTF + 2 * lane), cb = *(const f32x2*)(RACSB + 2 * lane), db = *(const f32x2*)(DTB + 2 * lane);
        *(LAS f32x2*)(wl + 2 * lane) = (f32x2){df.x * __expf(cendf - cf.x), df.y * __expf(cendf - cf.y)};
        *(LAS f32x2*)(wl + 128 + 2 * lane) = (f32x2){db.x * __expf(cendb - cb.x), db.y * __expf(cendb - cb.y)};
    }
    const bf16_t* xrow0 = XST + ((size_t)b * 1024 + hh * 64 + r32) * SEQ + c * CHUNK + 8 * hi;
    const bf16_t* brow0 = BT + ((size_t)b * 256 + g * 128 + r32) * SEQ + c * CHUNK + 8 * hi;
    bf16x8 xf[2][8];
#pragma unroll
    for (int pb = 0; pb < 2; ++pb)
#pragma unroll
        for (int ks = 0; ks < 8; ++ks) xf[pb][ks] = ld8(xrow0 + (size_t)(32 * pb) * SEQ + 16 * ks);
    asm volatile("s_waitcnt lgkmcnt(0)" ::: "memory");
#pragma unroll 1
    for (int nh = 0; nh < 2; ++nh) {
        bf16x8 bfr[2][8];
#pragma unroll
        for (int nb = 0; nb < 2; ++nb)
#pragma unroll
            for (int ks = 0; ks < 8; ++ks) bfr[nb][ks] = ld8(brow0 + (size_t)(32 * (2 * nh + nb)) * SEQ + 16 * ks);
#pragma unroll 1
        for (int dir = 0; dir < 2; ++dir) {
            f32x16 acc[2][2];
#pragma unroll
            for (int i = 0; i < 2; ++i)
#pragma unroll
                for (int j = 0; j < 2; ++j) acc[i][j] = f32x16{};
#pragma unroll
            for (int ks = 0; ks < 8; ++ks) {
                const f32x4 w0 = *(const volatile LAS f32x4*)(wl + dir * 128 + 16 * ks + 8 * hi), w1 = *(const volatile LAS f32x4*)(wl + dir * 128 + 16 * ks + 8 * hi + 4);
                const float w[8] = {w0[0], w0[1], w0[2], w0[3], w1[0], w1[1], w1[2], w1[3]};
#pragma unroll
                for (int pb = 0; pb < 2; ++pb) { u32x4 xr = __builtin_bit_cast(u32x4, xf[pb][ks]); asm volatile("" : "+v"(xr));
                    const bf16x8 xs = scale8(__builtin_bit_cast(bf16x8, xr), w);
#pragma unroll
                    for (int nb = 0; nb < 2; ++nb) acc[nb][pb] = MFMA32(bfr[nb][ks], xs, acc[nb][pb]); }
                __builtin_amdgcn_sched_barrier(0);
            }
            bf16_t* STo = (bf16_t*)(ws + WS_ST) + ((((size_t)(dir * BATCH + b) * NCHUNK + c) * 16 + hh) * 64 + r32) * 128 + 64 * nh + 4 * hi;
#pragma unroll
            for (int nb = 0; nb < 2; ++nb)
#pragma unroll
                for (int pb = 0; pb < 2; ++pb)
#pragma unroll
                    for (int q = 0; q < 4; ++q) {
                        const f32x16& v = acc[nb][pb];
                        *(u32x2*)(STo + (size_t)(32 * pb) * 128 + 32 * nb + 8 * q) = (u32x2){pk2(v[4 * q], v[4 * q + 1]), pk2(v[4 * q + 2], v[4 * q + 3])};
                    }
            __builtin_amdgcn_sched_barrier(0);
        }
    }
}
constexpr int P34_XT = 8192, P34_XROW = 272, P34_XDIR = 32 * P34_XROW, P34_XBUF = 2 * P34_XDIR;
constexpr int P34_BT = P34_XT + 2 * P34_XBUF, P34_BDIR = 128 * P34_XROW;
__device__ __forceinline__ void p34_chain(const Args& a, LAS unsigned char* lds, int unit) {
    unsigned char* ws = KWS();
    const int tid_ = opaque_tid(); const int lane = tid_ & 63, wave = tid_ >> 6, r32 = lane & 31, hi = lane >> 5;
    const int pb = unit & 1, bh = unit >> 1, b = bh >> 4, hh = bh & 15, g = hh >> 3;
    const int dir = wave >> 2, nbq = wave & 3;
    const float* CS = (const float*)(ws + (dir ? WS_RACSB : WS_ACSF)) + (size_t)(b * 16 + hh) * SEQ;
    const float* DT = (const float*)(ws + (dir ? WS_DTB : WS_DTF)) + (size_t)(b * 16 + hh) * SEQ;
    const int cendo = dir ? 0 : CHUNK - 1;
    bf16_t* STo = (bf16_t*)(ws + WS_ST) + ((((size_t)(dir * BATCH + b) * NCHUNK) * 16 + hh) * 64 + 32 * pb + r32) * 128 + 32 * nbq + 4 * hi;
    LAS float* wl = (LAS float*)(lds + wave * 1024);
    const int srow = tid_ >> 4, spc = tid_ & 15;
    const bf16_t* xg = (const bf16_t*)KOUT() + (size_t)TOK * 1024 + ((size_t)b * 1024 + hh * 64 + 32 * pb + srow) * SEQ + spc * 8;
    const bf16_t* bg = (const bf16_t*)(ws + WS_BT) + ((size_t)b * 256 + g * 128 + srow) * SEQ + spc * 8;
    const int sl = srow * P34_XROW + spc * 16;
    const int xfo = P34_XT + dir * P34_XDIR + r32 * P34_XROW + hi * 16, bfo = P34_BT + dir * P34_BDIR + (32 * nbq + r32) * P34_XROW + hi * 16;
    f32x16 P = f32x16{};
    const int c0 = dir ? NCHUNK - 1 : 0, cstep = dir ? -1 : 1;
    u32x4 sb0[8], sb1[8], sx0[2], sx1[2]; f32x2 cs0, dt0, cs1, dt1; float ce0, ce1;
#define P34_LOAD(SB, SX, CSv, DTv, CEv, idx) do { const int cf_ = (idx) * CHUNK, cb_ = (NCHUNK - 1 - (idx)) * CHUNK; \
        _Pragma("unroll") for (int k = 0; k < 4; ++k) { SB[k] = *(const u32x4*)(bg + (size_t)(32 * k) * SEQ + cf_); SB[4 + k] = *(const u32x4*)(bg + (size_t)(32 * k) * SEQ + cb_); } \
        SX[0] = *(const u32x4*)(xg + cf_); SX[1] = *(const u32x4*)(xg + cb_); \
        { const int t0_ = (c0 + (idx) * cstep) * CHUNK; CSv = *(const f32x2*)(CS + t0_ + 2 * lane); DTv = *(const f32x2*)(DT + t0_ + 2 * lane); CEv = CS[t0_ + cendo]; } } while (0)
#define P34_PUT(SB, SX, idx) do { \
        _Pragma("unroll") for (int k = 0; k < 4; ++k) { *(LAS u32x4*)(lds + P34_BT + sl + 32 * k * P34_XROW) = SB[k]; *(LAS u32x4*)(lds + P34_BT + P34_BDIR + sl + 32 * k * P34_XROW) = SB[4 + k]; } \
        LAS unsigned char* xb_ = lds + P34_XT + ((idx) & 1) * P34_XBUF + sl; *(LAS u32x4*)xb_ = SX[0]; *(LAS u32x4*)(xb_ + P34_XDIR) = SX[1]; } while (0)
#define P34_STEP(SB, SX, CSv, DTv, CEv, CSc, DTc, CEc, idx) do { \
        *(LAS f32x2*)(wl + 2 * lane) = (f32x2){DTc.x * __expf(CEc - CSc.x), DTc.y * __expf(CEc - CSc.y)}; \
        bf16x8 xf[8], bfr[8]; \
        _Pragma("unroll") for (int ks = 0; ks < 8; ++ks) { xf[ks] = *(const LAS bf16x8*)(lds + xfo + ((idx) & 1) * P34_XBUF + 32 * ks); bfr[ks] = *(const LAS bf16x8*)(lds + bfo + 32 * ks); } \
        const float dk = __expf(CEc); \
        asm volatile("s_waitcnt lgkmcnt(0)" ::: "memory"); \
        __syncthreads(); \
        if ((idx) + 1 < NCHUNK) P34_PUT(SB, SX, (idx) + 1); \
        if ((idx) + 3 < NCHUNK) P34_LOAD(SB, SX, CSv, DTv, CEv, (idx) + 3); \
        f32x16 acc = f32x16{}; \
        _Pragma("unroll") for (int ks = 0; ks < 8; ++ks) { \
            const f32x4 w0 = *(const volatile LAS f32x4*)(wl + 16 * ks + 8 * hi), w1 = *(const volatile LAS f32x4*)(wl + 16 * ks + 8 * hi + 4); \
            const float w[8] = {w0[0], w0[1], w0[2], w0[3], w1[0], w1[1], w1[2], w1[3]}; \
            acc = MFMA32(bfr[ks], scale8(xf[ks], w), acc); } \
        bf16_t* so = STo + (size_t)(c0 + (idx) * cstep) * 16 * 8192; \
        _Pragma("unroll") for (int q = 0; q < 4; ++q) *(u32x2*)(so + 8 * q) = (u32x2){pk2(P[4 * q], P[4 * q + 1]), pk2(P[4 * q + 2], P[4 * q + 3])}; \
        _Pragma("unroll") for (int r = 0; r < 16; ++r) P[r] = P[r] * dk + acc[r]; \
        asm volatile("s_waitcnt lgkmcnt(0)" ::: "memory"); \
        __syncthreads(); } while (0)
    P34_LOAD(sb0, sx0, cs0, dt0, ce0, 0); P34_LOAD(sb1, sx1, cs1, dt1, ce1, 1);
    __syncthreads();
    P34_PUT(sb0, sx0, 0);
    f32x2 csc = cs0, dtc = dt0; float cec = ce0;
    P34_LOAD(sb0, sx0, cs0, dt0, ce0, 2);
    asm volatile("s_waitcnt lgkmcnt(0)" ::: "memory");
    __syncthreads();
#pragma unroll 1
    for (int i = 0; i < NCHUNK; i += 2) {
        { const f32x2 csn = cs1, dtn = dt1; const float cen = ce1;
          P34_STEP(sb1, sx1, cs1, dt1, ce1, csc, dtc, cec, i);
          csc = csn; dtc = dtn; cec = cen; }
        { const f32x2 csn = cs0, dtn = dt0; const float cen = ce0;
          P34_STEP(sb0, sx0, cs0, dt0, ce0, csc, dtc, cec, i + 1);
          csc = csn; dtc = dtn; cec = cen; }
    }
#undef P34_STEP
#undef P34_PUT
#undef P34_LOAD
}
__device__ __forceinline__ void p4_scan(const Args& a) {
    unsigned char* ws = KWS();
    const int gtid = opaque_bx() * NT + opaque_tid(), gn = gridDim.x * NT;
    for (int it = gtid; it < 2 * BATCH * 16 * 1024; it += gn) {
        const int e8 = it & 1023, hh = (it >> 10) & 15, b = (it >> 14) & 7, dir = it >> 17;
        const float* CS = (const float*)(ws + (dir ? WS_RACSB : WS_ACSF)) + (size_t)(b * 16 + hh) * SEQ + (dir ? 0 : CHUNK - 1);
        bf16_t* base = (bf16_t*)(ws + WS_ST) + (((size_t)(dir * BATCH + b) * NCHUNK) * 16 + hh) * 8192 + e8 * 8;
        const long cstep = dir ? -(long)16 * 8192 : (long)16 * 8192; const int dstep = dir ? -CHUNK : CHUNK;
        bf16_t* p = base + (dir ? (size_t)(NCHUNK - 1) * 16 * 8192 : 0); const float* cp = CS + (dir ? (NCHUNK - 1) * CHUNK : 0);
        float prev[8];
#pragma unroll
        for (int j = 0; j < 8; ++j) prev[j] = 0.f;
#pragma unroll 1
        for (int c0 = 0; c0 < NCHUNK; c0 += 8) {
            u32x4 sv[8]; float dec[8];
#pragma unroll
            for (int k = 0; k < 8; ++k) { sv[k] = *(const u32x4*)(p + k * cstep); dec[k] = cp[k * dstep]; }
#pragma unroll
            for (int k = 0; k < 8; ++k) {
                *(u32x4*)(p + k * cstep) = (u32x4){pk2(prev[0], prev[1]), pk2(prev[2], prev[3]), pk2(prev[4], prev[5]), pk2(prev[6], prev[7])};
                const float dk = __expf(dec[k]);
#pragma unroll
                for (int q = 0; q < 4; ++q) { prev[2 * q] = prev[2 * q] * dk + bflo(sv[k][q]); prev[2 * q + 1] = prev[2 * q + 1] * dk + bfhi(sv[k][q]); }
            }
            p += 8 * cstep; cp += 8 * dstep;
        }
    }
}
constexpr int P5_G = 0, P5_B = 128 * 272, P5_C = 2 * 128 * 272, P5_ARR = 3 * 128 * 272, P5_RED = P5_ARR + 8 * 2048, P5_END = P5_RED + 64 * 8 * 4;
__device__ __forceinline__ bf16x8 opaque8(bf16x8 v) { u32x4 r = __builtin_bit_cast(u32x4, v); asm volatile("" : "+v"(r)); return __builtin_bit_cast(bf16x8, r); }
__device__ __forceinline__ void p5_out_unit(const Args& a, LAS unsigned char* lds, int unit) {
    unsigned char* ws = KWS();
    const int tid = opaque_tid(); const int lane = tid & 63, wave = tid >> 6, r32 = lane & 31, hi = lane >> 5;
    const int g = unit & 1, bc = unit >> 1, b = bc >> 5, c = bc & 31, hh = g * 8 + wave;
    const int t0 = b * SEQ + c * CHUNK;
    const bf16_t* XS = (const bf16_t*)KOUT(); const bf16_t* XST = XS + (size_t)TOK * 1024;
    const bf16_t* BC = (const bf16_t*)(ws + WS_BC);
    bf16_t* ZY = (bf16_t*)(ws + WS_Z);
    const size_t hbase = (size_t)(b * 16 + hh) * SEQ + c * CHUNK;
    LAS float* arr = (LAS float*)(lds + P5_ARR + wave * 2048);
    LAS float* red = (LAS float*)(lds + P5_RED);
    {
        u32x4 tb[4], tc[4];
#pragma unroll
        for (int i = 0; i < 4; ++i) { const int ci = tid + NT * i, r = ci >> 4, ch = ci & 15;
            tb[i] = *(const u32x4*)(BC + (size_t)(t0 + r) * 512 + g * 128 + ch * 8); tc[i] = *(const u32x4*)(BC + (size_t)(t0 + r) * 512 + 256 + g * 128 + ch * 8); }
        const float* src[4] = {(const float*)(ws + WS_ACSF) + hbase, (const float*)(ws + WS_RACSB) + hbase, (const float*)(ws + WS_DTF) + hbase, (const float*)(ws + WS_DTB) + hbase};
        f32x2 av[4];
#pragma unroll
        for (int k = 0; k < 4; ++k) av[k] = *(const f32x2*)(src[k] + 2 * lane);
#pragma unroll
        for (int i = 0; i < 4; ++i) { const int ci = tid + NT * i, r = ci >> 4, ch = ci & 15;
            *(LAS u32x4*)(lds + P5_B + r * 272 + ch * 16) = tb[i]; *(LAS u32x4*)(lds + P5_C + r * 272 + ch * 16) = tc[i]; }
#pragma unroll
        for (int k = 0; k < 4; ++k) { arr[k * 128 + 2 * lane] = av[k].x; arr[k * 128 + 2 * lane + 1] = av[k].y; }
    }
    __syncthreads();
    {
        const int lb = wave >> 1;
        LAS unsigned char* crow = lds + P5_C + (32 * lb + r32) * 272 + 16 * hi;
#pragma unroll
        for (int sbi = 0; sbi < 2; ++sbi) {
            const int sb = 2 * (wave & 1) + sbi;
            LAS unsigned char* brow = lds + P5_B + (32 * sb + r32) * 272 + 16 * hi;
            f32x16 acc = f32x16{};
#pragma unroll
            for (int ks = 0; ks < 8; ++ks) acc = MFMA32(*(const LAS bf16x8*)(brow + 32 * ks), *(const LAS bf16x8*)(crow + 32 * ks), acc);
#pragma unroll
            for (int q = 0; q < 4; ++q)
                *(LAS u32x2*)(lds + P5_G + (32 * lb + r32) * 272 + (32 * sb + 8 * q + 4 * hi) * 2) = (u32x2){pk2(acc[4 * q], acc[4 * q + 1]), pk2(acc[4 * q + 2], acc[4 * q + 3])};
        }
    }
    __syncthreads();
    const float dsk = KIN(10)[hh];
    const bf16_t* xrow0 = XST + ((size_t)b * 1024 + hh * 64 + r32) * SEQ + c * CHUNK + 8 * hi;
#pragma unroll 1
    for (int lh = 0; lh < 2; ++lh) {
        f32x16 acc[2][2];
#pragma unroll
        for (int i = 0; i < 2; ++i)
#pragma unroll
            for (int j = 0; j < 2; ++j) acc[i][j] = f32x16{};
#pragma unroll 1
        for (int kh = 0; kh < 2; ++kh) {
            bf16x8 xf[2][4];
            int kho = kh * 64; asm volatile("" : "+s"(kho));
            const bf16_t* xr = xrow0 + kho;
#pragma unroll
            for (int pb = 0; pb < 2; ++pb)
#pragma unroll
                for (int k4 = 0; k4 < 4; ++k4) xf[pb][k4] = ld8(xr + (size_t)(32 * pb) * SEQ + 16 * k4);
#pragma unroll
            for (int lb2 = 0; lb2 < 2; ++lb2) {
                const int l = 64 * lh + 32 * lb2 + r32;
                const float afl = arr[l], rbl = arr[128 + l];
#pragma unroll
                for (int k4 = 0; k4 < 4; ++k4) {
                    const int s8 = kho + 16 * k4 + 8 * hi;
                    const bf16x8 gv = *(const LAS bf16x8*)(lds + P5_G + l * 272 + s8 * 2);
                    float w[8]; bf16x8 mf;
                    const int sblk = kho + 16 * k4, lblk = 64 * lh + 32 * lb2;
                    if (sblk + 16 <= lblk) {
#pragma unroll
                        for (int j = 0; j < 8; ++j) w[j] = __expf(afl - arr[s8 + j]) * arr[256 + s8 + j];
                        mf = scale8(gv, w);
                    } else if (sblk >= lblk + 32) {
#pragma unroll
                        for (int j = 0; j < 8; ++j) w[j] = __expf(rbl - arr[128 + s8 + j]) * arr[384 + s8 + j];
                        mf = scale8(gv, w);
                    } else {
                        float ad[8];
#pragma unroll
                        for (int j = 0; j < 8; ++j) {
                            const int s = s8 + j;
                            const float afs = arr[s], rbs = arr[128 + s], dfs = arr[256 + s], dbs = arr[384 + s];
                            const bool fw = s < l;
                            const float e = __expf(fminf(fw ? (afl - afs) : (rbl - rbs), 0.f)) * (fw ? dfs : dbs);
                            w[j] = (s == l) ? (dfs + dbs) : e; ad[j] = (s == l) ? dsk : 0.f;
                        }
                        mf = scale8a(gv, w, ad);
                    }
#pragma unroll
                    for (int pb = 0; pb < 2; ++pb) acc[pb][lb2] = MFMA32(opaque8(xf[pb][k4]), mf, acc[pb][lb2]);
                    __builtin_amdgcn_sched_barrier(0);
                }
            }
        }
#pragma unroll 1
        for (int dir = 0; dir < 2; ++dir) {
            f32x16 tacc[2][2];
#pragma unroll
            for (int i = 0; i < 2; ++i)
#pragma unroll
                for (int j = 0; j < 2; ++j) tacc[i][j] = f32x16{};
            int diro = dir; asm volatile("" : "+s"(diro));
            const bf16_t* sp = (const bf16_t*)(ws + WS_ST) + ((((size_t)(diro * BATCH + b) * NCHUNK + c) * 16 + hh) * 64 + r32) * 128 + 8 * hi;
            bf16x8 pf[2][8];
#pragma unroll
            for (int pb = 0; pb < 2; ++pb)
#pragma unroll
                for (int ks = 0; ks < 8; ++ks) pf[pb][ks] = ld8(sp + (size_t)(32 * pb) * 128 + 16 * ks);
#pragma unroll
            for (int ks = 0; ks < 8; ++ks) {
#pragma unroll
                for (int lb2 = 0; lb2 < 2; ++lb2) {
                    const int l = 64 * lh + 32 * lb2 + r32;
                    const bf16x8 cv = *(const LAS bf16x8*)(lds + P5_C + l * 272 + (16 * ks + 8 * hi) * 2);
#pragma unroll
                    for (int pb = 0; pb < 2; ++pb) tacc[pb][lb2] = MFMA32(pf[pb][ks], cv, tacc[pb][lb2]);
                }
            }
#pragma unroll
            for (int lb2 = 0; lb2 < 2; ++lb2) {
                const int l = 64 * lh + 32 * lb2 + r32;
                const float e = __expf(arr[(dir ? 128 : 0) + l]);
#pragma unroll
                for (int pb = 0; pb < 2; ++pb)
#pragma unroll
                    for (int r = 0; r < 16; ++r) acc[pb][lb2][r] += e * tacc[pb][lb2][r];
            }
        }
        float ssq[2] = {0.f, 0.f};
#pragma unroll
        for (int lb2 = 0; lb2 < 2; ++lb2) {
            const int t = t0 + 64 * lh + 32 * lb2 + r32;
#pragma unroll
            for (int pb = 0; pb < 2; ++pb)
#pragma unroll
                for (int q = 0; q < 4; ++q) {
                    const int ch = hh * 64 + 32 * pb + 8 * q + 4 * hi;
                    const u32x2 zv = *(const u32x2*)(ZY + (size_t)t * 1024 + ch);
                    f32x16& v = acc[pb][lb2];
                    v[4 * q] *= bflo(zv.x); v[4 * q + 1] *= bfhi(zv.x); v[4 * q + 2] *= bflo(zv.y); v[4 * q + 3] *= bfhi(zv.y);
                    ssq[lb2] += (v[4 * q] * v[4 * q] + v[4 * q + 1] * v[4 * q + 1]) + (v[4 * q + 2] * v[4 * q + 2] + v[4 * q + 3] * v[4 * q + 3]);
                }
        }
#pragma unroll
        for (int lb2 = 0; lb2 < 2; ++lb2) { ssq[lb2] += __shfl_xor(ssq[lb2], 32); if (hi == 0) red[(32 * lb2 + r32) * 8 + wave] = ssq[lb2]; }
        __syncthreads();
#pragma unroll
        for (int lb2 = 0; lb2 < 2; ++lb2) {
            const f32x4 r0 = *(const LAS f32x4*)(red + (32 * lb2 + r32) * 8), r1 = *(const LAS f32x4*)(red + (32 * lb2 + r32) * 8 + 4);
            const float tot = ((r0.x + r0.y) + (r0.z + r0.w)) + ((r1.x + r1.y) + (r1.z + r1.w));
            const float rstd = 1.f / sqrtf(tot * (1.f / 512.f) + EPS);
            const int t = t0 + 64 * lh + 32 * lb2 + r32;
#pragma unroll
            for (int pb = 0; pb < 2; ++pb)
#pragma unroll
                for (int q = 0; q < 4; ++q) {
                    const int ch = hh * 64 + 32 * pb + 8 * q + 4 * hi; const f32x16& v = acc[pb][lb2];
                    *(u32x2*)(ZY + (size_t)t * 1024 + ch) = (u32x2){pk2(v[4 * q] * rstd, v[4 * q + 1] * rstd), pk2(v[4 * q + 2] * rstd, v[4 * q + 3] * rstd)};
                }
        }
        __syncthreads();
    }
}
#define PK8(v0, v1) (u32x4){pk2((v0)[0], (v0)[1]), pk2((v0)[2], (v0)[3]), pk2((v1)[0], (v1)[1]), pk2((v1)[2], (v1)[3])}
struct DQ { float rs; f32x4 cs, sn; };
struct EpiQ {
    bf16_t* __restrict__ Q; const float* __restrict__ RQ; const float* __restrict__ COS; const float* __restrict__ SIN;
    __device__ __forceinline__ void operator()(const f32x4 (&acc)[2][2][4][2], const pg8::Unit& u, int wr, int wc, int fr, int fq) const {
        pg8::foreach8_batched<4, DQ>(acc, u, wr, wc, fr, fq,
            [&](int row, int col) { DQ d; d.rs = RQ[row]; const int dd = col % 96; const int i0 = (dd >= 64) ? ((dd - 64) >> 1) : 0;
                d.cs = *(const f32x4*)(COS + (size_t)row * 16 + i0); d.sn = *(const f32x4*)(SIN + (size_t)row * 16 + i0); return d; },
            [&](int row, int col, f32x4 v0, f32x4 v1, const DQ& d) {
                v0 = v0 * d.rs; v1 = v1 * d.rs;
                if (col % 96 >= 64) { const f32x4 cs = d.cs, sn = d.sn; const f32x4 a0 = v0, a1 = v1;
                    v0[0] = a0[0] * cs[0] - a0[1] * sn[0]; v0[1] = a0[0] * sn[0] + a0[1] * cs[0]; v0[2] = a0[2] * cs[1] - a0[3] * sn[1]; v0[3] = a0[2] * sn[1] + a0[3] * cs[1];
                    v1[0] = a1[0] * cs[2] - a1[1] * sn[2]; v1[1] = a1[0] * sn[2] + a1[1] * cs[2]; v1[2] = a1[2] * cs[3] - a1[3] * sn[3]; v1[3] = a1[2] * sn[3] + a1[3] * cs[3]; }
                *(u32x4*)(Q + (size_t)row * QW + col) = PK8(v0, v1); });
    }
};
struct DR { float rs; };
struct EpiK {
    bf16_t* __restrict__ K; const float* __restrict__ RKV;
    __device__ __forceinline__ void operator()(const f32x4 (&acc)[2][2][4][2], const pg8::Unit& u, int wr, int wc, int fr, int fq) const {
        pg8::foreach8_batched<4, DR>(acc, u, wr, wc, fr, fq,
            [&](int row, int col) { DR d; d.rs = RKV[row]; return d; },
            [&](int row, int col, f32x4 v0, f32x4 v1, const DR& d) { v0 = v0 * d.rs; v1 = v1 * d.rs;
                *(u32x4*)(K + (size_t)row * KW + col) = PK8(v0, v1); });
    }
};
struct EpiVT {
    bf16_t* VT; const float* RKV;
    __device__ __forceinline__ void operator()(const f32x4 (&acc)[2][2][4][2], const pg8::Unit& u, int wr, int wc, int fr, int fq) const {
        pg8::foreach8(acc, u, wr, wc, fr, fq, [&](int row, int col, f32x4 v0, f32x4 v1) {
            const f32x4 r0 = *(const f32x4*)(RKV + col), r1 = *(const f32x4*)(RKV + col + 4); v0 = v0 * r0; v1 = v1 * r1;
            const int m16 = col & ~15, g = (col >> 3) & 1;
            *(u32x2*)(VT + (size_t)row * TOK + m16 + 4 * g) = (u32x2){pk2(v0[0], v0[1]), pk2(v0[2], v0[3])};
            *(u32x2*)(VT + (size_t)row * TOK + m16 + 8 + 4 * g) = (u32x2){pk2(v1[0], v1[1]), pk2(v1[2], v1[3])};
        });
    }
};
constexpr int AT_KS = 208, AT_VS = 144;
constexpr int AT_KB = 64 * AT_KS, AT_VB = 64 * AT_VS;
constexpr int AT_K0 = 0, AT_V0 = 2 * AT_KB, AT_WS = AT_V0 + 2 * AT_VB, AT_END = AT_WS + 8 * 256;
constexpr float AT_THR = 8.f;
__device__ __forceinline__ unsigned cvtpk(float lo, float hi) { f32x2 v = {lo, hi}; bf16x2_t b = __builtin_convertvector(v, bf16x2_t); return __builtin_bit_cast(unsigned, b); }
#define MX3(a, b, c) __builtin_fmaxf(__builtin_fmaxf((a), (b)), (c))
__device__ __forceinline__ void p7_attn_unit(const Args& a, LAS unsigned char* lds, int b, int h, int qb) {
    unsigned char* ws = KWS();
    const int tid = opaque_tid(), lane = tid & 63, wave = tid >> 6, r32 = lane & 31, hi = lane >> 5;
    const bf16_t* Q = (const bf16_t*)KOUT(); const bf16_t* K = (const bf16_t*)(ws + WS_K); const bf16_t* VT = (const bf16_t*)(ws + WS_VT);
    bf16_t* YM = (bf16_t*)(ws + WS_YM);
    const int q0 = qb * 256 + wave * 32;
    bf16x8 qf[6];
    { const bf16_t* qp = Q + (size_t)(b * SEQ + q0 + r32) * QW + h * 96 + 8 * hi;
#pragma unroll
      for (int st = 0; st < 6; ++st) qf[st] = ld8(qp + 16 * st); }
    const int kr0 = tid / 12, kc0 = tid % 12, kr1 = (512 + tid) / 12, kc1 = (512 + tid) % 12;
    const int vd = tid >> 3, vc = tid & 7;
    const bf16_t* KRp = (const bf16_t*)(ws + WS_KR);
    const unsigned ks0 = kc0 < 8 ? KW : 32, ks1 = kc1 < 8 ? KW : 32;
    const bf16_t* kg0 = kc0 < 8 ? K + (size_t)(b * SEQ + kr0) * KW + h * 64 + kc0 * 8 : KRp + (size_t)(b * SEQ + kr0) * 32 + (kc0 - 8) * 8;
    const bf16_t* kg1 = kc1 < 8 ? K + (size_t)(b * SEQ + kr1) * KW + h * 64 + kc1 * 8 : KRp + (size_t)(b * SEQ + kr1) * 32 + (kc1 - 8) * 8;
    const bf16_t* vg = VT + (size_t)(h * 64 + vd) * TOK + b * SEQ + vc * 8;
    const int kl0 = kr0 * AT_KS + kc0 * 16, kl1 = kr1 * AT_KS + kc1 * 16, vl = vd * AT_VS + vc * 16;
    LAS float* wsf = (LAS float*)(lds + AT_WS + wave * 256);
    u32x4 skA0, skA1 = (u32x4){0u, 0u, 0u, 0u}, svA, skB0, skB1 = (u32x4){0u, 0u, 0u, 0u}, svB;
    skA0 = *(const u32x4*)kg0; if (tid < 256) skA1 = *(const u32x4*)kg1; svA = *(const u32x4*)vg;
    { skB0 = *(const u32x4*)(kg0 + 64u * ks0); if (tid < 256) skB1 = *(const u32x4*)(kg1 + 64u * ks1); svB = *(const u32x4*)(vg + 64); }
    __syncthreads();
    *(LAS u32x4*)(lds + AT_K0 + kl0) = skA0; if (tid < 256) *(LAS u32x4*)(lds + AT_K0 + kl1) = skA1; *(LAS u32x4*)(lds + AT_V0 + vl) = svA;
    __syncthreads();
    f32x16 o0 = f32x16{}, o1 = f32x16{};
    float mref = 0.f, lrun = 0.f;
    f32x16 negm;
#pragma unroll
    for (int r = 0; r < 16; ++r) negm[r] = 0.f;
    constexpr int NTILE = SEQ / 64;
    const int koff = r32 * AT_KS + hi * 16, voff = r32 * AT_VS + hi * 16;
#define AT_BODY(t, RK0, RK1, RV, WK0, WK1, WV) do { \
        const int buf = (t) & 1; \
        if ((t) + 2 < NTILE) { const unsigned kt_ = (unsigned)((t) + 2) * 64u; RK0 = *(const u32x4*)(kg0 + kt_ * ks0); if (tid < 256) RK1 = *(const u32x4*)(kg1 + kt_ * ks1); RV = *(const u32x4*)(vg + ((t) + 2) * 64); } \
        LAS unsigned char* kb = lds + AT_K0 + buf * AT_KB + koff; LAS unsigned char* vb = lds + AT_V0 + buf * AT_VB + voff; \
        f32x16 p0 = negm, p1 = negm; \
        { bf16x8 kf0[6], kf1[6]; \
          _Pragma("unroll") for (int st = 0; st < 6; ++st) { kf0[st] = *(const LAS bf16x8*)(kb + st * 32); kf1[st] = *(const LAS bf16x8*)(kb + 32 * AT_KS + st * 32); } \
          __builtin_amdgcn_sched_barrier(0); \
          __builtin_amdgcn_s_setprio(1); \
          _Pragma("unroll") for (int st = 0; st < 6; ++st) { p0 = MFMA32(kf0[st], qf[st], p0); p1 = MFMA32(kf1[st], qf[st], p1); } \
          __builtin_amdgcn_s_setprio(0); \
          __builtin_amdgcn_sched_barrier(0); } \
        bf16x8 va[2][2], vb2[2][2]; \
        _Pragma("unroll") for (int kbk = 0; kbk < 2; ++kbk) \
            _Pragma("unroll") for (int s = 0; s < 2; ++s) { const int off = (32 * kbk + 16 * s) * 2; \
                va[kbk][s] = *(const LAS bf16x8*)(vb + off); vb2[kbk][s] = *(const LAS bf16x8*)(vb + 32 * AT_VS + off); } \
        __builtin_amdgcn_sched_barrier(0); \
        float ma = MX3(p0[0], p0[1], p1[0]), mb = MX3(p0[2], p0[3], p1[1]); ma = MX3(ma, p1[2], p1[3]); \
        _Pragma("unroll") for (int r = 4; r < 16; r += 4) { ma = MX3(ma, p0[r], p0[r + 1]); mb = MX3(mb, p0[r + 2], p0[r + 3]); ma = MX3(ma, p1[r], p1[r + 1]); mb = MX3(mb, p1[r + 2], p1[r + 3]); } \
        float mx = fmaxf(ma, mb); \
        { SWAP_PAIR(__builtin_amdgcn_permlane32_swap, mx, x0, x1); mx = fmaxf(__builtin_bit_cast(float, x0), __builtin_bit_cast(float, x1)); } \
        if ((t) == 0 || __any(mx > AT_THR)) { \
            const float dl = ((t) == 0) ? mx : fmaxf(mx, 0.f); mref += dl; \
            const float f = ((t) == 0) ? 1.f : __builtin_amdgcn_exp2f(-dl); lrun *= f; \
            _Pragma("unroll") for (int r = 0; r < 16; ++r) { p0[r] -= dl; p1[r] -= dl; negm[r] = -mref; } \
            if (hi == 0) wsf[r32] = f; \
            asm volatile("s_waitcnt lgkmcnt(0)" ::: "memory"); \
            _Pragma("unroll") for (int q = 0; q < 4; ++q) { const f32x4 al = *(const volatile LAS f32x4*)(wsf + 8 * q + 4 * hi); \
                _Pragma("unroll") for (int i = 0; i < 4; ++i) { o0[4 * q + i] *= al[i]; o1[4 * q + i] *= al[i]; } } \
        } \
        float ls = 0.f; \
        _Pragma("unroll") for (int r = 0; r < 16; ++r) { p0[r] = __builtin_amdgcn_exp2f(p0[r]); p1[r] = __builtin_amdgcn_exp2f(p1[r]); ls += p0[r] + p1[r]; } \
        lrun += ls; \
        bf16x8 pf[2][2]; \
        pf[0][0] = __builtin_bit_cast(bf16x8, (u32x4){cvtpk(p0[0], p0[1]), cvtpk(p0[2], p0[3]), cvtpk(p0[4], p0[5]), cvtpk(p0[6], p0[7])}); \
        pf[0][1] = __builtin_bit_cast(bf16x8, (u32x4){cvtpk(p0[8], p0[9]), cvtpk(p0[10], p0[11]), cvtpk(p0[12], p0[13]), cvtpk(p0[14], p0[15])}); \
        pf[1][0] = __builtin_bit_cast(bf16x8, (u32x4){cvtpk(p1[0], p1[1]), cvtpk(p1[2], p1[3]), cvtpk(p1[4], p1[5]), cvtpk(p1[6], p1[7])}); \
        pf[1][1] = __builtin_bit_cast(bf16x8, (u32x4){cvtpk(p1[8], p1[9]), cvtpk(p1[10], p1[11]), cvtpk(p1[12], p1[13]), cvtpk(p1[14], p1[15])}); \
        __builtin_amdgcn_sched_barrier(0); \
        __builtin_amdgcn_s_setprio(1); \
        _Pragma("unroll") for (int kbk = 0; kbk < 2; ++kbk) \
            _Pragma("unroll") for (int s = 0; s < 2; ++s) { \
                o0 = MFMA32(pf[kbk][s], va[kbk][s], o0); \
                o1 = MFMA32(pf[kbk][s], vb2[kbk][s], o1); } \
        __builtin_amdgcn_s_setprio(0); \
        __builtin_amdgcn_sched_barrier(0); \
        if ((t) + 1 < NTILE) { LAS unsigned char* kn = lds + AT_K0 + (buf ^ 1) * AT_KB; LAS unsigned char* vn = lds + AT_V0 + (buf ^ 1) * AT_VB; \
            *(LAS u32x4*)(kn + kl0) = WK0; if (tid < 256) *(LAS u32x4*)(kn + kl1) = WK1; *(LAS u32x4*)(vn + vl) = WV; } \
        __syncthreads(); } while (0)
#pragma unroll 1
    for (int t = 0; t < NTILE; t += 2) {
        AT_BODY(t, skA0, skA1, svA, skB0, skB1, svB);
        AT_BODY(t + 1, skB0, skB1, svB, skA0, skA1, svA);
    }
#undef AT_BODY
    { SWAP_PAIR(__builtin_amdgcn_permlane32_swap, lrun, x0, x1); lrun = __builtin_bit_cast(float, x0) + __builtin_bit_cast(float, x1); }
    if (hi == 0) wsf[32 + r32] = 1.f / lrun;
    asm volatile("s_waitcnt lgkmcnt(0)" ::: "memory");
#pragma unroll
    for (int q = 0; q < 4; ++q) { const f32x4 il = *(const volatile LAS f32x4*)(wsf + 32 + 8 * q + 4 * hi);
#pragma unroll
        for (int i = 0; i < 4; ++i) { const int row = q0 + 8 * q + 4 * hi + i; bf16_t* yp = YM + (size_t)(b * SEQ + row) * 1024 + h * 64 + r32;
            yp[0] = (bf16_t)f2bf(o0[4 * q + i] * il[i]); yp[32] = (bf16_t)f2bf(o1[4 * q + i] * il[i]); } }
}
__device__ __forceinline__ void p7_attention(const Args& a, LAS unsigned char* lds) {
    const int G = gridDim.x, bx = opaque_bx();
    const int vcu = (G % 8 == 0) ? (bx % 8) * (G / 8) + bx / 8 : bx;
    for (int u = vcu; u < BATCH * 16 * 16; u += G) {
        const int qb = u & 15, bh = u >> 4;
        p7_attn_unit(a, lds, bh >> 4, bh & 15, qb);
    }
}

struct DG { u32x2 g; };
struct DGM { u32x2 g; u32x4 m; };
#define GATE8(gv, g) float g[8]; { const float c_ = 1.f / 255.f; g[0] = (float)((gv.x >> 0) & 0xffu) * c_; g[1] = (float)((gv.x >> 8) & 0xffu) * c_; g[2] = (float)((gv.x >> 16) & 0xffu) * c_; g[3] = (float)((gv.x >> 24) & 0xffu) * c_; \
    g[4] = (float)((gv.y >> 0) & 0xffu) * c_; g[5] = (float)((gv.y >> 8) & 0xffu) * c_; g[6] = (float)((gv.y >> 16) & 0xffu) * c_; g[7] = (float)((gv.y >> 24) & 0xffu) * c_; }
struct EpiMerge1 {
    bf16_t* __restrict__ M; const unsigned char* __restrict__ G;
    __device__ __forceinline__ void operator()(const f32x4 (&acc)[2][2][4][2], const pg8::Unit& u, int wr, int wc, int fr, int fq) const {
        pg8::foreach8_batched<4, DG>(acc, u, wr, wc, fr, fq,
            [&](int row, int col) { DG d; d.g = *(const u32x2*)(G + (size_t)row * 2048 + col); return d; },
            [&](int row, int col, f32x4 v0, f32x4 v1, const DG& d) { const u32x2 gv = d.g; GATE8(gv, g);
#pragma unroll
                for (int j = 0; j < 4; ++j) { v0[j] *= g[j]; v1[j] *= g[4 + j]; }
                *(u32x4*)(M + (size_t)row * 1024 + col) = PK8(v0, v1); });
    }
};
struct EpiMerge2 {
    bf16_t* M; const unsigned char* G;
    __device__ __forceinline__ void operator()(const f32x4 (&acc)[2][2][4][2], const pg8::Unit& u, int wr, int wc, int fr, int fq) const {
        pg8::foreach8_batched<4, DGM>(acc, u, wr, wc, fr, fq,
            [&](int row, int col) { DGM d; d.g = *(const u32x2*)(G + (size_t)row * 2048 + 1024 + col); d.m = *(const u32x4*)(M + (size_t)row * 1024 + col); return d; },
            [&](int row, int col, f32x4 v0, f32x4 v1, const DGM& d) { const u32x2 gv = d.g; const u32x4 mv = d.m; GATE8(gv, g);
                v0[0] = bflo(mv.x) + v0[0] * g[0]; v0[1] = bfhi(mv.x) + v0[1] * g[1]; v0[2] = bflo(mv.y) + v0[2] * g[2]; v0[3] = bfhi(mv.y) + v0[3] * g[3];
                v1[0] = bflo(mv.z) + v1[0] * g[4]; v1[1] = bfhi(mv.z) + v1[1] * g[5]; v1[2] = bflo(mv.w) + v1[2] * g[6]; v1[3] = bfhi(mv.w) + v1[3] * g[7];
                *(u32x4*)(M + (size_t)row * 1024 + col) = PK8(v0, v1); });
    }
};
struct DX { f32x4 x0, x1; };
struct EpiOut {
    const float* __restrict__ X; bf16_t* __restrict__ HB; float* __restrict__ SSQ;
    __device__ __forceinline__ void operator()(const f32x4 (&acc)[2][2][4][2], const pg8::Unit& u, int wr, int wc, int fr, int fq) const {
#pragma unroll
        for (int ai = 0; ai < 2; ++ai)
#pragma unroll
            for (int m0 = 0; m0 < 4; m0 += 2) {
                DX d[2][2];
#pragma unroll
                for (int mm = 0; mm < 2; ++mm) { const int row = u.pm * 256 + ai * 128 + wr * 64 + (m0 + mm) * 16 + fr;
#pragma unroll
                    for (int bj = 0; bj < 2; ++bj) { const int col = u.pn * 256 + bj * 128 + wc * 32 + 8 * fq;
                        d[mm][bj].x0 = *(const f32x4*)(X + (size_t)row * 1024 + col); d[mm][bj].x1 = *(const f32x4*)(X + (size_t)row * 1024 + col + 4); } }
#pragma unroll
                for (int mm = 0; mm < 2; ++mm) { const int m = m0 + mm; const int row = u.pm * 256 + ai * 128 + wr * 64 + m * 16 + fr; float s = 0.f;
#pragma unroll
                    for (int bj = 0; bj < 2; ++bj) { const int col = u.pn * 256 + bj * 128 + wc * 32 + 8 * fq;
                        const f32x4 v0 = acc[ai][bj][m][0] + d[mm][bj].x0, v1 = acc[ai][bj][m][1] + d[mm][bj].x1;
                        *(u32x4*)(HB + (size_t)row * 1024 + col) = PK8(v0, v1);
                        s += (v0[0] * v0[0] + v0[1] * v0[1]) + (v0[2] * v0[2] + v0[3] * v0[3]) + (v1[0] * v1[0] + v1[1] * v1[1]) + (v1[2] * v1[2] + v1[3] * v1[3]); }
                    s += __shfl_xor(s, 16); s += __shfl_xor(s, 32);
                    if (fq == 0) SSQ[(size_t)row * 16 + u.pn * 4 + wc] = s; }
                asm volatile("" ::: "memory");
            }
    }
};
struct EpiScore {
    float* __restrict__ SC; const float* __restrict__ SSQ;
    __device__ __forceinline__ void operator()(const f32x4 (&acc)[2][2][4][2], const pg8::Unit& u, int wr, int wc, int fr, int fq) const {
        float rs[2][4];
#pragma unroll
        for (int ai = 0; ai < 2; ++ai)
#pragma unroll
            for (int m = 0; m < 4; ++m) {
                const int row = u.pm * 256 + ai * 128 + wr * 64 + m * 16 + fr;
                const f32x4* sp = (const f32x4*)(SSQ + (size_t)row * 16);
                const f32x4 s0 = sp[0], s1 = sp[1], s2 = sp[2], s3 = sp[3];
                const float tot = (((s0[0] + s0[1]) + (s0[2] + s0[3])) + ((s1[0] + s1[1]) + (s1[2] + s1[3]))) + (((s2[0] + s2[1]) + (s2[2] + s2[3])) + ((s3[0] + s3[1]) + (s3[2] + s3[3])));
                rs[ai][m] = 1.f / sqrtf(tot * (1.f / 1024.f) + EPS);
            }
#pragma unroll
        for (int ai = 0; ai < 2; ++ai)
#pragma unroll
            for (int m = 0; m < 4; ++m) {
                const int row = u.pm * 256 + ai * 128 + wr * 64 + m * 16 + fr;
#pragma unroll
                for (int bj = 0; bj < 2; ++bj) {
                    const int col = u.pn * 256 + bj * 128 + wc * 32 + 8 * fq;
                    const f32x4 a0 = acc[ai][bj][m][0] * rs[ai][m], a1 = acc[ai][bj][m][1] * rs[ai][m];
                    unsigned w[4];
#pragma unroll
                    for (int i = 0; i < 2; ++i) {
                        w[i] = (unsigned)__builtin_bit_cast(unsigned short, (_Float16)a0[2 * i]) | ((unsigned)__builtin_bit_cast(unsigned short, (_Float16)a0[2 * i + 1]) << 16);
                        w[2 + i] = (unsigned)__builtin_bit_cast(unsigned short, (_Float16)a1[2 * i]) | ((unsigned)__builtin_bit_cast(unsigned short, (_Float16)a1[2 * i + 1]) << 16); }
                    *(u32x4*)((unsigned short*)SC + (size_t)row * 2048 + col) = (u32x4){w[0], w[1], w[2], w[3]};
                }
            }
    }
};
__device__ __forceinline__ unsigned pack_fp8x4(float a, float b, float c, float d) {
    int p = __builtin_amdgcn_cvt_pk_fp8_f32(a, b, 0, false); p = __builtin_amdgcn_cvt_pk_fp8_f32(c, d, p, true); return (unsigned)p;
}
__device__ __forceinline__ unsigned pack_i8x4(float a, float b, float c, float d) {
    const int qa = (int)__builtin_rintf(a), qb = (int)__builtin_rintf(b), qc = (int)__builtin_rintf(c), qd = (int)__builtin_rintf(d);
    return ((unsigned)qa & 0xffu) | (((unsigned)qb & 0xffu) << 8) | (((unsigned)qc & 0xffu) << 16) | ((unsigned)qd << 24);
}
__device__ __forceinline__ void p9_peer_tables(const Args& a, int rbeg, int rend, int blk, int nblk) {
    unsigned char* ws = KWS();
    const int tid_ = opaque_tid(); const int wave = tid_ >> 6, lane = tid_ & 63;
    const int gw = blk * NW + wave, ngw = nblk * NW;
    const f32x4* NWv = (const f32x4*)KIN(19) + 4 * lane;
    const f32x4 n0 = NWv[0], n1 = NWv[1], n2 = NWv[2], n3 = NWv[3];
    constexpr int RB = 4;
    for (int r0 = rbeg + gw * RB; r0 < rend; r0 += ngw * RB) {
        f32x4 v[RB][4];
#pragma unroll
        for (int k = 0; k < RB; ++k) { const int r = r0 + k; const bool isv = r >= 16384; const int row = isv ? r - 16384 : r;
            const f32x4* src = (const f32x4*)(isv ? KIN(23) : KIN(22)) + (size_t)row * 256 + 4 * lane;
#pragma unroll
            for (int q = 0; q < 4; ++q) v[k][q] = __builtin_nontemporal_load(src + q); }
#pragma unroll
        for (int k = 0; k < RB; ++k) { const int r = r0 + k; const bool isv = r >= 16384; const int row = isv ? r - 16384 : r;
            f32x4 v0 = v[k][0], v1 = v[k][1], v2 = v[k][2], v3 = v[k][3];
            if (!isv) { v0 = v0 * n0; v1 = v1 * n1; v2 = v2 * n2; v3 = v3 * n3; }
            float m = 0.f;
#pragma unroll
            for (int j = 0; j < 4; ++j) m = fmaxf(m, fmaxf(fmaxf(fabsf(v0[j]), fabsf(v1[j])), fmaxf(fabsf(v2[j]), fabsf(v3[j]))));
            m = fmaxf(wave_max(m), 1e-30f);
            const float sc = 127.f / m;
            v0 = v0 * sc; v1 = v1 * sc; v2 = v2 * sc; v3 = v3 * sc;
            const u32x4 o = (u32x4){pack_i8x4(v0[0], v0[1], v0[2], v0[3]), pack_i8x4(v1[0], v1[1], v1[2], v1[3]), pack_i8x4(v2[0], v2[1], v2[2], v2[3]), pack_i8x4(v3[0], v3[1], v3[2], v3[3])};
            *(u32x4*)(ws + (isv ? WS_PV : WS_PU) + (size_t)row * 1024 + 16 * lane) = o;
            if (lane == 0) ((float*)(ws + (isv ? WS_PVS : WS_PUS)))[row] = m * (1.f / 127.f);
        }
    }
}
typedef unsigned int gu32_t;
#define XB_TMO      128
#define XB_XCNT(j)  (256  + 64 * (j))
#define XB_XSUB(j)  (1280 + 64 * (j))
#define XB_XGEN(j)  (2304 + 64 * (j))
#define XB_TOP      3328
#define XB_TOPGEN   3392
#define XCD_BAR_WORDS 3456
#define XB_SPIN_CAP (1u << 18)

__device__ __forceinline__ unsigned xb_ld(unsigned* p)              { return __hip_atomic_load(p, __ATOMIC_RELAXED, __HIP_MEMORY_SCOPE_AGENT); }
__device__ __forceinline__ unsigned xb_add(unsigned* p, unsigned v) { return __hip_atomic_fetch_add(p, v, __ATOMIC_RELAXED, __HIP_MEMORY_SCOPE_AGENT); }
__device__ __forceinline__ unsigned xb_xcc_id() { return (unsigned)__builtin_amdgcn_s_getreg((3 << 11) | 20) & 0xFu; }
#define XB_SPIN(cond, bar) do { unsigned _sp = 0; while (cond) { __builtin_amdgcn_s_sleep(1); \
    if ((++_sp & 255u) == 0u) { if (xb_ld(&(bar)[XB_TMO])) break; if (_sp > XB_SPIN_CAP) { atomicAdd(&(bar)[XB_TMO], 1u); break; } } } } while (0)

struct XcdBarrier {
    unsigned* bar; unsigned x;
    volatile LAS unsigned* st;
};

__device__ __forceinline__ XcdBarrier xcd_barrier_post(unsigned* bar, volatile LAS unsigned* st) {
    XcdBarrier b; b.bar = bar; b.x = xb_xcc_id(); b.st = st;
    if (threadIdx.x == 0) (void)xb_add(&bar[XB_XCNT(b.x)], 1u);
    return b;
}
__device__ __forceinline__ void xcd_barrier_complete(unsigned* bar, unsigned x, unsigned& nloc, unsigned& nx) {
    const unsigned G = gridDim.x * gridDim.y * gridDim.z;
    unsigned sum, cnt, mine, sp = 0u;
    for (;;) {
        sum = 0u; cnt = 0u; mine = 0u;
#pragma unroll
        for (unsigned j = 0; j < 16; ++j) { const unsigned c = xb_ld(&bar[XB_XCNT(j)]); sum += c; cnt += (c > 0u) ? 1u : 0u; mine = (j == x) ? c : mine; }
        if (sum == G) break;
        __builtin_amdgcn_s_sleep(1);
        if ((++sp & 255u) == 0u) { if (xb_ld(&bar[XB_TMO])) break; if (sp > XB_SPIN_CAP) { atomicAdd(&bar[XB_TMO], 1u); break; } }
    }
    nloc = mine > 0u ? mine : 1u; nx = cnt > 0u ? cnt : 1u;
}

__device__ __forceinline__ void xcd_barrier(const XcdBarrier& b) {
    asm volatile("s_waitcnt vmcnt(0)" ::: "memory");
    __syncthreads();
    if (threadIdx.x == 0) {
        unsigned* bar = b.bar;
        __builtin_amdgcn_s_waitcnt(0);
        unsigned nloc = b.st[0], nx = b.st[1];
        if (nloc == 0u) { xcd_barrier_complete(bar, b.x, nloc, nx); b.st[0] = nloc; b.st[1] = nx; }
        const unsigned old = xb_add(&bar[XB_XSUB(b.x)], 1u);
        const unsigned gen = old / nloc;
        if (old + 1u == (gen + 1u) * nloc) {
            __builtin_amdgcn_fence(__ATOMIC_RELEASE, "agent");
            asm volatile("s_waitcnt vmcnt(0)" ::: "memory");
            const unsigned og = xb_add(&bar[XB_TOP], 1u);
            const unsigned tg = og / nx;
            if (og + 1u == (tg + 1u) * nx) xb_add(&bar[XB_TOPGEN], 1u);
            else XB_SPIN(xb_ld(&bar[XB_TOPGEN]) == tg, bar);
            __builtin_amdgcn_fence(__ATOMIC_ACQUIRE, "agent");
            xb_add(&bar[XB_XGEN(b.x)], 1u);
            asm volatile("s_waitcnt vmcnt(0)" ::: "memory");
        } else {
            XB_SPIN(xb_ld(&bar[XB_XGEN(b.x)]) == gen, bar);
            __builtin_amdgcn_fence(__ATOMIC_ACQUIRE, "agent");
            asm volatile("s_waitcnt vmcnt(0)" ::: "memory");
        }
    }
    __syncthreads();
}

__device__ __forceinline__ float xor4f(float x) {
    int t = __builtin_amdgcn_update_dpp(0, __builtin_bit_cast(int, x), 0x104, 0xF, 0x5, false);
    t = __builtin_amdgcn_update_dpp(t, __builtin_bit_cast(int, x), 0x114, 0xF, 0xA, false);
    return __builtin_bit_cast(float, t);
}
__device__ __forceinline__ unsigned okey(unsigned b) { return b ^ ((unsigned)((int)b >> 31) | 0x80000000u); }
__device__ __forceinline__ unsigned okey_inv(unsigned u) { return (u & 0x80000000u) ? (u ^ 0x80000000u) : ~u; }
__device__ __forceinline__ unsigned umax_(unsigned a, unsigned b) { return a > b ? a : b; }
__device__ __forceinline__ unsigned umin_(unsigned a, unsigned b) { return a < b ? a : b; }
template <int CTRL> __device__ __forceinline__ unsigned dppu(unsigned x) { return (unsigned)__builtin_amdgcn_update_dpp(0, (int)x, CTRL, 0xF, 0xF, true); }
__device__ __forceinline__ unsigned xor4u(unsigned x) {
    int t = __builtin_amdgcn_update_dpp(0, (int)x, 0x104, 0xF, 0x5, false); t = __builtin_amdgcn_update_dpp(t, (int)x, 0x114, 0xF, 0xA, false); return (unsigned)t;
}
template <int N> __device__ __forceinline__ void bitonic_merge_desc(unsigned (&a)[N]) {
#pragma unroll
    for (int j = N >> 1; j > 0; j >>= 1)
#pragma unroll
        for (int i = 0; i < N; ++i) { const int l = i ^ j; if (l > i) { const unsigned hi = umax_(a[i], a[l]), lo = umin_(a[i], a[l]); a[i] = hi; a[l] = lo; } }
}
template <int N> __device__ __forceinline__ void bitonic_sort_desc(unsigned (&a)[N]) {
#pragma unroll
    for (int k = 2; k <= N; k <<= 1)
#pragma unroll
        for (int j = k >> 1; j > 0; j >>= 1)
#pragma unroll
            for (int i = 0; i < N; ++i) { const int l = i ^ j; if (l > i) { const bool asc = (k < N) && ((i & k) != 0);
                const unsigned hi = umax_(a[i], a[l]), lo = umin_(a[i], a[l]); a[i] = asc ? lo : hi; a[l] = asc ? hi : lo; } }
}
__device__ __forceinline__ float row_max16(float x) { x = fmaxf(x, dppf<0xB1>(x)); x = fmaxf(x, dppf<0x4E>(x)); x = fmaxf(x, dppf<0x141>(x)); x = fmaxf(x, dppf<0x140>(x)); return x; }
constexpr int P11_LISTS = 0, P11_TOPK = 1024, P11_TAB = 1536, P11_RES = 2048, P11_WAVE_LDS = 2048 + 8 * 1536;
__device__ __forceinline__ void p11_load_scores(u32x4 (&sc)[8], int t, int lane) {
    const u32x4* SC = (const u32x4*)((const unsigned short*)(KWS() + WS_SC) + (size_t)t * 2048 + 32 * lane);
    u32x4 raw[4];
#pragma unroll
    for (int i = 0; i < 4; ++i) raw[i] = SC[i];
#pragma unroll
    for (int i = 0; i < 4; ++i)
#pragma unroll
        for (int c = 0; c < 4; ++c) { const unsigned w = raw[i][c];
            const float fx = (float)__builtin_bit_cast(_Float16, (unsigned short)(w & 0xFFFFu)), fy = (float)__builtin_bit_cast(_Float16, (unsigned short)(w >> 16));
            sc[2 * i + (c >> 1)][2 * (c & 1)] = __builtin_bit_cast(unsigned, fx); sc[2 * i + (c >> 1)][2 * (c & 1) + 1] = __builtin_bit_cast(unsigned, fy); }
}
__device__ __forceinline__ void p11_setup(LAS unsigned char* wl, int lane, unsigned (&lut)[7]) {
    int c = lane, ti = 0, tj = 0, valid = 0;
#pragma unroll 1
    for (int i = 0; i < 16; ++i) { const int n = 16 / (i + 1); if (c < n) { ti = i; tj = c; valid = 1; break; } c -= n; }
    ((LAS unsigned*)(wl + P11_TAB))[lane] = (unsigned)(ti | (tj << 4) | (valid << 8));
    asm volatile("s_waitcnt lgkmcnt(0)" ::: "memory");
#pragma unroll
    for (int m = 0; m < 7; ++m) lut[m] = ((volatile LAS unsigned*)(wl + P11_TAB))[(lane & 7) + 8 * m];
}
#ifndef P11_NTG
#define P11_NTG 4
#endif
__device__ __forceinline__ void p11_topk(const u32x4 (&sc)[8], const unsigned (&lut)[7], LAS unsigned char* wl, int lane, unsigned (&e_slot)[2], float (&g_slot)[2]) {
    {
        unsigned h0[16], h1[16];
        const unsigned pbase = (unsigned)((lane & 3) * 32);
#pragma unroll
        for (int i = 0; i < 4; ++i)
#pragma unroll
            for (int c = 0; c < 4; ++c) { h0[4 * i + c] = okey((sc[i][c] & ~0x7Fu) | (pbase + 4 * i + c)); h1[4 * i + c] = okey((sc[4 + i][c] & ~0x7Fu) | (pbase + 16 + 4 * i + c)); }
        bitonic_sort_desc<16>(h0); bitonic_sort_desc<16>(h1);
        unsigned s16[16];
#pragma unroll
        for (int i = 0; i < 16; ++i) s16[i] = umax_(h0[i], h1[15 - i]);
        bitonic_merge_desc<16>(s16);
        { unsigned d[16];
#pragma unroll
          for (int i = 0; i < 16; ++i) d[i] = umax_(s16[i], dppu<0xB1>(s16[15 - i]));
          bitonic_merge_desc<16>(d);
#pragma unroll
          for (int i = 0; i < 16; ++i) s16[i] = umax_(d[i], dppu<0x4E>(d[15 - i]));
          bitonic_merge_desc<16>(s16); }
        if ((lane & 3) == 0) { LAS u32x4* lp = (LAS u32x4*)(wl + P11_LISTS + (lane >> 2) * 64);
            lp[0] = (u32x4){s16[0], s16[1], s16[2], s16[3]}; lp[1] = (u32x4){s16[4], s16[5], s16[6], s16[7]}; lp[2] = (u32x4){s16[8], s16[9], s16[10], s16[11]}; lp[3] = (u32x4){s16[12], s16[13], s16[14], s16[15]}; }
        asm volatile("s_waitcnt lgkmcnt(0)" ::: "memory");
        const int hd = lane >> 3, e = lane & 7;
        volatile LAS unsigned* la = (volatile LAS unsigned*)(wl + P11_LISTS + (2 * hd) * 64);
        volatile LAS unsigned* lb = (volatile LAS unsigned*)(wl + P11_LISTS + (2 * hd + 1) * 64);
        unsigned cand[8];
#pragma unroll
        for (int m = 0; m < 7; ++m) {
            const unsigned ij = lut[m];
            const float av = __builtin_bit_cast(float, okey_inv(la[ij & 15u]) & ~0x7Fu), bv = __builtin_bit_cast(float, okey_inv(lb[(ij >> 4) & 15u]) & ~0x7Fu);
            const unsigned kk = okey((__builtin_bit_cast(unsigned, av + bv) & ~0x3Fu) | (unsigned)(e + 8 * m));
            cand[m] = (ij & 0x100u) ? kk : 0u;
        }
        cand[7] = 0u;
        bitonic_sort_desc<8>(cand);
        unsigned t16[16];
#pragma unroll
        for (int i = 0; i < 8; ++i) { t16[i] = cand[i]; t16[15 - i] = dppu<0xB1>(cand[i]); }
        bitonic_merge_desc<16>(t16);
        { unsigned d[16];
#pragma unroll
          for (int i = 0; i < 16; ++i) d[i] = umax_(t16[i], dppu<0x4E>(t16[15 - i]));
          bitonic_merge_desc<16>(d);
#pragma unroll
          for (int i = 0; i < 16; ++i) t16[i] = umax_(d[i], xor4u(d[15 - i]));
          bitonic_merge_desc<16>(t16); }
        if (e == 0) { LAS u32x4* tp = (LAS u32x4*)(wl + P11_TOPK + hd * 64);
            tp[0] = (u32x4){t16[0], t16[1], t16[2], t16[3]}; tp[1] = (u32x4){t16[4], t16[5], t16[6], t16[7]}; tp[2] = (u32x4){t16[8], t16[9], t16[10], t16[11]}; tp[3] = (u32x4){t16[12], t16[13], t16[14], t16[15]}; }
        asm volatile("s_waitcnt lgkmcnt(0)" ::: "memory");
#pragma unroll
        for (int sl = 0; sl < 2; ++sl) {
            const int hd2 = 4 * sl + (lane >> 4);
            const unsigned kb = okey_inv(((volatile LAS unsigned*)(wl + P11_TOPK))[hd2 * 16 + (lane & 15)]);
            const unsigned ij = ((volatile LAS unsigned*)(wl + P11_TAB))[kb & 0x3Fu];
            const unsigned ka = okey_inv(((volatile LAS unsigned*)(wl + P11_LISTS))[(2 * hd2) * 16 + (ij & 15u)]);
            const unsigned kq = okey_inv(((volatile LAS unsigned*)(wl + P11_LISTS))[(2 * hd2 + 1) * 16 + ((ij >> 4) & 15u)]);
            e_slot[sl] = (ka & 0x7Fu) * 128u + (kq & 0x7Fu);
            const float sv = __builtin_bit_cast(float, kb & ~0x3Fu);
            const float ex = __expf(sv - row_max16(sv));
            g_slot[sl] = ex / row_sum16(ex);
        }
    }
#pragma unroll
    for (int sl = 0; sl < 2; ++sl) {
        unsigned key = (e_slot[sl] << 6) | (unsigned)lane;
#pragma unroll
        for (int k = 2; k <= 64; k <<= 1)
#pragma unroll
            for (int j = k >> 1; j > 0; j >>= 1) {
                const unsigned other = (unsigned)__shfl_xor((int)key, j);
                const bool up = (k == 64) || ((lane & k) == 0), lower = (lane & j) == 0;
                const unsigned mn = umin_(key, other), mx = umax_(key, other);
                key = (lower == up) ? mn : mx;
            }
        e_slot[sl] = key >> 6;
        g_slot[sl] = __shfl(g_slot[sl], (int)(key & 63u));
    }
    {
        unsigned k0 = (e_slot[0] << 7) | (unsigned)lane, k1 = (e_slot[1] << 7) | 64u | (unsigned)lane;
        const unsigned r1 = (unsigned)__shfl((int)k1, 63 - lane);
        unsigned lo = umin_(k0, r1), hi = umax_(k0, r1);
#pragma unroll
        for (int j = 32; j > 0; j >>= 1) {
            const unsigned ol = (unsigned)__shfl_xor((int)lo, j), oh = (unsigned)__shfl_xor((int)hi, j);
            const bool lower = (lane & j) == 0;
            lo = lower ? umin_(lo, ol) : umax_(lo, ol); hi = lower ? umin_(hi, oh) : umax_(hi, oh);
        }
        const float g0 = g_slot[0], g1 = g_slot[1];
        const float a0 = __shfl(g0, (int)(lo & 63u)), a1 = __shfl(g1, (int)(lo & 63u)), b0 = __shfl(g0, (int)(hi & 63u)), b1 = __shfl(g1, (int)(hi & 63u));
        e_slot[0] = lo >> 7; g_slot[0] = (lo & 64u) ? a1 : a0;
        e_slot[1] = hi >> 7; g_slot[1] = (hi & 64u) ? b1 : b0;
    }
}
typedef __bf16 bf16x2_t __attribute__((ext_vector_type(2)));
template <int NTG>
__device__ __forceinline__ void p11_group(const Args& a, int t0, int tstride, const unsigned (&lut)[7], LAS unsigned char* wl, int lane) {
    unsigned char* ws = KWS();
    unsigned es[NTG][2]; float cu[NTG][2], cv[NTG][2];
    {
        u32x4 sc[8];
#pragma unroll 1
        for (int j0 = 0; j0 < NTG; j0 += 2) {
#pragma unroll
            for (int jj = 0; jj < 2; ++jj) {
                const int j = j0 + jj, t = t0 + j * tstride;
                int lo_ = lane; asm volatile("" : "+v"(lo_));
                p11_load_scores(sc, t, lo_);
                unsigned e2[2]; float g_slot[2];
                p11_topk(sc, lut, wl, lo_, e2, g_slot);
                const f32x4* sp = (const f32x4*)((const float*)(ws + WS_SSQ) + (size_t)t * 16);
                const f32x4 s0 = sp[0], s1 = sp[1], s2 = sp[2], s3 = sp[3];
                const float tot = (((s0[0] + s0[1]) + (s0[2] + s0[3])) + ((s1[0] + s1[1]) + (s1[2] + s1[3]))) + (((s2[0] + s2[1]) + (s2[2] + s2[3])) + ((s3[0] + s3[1]) + (s3[2] + s3[3])));
                const float rs = 1.f / sqrtf(tot * (1.f / 1024.f) + EPS);
                volatile LAS unsigned* res = (volatile LAS unsigned*)(wl + P11_RES) + j * 384;
#pragma unroll
                for (int sl = 0; sl < 2; ++sl) {
                    res[sl * 64 + lo_] = e2[sl];
                    res[128 + sl * 64 + lo_] = __builtin_bit_cast(unsigned, rs * ((const float*)(ws + WS_PUS))[e2[sl]]);
                    res[256 + sl * 64 + lo_] = __builtin_bit_cast(unsigned, g_slot[sl] * ((const float*)(ws + WS_PVS))[e2[sl]]);
                }
            }
        }
        asm volatile("s_waitcnt lgkmcnt(0)" ::: "memory");
#pragma unroll
        for (int j = 0; j < NTG; ++j) { volatile LAS unsigned* res = (volatile LAS unsigned*)(wl + P11_RES) + j * 384;
#pragma unroll
            for (int sl = 0; sl < 2; ++sl) { es[j][sl] = res[sl * 64 + lane]; cu[j][sl] = __builtin_bit_cast(float, res[128 + sl * 64 + lane]); cv[j][sl] = __builtin_bit_cast(float, res[256 + sl * 64 + lane]); } }
    }
    const int loff = 16 * lane;
    u32x4 rr[2][4];
#define P11_LOADR(TAB, B, l, sl, k) do { const int es_ = (int)es[l][sl]; const int p0_ = (k) * 4; \
        _Pragma("unroll") for (int jj = 0; jj < 4; ++jj) { const size_t eo_ = (size_t)(unsigned)__builtin_amdgcn_readlane(es_, p0_ + jj) * 1024; rr[B][jj] = *(const u32x4*)(((TAB) + eo_) + loff); } } while (0)
    float wgt[NTG][2];
    {
        const unsigned char* PU = ws + WS_PU;
        u32x4 hh_[NTG], hl_[NTG]; float hsc[NTG];
#pragma unroll
        for (int j = 0; j < NTG; ++j) { const int t = t0 + j * tstride;
            const u32x4 h0 = *(const u32x4*)((const bf16_t*)(ws + WS_HB) + (size_t)t * 1024 + 16 * lane), h1 = *(const u32x4*)((const bf16_t*)(ws + WS_HB) + (size_t)t * 1024 + 16 * lane + 8);
            float f[16]; float am = 0.f;
#pragma unroll
            for (int q = 0; q < 4; ++q) { f[2 * q] = bflo(h0[q]); f[2 * q + 1] = bfhi(h0[q]); f[8 + 2 * q] = bflo(h1[q]); f[8 + 2 * q + 1] = bfhi(h1[q]); }
#pragma unroll
            for (int i = 0; i < 16; ++i) am = fmaxf(am, fabsf(f[i]));
            am = fmaxf(wave_max(am), 1e-30f);
            const float sh = 127.f / am; hsc[j] = am * (1.f / (127.f * 254.f));
            unsigned wh[4], wl_[4];
#pragma unroll
            for (int q = 0; q < 4; ++q) { float a_[4], r_[4];
#pragma unroll
                for (int i = 0; i < 4; ++i) { a_[i] = __builtin_rintf(f[4 * q + i] * sh); r_[i] = (f[4 * q + i] * sh - a_[i]) * 254.f; }
                wh[q] = pack_i8x4(a_[0], a_[1], a_[2], a_[3]); wl_[q] = pack_i8x4(r_[0], r_[1], r_[2], r_[3]); }
            hh_[j] = (u32x4){wh[0], wh[1], wh[2], wh[3]}; hl_[j] = (u32x4){wl_[0], wl_[1], wl_[2], wl_[3]}; }
        float dots[NTG][2];
#pragma unroll
        for (int j = 0; j < NTG; ++j) { dots[j][0] = 0.f; dots[j][1] = 0.f; }
        __syncthreads();
#define P11_COMPU(B, l, sl, k) do { float part[4]; \
        u32x4 h0_ = hh_[l], h1_ = hl_[l]; asm volatile("" : "+v"(h0_), "+v"(h1_)); \
        _Pragma("unroll") for (int jj = 0; jj < 4; ++jj) { int ah_ = 0, al_ = 0; \
            _Pragma("unroll") for (int q = 0; q < 4; ++q) { ah_ = __builtin_amdgcn_sdot4((int)rr[B][jj][q], (int)h0_[q], ah_, false); al_ = __builtin_amdgcn_sdot4((int)rr[B][jj][q], (int)h1_[q], al_, false); } \
            part[jj] = (float)(ah_ * 254 + al_); } \
        float q2[2]; \
        _Pragma("unroll") for (int kk = 0; kk < 2; ++kk) { const float keep = (lane & 1) ? part[2 * kk + 1] : part[2 * kk], send = (lane & 1) ? part[2 * kk] : part[2 * kk + 1]; q2[kk] = keep + dppf<0xB1>(send); } \
        float d_ = ((lane & 2) ? q2[1] : q2[0]) + dppf<0x4E>((lane & 2) ? q2[0] : q2[1]); \
        d_ += xor4f(d_); d_ += dppf<0x128>(d_); d_ = swap32_sum(swap16_sum(d_));                       \
        if ((lane >> 2) == (k)) dots[l][sl] = d_; } while (0)
        constexpr int L = NTG;
        P11_LOADR(PU, 0, 0, 0, 0);
#pragma unroll
        for (int sl = 0; sl < 2; ++sl) {
#pragma unroll 1
            for (int k = 0; k < 16; ++k) {
#pragma unroll
                for (int l = 0; l < L; ++l) {
                    if (l + 1 < L) { if ((l & 1) == 0) P11_LOADR(PU, 1, l + 1, sl, k); else P11_LOADR(PU, 0, l + 1, sl, k); }
                    else if (k + 1 < 16) P11_LOADR(PU, 0, 0, sl, k + 1);
                    else if (sl == 0) P11_LOADR(PU, 0, 0, 1, 0);
                    if ((l & 1) == 0) P11_COMPU(0, l, sl, k); else P11_COMPU(1, l, sl, k);
                }
            }
        }
#undef P11_COMPU
#pragma unroll
        for (int j = 0; j < NTG; ++j)
#pragma unroll
            for (int sl = 0; sl < 2; ++sl) { const float z = dots[j][sl] * hsc[j] * cu[j][sl]; wgt[j][sl] = cv[j][sl] * (0.5f * z * (1.f + erff(z * 0.70710678118654752f))); }
    }
    int o[NTG][16]; float wsc[NTG]; unsigned wpk[NTG][2];
#pragma unroll
    for (int j = 0; j < NTG; ++j) {
#pragma unroll
        for (int i = 0; i < 16; ++i) o[j][i] = 0;
        const float am = fmaxf(wave_max(fmaxf(fabsf(wgt[j][0]), fabsf(wgt[j][1]))), 1e-30f);
        const float sw = 127.f / am; wsc[j] = am * (1.f / 127.f);
#pragma unroll
        for (int sl = 0; sl < 2; ++sl) { const unsigned wq_ = (unsigned)(int)__builtin_rintf(wgt[j][sl] * sw) & 0xffu;
            wpk[j][sl] = dppu<0x00>(wq_) | (dppu<0x55>(wq_) << 8) | (dppu<0xAA>(wq_) << 16) | (dppu<0xFF>(wq_) << 24); }
    }
    __syncthreads();
    {
        const unsigned char* PV = ws + WS_PV;
#define P11_COMPV(B, l, sl, k) do { const unsigned w4_ = (unsigned)__builtin_amdgcn_readlane((int)wpk[l][sl], (k) * 4); \
        _Pragma("unroll") for (int q = 0; q < 4; ++q) { const unsigned r0_ = rr[B][0][q], r1_ = rr[B][1][q], r2_ = rr[B][2][q], r3_ = rr[B][3][q]; \
            const unsigned a_ = __builtin_amdgcn_perm(r1_, r0_, 0x05010400u), b_ = __builtin_amdgcn_perm(r1_, r0_, 0x07030602u); \
            const unsigned c_ = __builtin_amdgcn_perm(r3_, r2_, 0x05010400u), d_ = __builtin_amdgcn_perm(r3_, r2_, 0x07030602u); \
            o[l][4 * q] = __builtin_amdgcn_sdot4((int)__builtin_amdgcn_perm(c_, a_, 0x05040100u), (int)w4_, o[l][4 * q], false); \
            o[l][4 * q + 1] = __builtin_amdgcn_sdot4((int)__builtin_amdgcn_perm(c_, a_, 0x07060302u), (int)w4_, o[l][4 * q + 1], false); \
            o[l][4 * q + 2] = __builtin_amdgcn_sdot4((int)__builtin_amdgcn_perm(d_, b_, 0x05040100u), (int)w4_, o[l][4 * q + 2], false); \
            o[l][4 * q + 3] = __builtin_amdgcn_sdot4((int)__builtin_amdgcn_perm(d_, b_, 0x07060302u), (int)w4_, o[l][4 * q + 3], false); } } while (0)
        constexpr int L = NTG;
        P11_LOADR(PV, 0, 0, 0, 0);
#pragma unroll
        for (int sl = 0; sl < 2; ++sl) {
#pragma unroll 1
            for (int k = 0; k < 16; ++k) {
#pragma unroll
                for (int l = 0; l < L; ++l) {
                    if (l + 1 < L) { if ((l & 1) == 0) P11_LOADR(PV, 1, l + 1, sl, k); else P11_LOADR(PV, 0, l + 1, sl, k); }
                    else if (k + 1 < 16) P11_LOADR(PV, 0, 0, sl, k + 1);
                    else if (sl == 0) P11_LOADR(PV, 0, 0, 1, 0);
                    if ((l & 1) == 0) P11_COMPV(0, l, sl, k); else P11_COMPV(1, l, sl, k);
                }
            }
        }
#undef P11_COMPV
    }
#undef P11_LOADR
    const float* NF = KIN(24) + 16 * lane;
#pragma unroll
    for (int j = 0; j < NTG; ++j) {
        float* H = KOUT() + (size_t)(t0 + j * tstride) * 1024 + 16 * lane;
        const u32x4* hb = (const u32x4*)((const bf16_t*)(ws + WS_HB) + (size_t)(t0 + j * tstride) * 1024 + 16 * lane);
        const u32x4 hb0 = hb[0], hb1 = hb[1];
        float y[16]; float ss = 0.f;
#pragma unroll
        for (int q = 0; q < 4; ++q) { y[2 * q] = bflo(hb0[q]); y[2 * q + 1] = bfhi(hb0[q]); y[8 + 2 * q] = bflo(hb1[q]); y[8 + 2 * q + 1] = bfhi(hb1[q]); }
#pragma unroll
        for (int i = 0; i < 16; ++i) { y[i] += (float)o[j][i] * wsc[j]; ss += y[i] * y[i]; }
        const float rf = 1.f / sqrtf(wave_sum_fast(ss) * (1.f / 1024.f) + EPS);
#pragma unroll
        for (int q = 0; q < 4; ++q) { const f32x4 nv = *(const f32x4*)(NF + 4 * q);
            *(f32x4*)(H + 4 * q) = (f32x4){y[4 * q] * rf * nv[0], y[4 * q + 1] * rf * nv[1], y[4 * q + 2] * rf * nv[2], y[4 * q + 3] * rf * nv[3]}; }
    }
}

__global__ void __launch_bounds__(NT, 2) mega(Args a) {
    extern __shared__ __attribute__((aligned(16))) unsigned char lds_raw[];
    LAS unsigned char* lds = (LAS unsigned char*)lds_raw;
    volatile LAS unsigned* MISC = (volatile LAS unsigned*)(lds + 131072 + 320);
    if (threadIdx.x < 32) MISC[threadIdx.x] = 0u;
    __syncthreads();
    XcdBarrier xbar = xcd_barrier_post((unsigned*)(KWS() + WS_CTL) + 4096, MISC + 8);
#define GSYNC() xcd_barrier(xbar)
#ifndef PH_LO
#define PH_LO 0
#endif
#ifndef PH_HI
#define PH_HI 99
#endif
#define IN(k) (PH_LO <= (k) && (k) <= PH_HI)
    if (IN(0)) { p0_prologue(a, lds); GSYNC(); }
    if (IN(1)) {
        unsigned char* ws = KWS(); const int G = gridDim.x, bx = opaque_bx(); pg8::StaticOrder S;
        pg8::Gemm g{(const bf16_t*)(ws + WS_XN), (const bf16_t*)(ws + WS_WIN), TOK, IN_PAD, 1024, 1024, 1024}; S.init(TOK, IN_PAD, G, bx);
        EpiInProj E{(bf16_t*)(ws + WS_Z), (bf16_t*)(ws + WS_XBC), (bf16_t*)(ws + WS_G), (bf16_t*)(ws + WS_QA), (bf16_t*)(ws + WS_KVA)};
        { const int rem = S.nwg % G; if (rem == 0) p9_peer_tables(a, 0, 16384, bx, G); else if (bx >= rem) p9_peer_tables(a, 0, 16384, bx - rem, G - rem); }
        pg8::gemm_phase(lds, g, S, E); GSYNC();
    }
    if (IN(2)) { p2_prep(a, lds); GSYNC(); }
    if (IN(3)) { const int G = gridDim.x; for (int u = opaque_bx(); u < BATCH * 16 * 2; u += G) p34_chain(a, lds, u); GSYNC(); }
    if (IN(5)) { const int G = gridDim.x; for (int u = opaque_bx(); u < BATCH * NCHUNK * 2; u += G) p5_out_unit(a, lds, u); GSYNC(); }
    if (IN(6)) {
        unsigned char* ws = KWS(); const int G = gridDim.x, bx = opaque_bx(); pg8::StaticOrder S;
        const int rot = (bx >> 3) % 3;
#pragma unroll 1
        for (int s_ = 0; s_ < 3; ++s_) {
            int ph_ = s_ + rot; if (ph_ >= 3) ph_ -= 3; asm volatile("" : "+s"(ph_));
            if (ph_ == 0) {
        { pg8::Gemm g{(const bf16_t*)(ws + WS_QA), (const bf16_t*)(ws + WS_WQB), TOK, 1536, 384, 512, 384}; S.init(TOK, 1536, G, bx);
          EpiQ E{(bf16_t*)KOUT(), (const float*)(ws + WS_RQ), (const float*)(ws + WS_COS), (const float*)(ws + WS_SIN)}; pg8::gemm_phase(lds, g, S, E); }
            } else if (ph_ == 1) {
        { pg8::Gemm g{(const bf16_t*)(ws + WS_KVA), (const bf16_t*)(ws + WS_WK), TOK, 1024, 256, 256, 256}; S.init(TOK, 1024, G, bx);
          EpiK E{(bf16_t*)(ws + WS_K), (const float*)(ws + WS_RKV)}; pg8::gemm_phase(lds, g, S, E); }
            } else {
        { pg8::Gemm g{(const bf16_t*)(ws + WS_WV), (const bf16_t*)(ws + WS_KVA), 1024, TOK, 256, 256, 256}; S.init(1024, TOK, G, bx);
          EpiVT E{(bf16_t*)(ws + WS_VT), (const float*)(ws + WS_RKV)}; pg8::gemm_phase(lds, g, S, E); }
            }
        }
        GSYNC();
    }
    if (IN(7)) { p7_attention(a, lds); GSYNC(); }
    if (IN(8)) {
        unsigned char* ws = KWS(); const int G = gridDim.x, bx = opaque_bx(); pg8::StaticOrder S;
        { pg8::Gemm g{(const bf16_t*)(ws + WS_YS), (const bf16_t*)(ws + WS_PA), TOK, 1024, 1024, 1024, 1024}; S.init(TOK, 1024, G, bx);
          EpiMerge1 E{(bf16_t*)(ws + WS_M), (const unsigned char*)(ws + WS_G)}; pg8::gemm_phase(lds, g, S, E); }
        { pg8::Gemm g{(const bf16_t*)(ws + WS_YM), (const bf16_t*)(ws + WS_PB), TOK, 1024, 1024, 1024, 1024}; S.init(TOK, 1024, G, bx);
          EpiMerge2 E{(bf16_t*)(ws + WS_M), (const unsigned char*)(ws + WS_G)}; pg8::gemm_phase(lds, g, S, E); }
        GSYNC();
    }
    if (IN(9)) {
        unsigned char* ws = KWS(); const int G = gridDim.x, bx = opaque_bx(); pg8::StaticOrder S;
        { pg8::Gemm g{(const bf16_t*)(ws + WS_M), (const bf16_t*)(ws + WS_WOUT), TOK, 1024, 1024, 1024, 1024}; S.init(TOK, 1024, G, bx);
          EpiOut E{KIN(0), (bf16_t*)(ws + WS_HB), (float*)(ws + WS_SSQ)};
          const bool first = (bx >> 3) & 1;
          if (first) p9_peer_tables(a, 16384, 32768, bx, G);
          pg8::gemm_phase(lds, g, S, E);
          if (!first) p9_peer_tables(a, 16384, 32768, bx, G); }
        GSYNC();
    }
    if (IN(10)) {
        unsigned char* ws = KWS(); const int G = gridDim.x, bx = opaque_bx(); pg8::StaticOrder S;
        pg8::Gemm g{(const bf16_t*)(ws + WS_HB), (const bf16_t*)(ws + WS_WPQ), TOK, 2048, 1024, 1024, 1024}; S.init(TOK, 2048, G, bx);
        EpiScore E{(float*)(ws + WS_SC), (const float*)(ws + WS_SSQ)}; pg8::gemm_phase(lds, g, S, E);
        GSYNC();
    }
    if (IN(11)) { const int tid_ = opaque_tid(); const int wave = tid_ >> 6, lane = tid_ & 63; const int gw = opaque_bx() * NW + wave, ngw = gridDim.x * NW; LAS unsigned char* wl = lds + wave * P11_WAVE_LDS; unsigned lut[7]; p11_setup(wl, lane, lut); for (int t = gw; t < TOK; t += P11_NTG * ngw) p11_group<P11_NTG>(a, t, ngw, lut, wl, lane); }
}

extern "C" void kernel_launch(void* const* d_in, const int* in_sizes, int n_in, void* d_out, int out_size, void* d_ws, size_t ws_size, hipStream_t stream) {
    static int grid = 0;
    if (grid == 0) {
        if (n_in != 25 || out_size != TOK * DM || ws_size < WS_END) { fprintf(stderr, "kernel_launch: unexpected sizes n_in %d out %d ws %zu\n", n_in, out_size, ws_size); grid = -1; return; }
        int dev = 0, cus = 0, per_cu = 0;
        (void)hipGetDevice(&dev);
        (void)hipDeviceGetAttribute(&cus, hipDeviceAttributeMultiprocessorCount, dev);
        (void)hipFuncSetAttribute((const void*)mega, hipFuncAttributeMaxDynamicSharedMemorySize, LDS_BYTES);
        (void)hipOccupancyMaxActiveBlocksPerMultiprocessor(&per_cu, (const void*)mega, NT, LDS_BYTES);
        if (per_cu < 1) { fprintf(stderr, "kernel_launch: occupancy query reports %d\n", per_cu); grid = -1; return; }
        grid = cus;
    }
    if (grid < 0) return;
    if (hipMemsetAsync((char*)d_ws + WS_CTL, 0, 1 * MiB, stream) != hipSuccess) { fprintf(stderr, "kernel_launch: hipMemsetAsync failed\n"); return; }
    Args a{};
    for (int i = 0; i < 25; ++i) a.in[i] = (const float*)d_in[i];
    a.out = (float*)d_out; a.ws = (unsigned char*)d_ws;
    void* args[] = {&a};
    hipError_t e = hipLaunchCooperativeKernel((const void*)mega, dim3(grid), dim3(NT), args, LDS_BYTES, stream);
    if (e != hipSuccess) fprintf(stderr, "kernel_launch: cooperative launch failed: %s (grid %d)\n", hipGetErrorString(e), grid);
}
```

```cpp
#include <hip/hip_runtime.h>
#include <hip/hip_cooperative_groups.h>
#include <cstdio>
#include <cstdint>
namespace cg = cooperative_groups;

#define LAS __attribute__((address_space(3)))
typedef unsigned short bf16_t;
typedef short bf16x8 __attribute__((ext_vector_type(8)));
typedef float f32x4 __attribute__((ext_vector_type(4)));
typedef float f32x2 __attribute__((ext_vector_type(2)));
typedef int i32x8_t __attribute__((ext_vector_type(8)));
typedef float f32x16 __attribute__((ext_vector_type(16)));
typedef unsigned u32x4 __attribute__((ext_vector_type(4)));
typedef unsigned u32x2 __attribute__((ext_vector_type(2)));

constexpr int BATCH = 8, SEQ = 4096, TOK = BATCH * SEQ, DM = 1024;
constexpr int NW = 8, NT = NW * 64;
constexpr int CHUNK = 128, NCHUNK = SEQ / CHUNK;
constexpr int IN_PAD = 5376;
constexpr int QW = 1536, KW = 1024;
constexpr float EPS = 1e-6f;
constexpr float QSCALE = 0.10206207261596577f * 1.4426950408889634f;

__device__ __forceinline__ unsigned f2bf(float f) { unsigned u = __builtin_bit_cast(unsigned, f); return (u + 0x7fffu + ((u >> 16) & 1u)) >> 16; }
typedef __bf16 bf16x2_t __attribute__((ext_vector_type(2)));
__device__ __forceinline__ unsigned pk2(float lo, float hi) { f32x2 v = {lo, hi}; bf16x2_t b = __builtin_convertvector(v, bf16x2_t); return __builtin_bit_cast(unsigned, b); }
__device__ __forceinline__ float bflo(unsigned u) { return __builtin_bit_cast(float, u << 16); }
__device__ __forceinline__ float bfhi(unsigned u) { return __builtin_bit_cast(float, u & 0xffff0000u); }
__device__ __forceinline__ float bf1(bf16_t u) { return __builtin_bit_cast(float, (unsigned)u << 16); }
__device__ __forceinline__ float wave_sum(float v) {
#pragma unroll
    for (int o = 1; o < 64; o <<= 1) v += __shfl_xor(v, o);
    return v;
}
__device__ __forceinline__ int opaque_bx() { int b = blockIdx.x; asm volatile("" : "+s"(b)); return b; }
constexpr int TID_TABLE_LDS = 131072 + 320 + 128;
__device__ __forceinline__ unsigned hw_wave_slot() { return (unsigned)__builtin_amdgcn_s_getreg(4 | (5 << 11)) & 63u; }
__device__ __forceinline__ int opaque_tid() {
    extern __shared__ __attribute__((aligned(16))) unsigned char lds_raw[];
    const int wv = ((volatile LAS int*)((LAS unsigned char*)lds_raw + TID_TABLE_LDS))[hw_wave_slot()];
    int l; asm volatile("v_mbcnt_lo_u32_b32 %0, -1, 0\n\tv_mbcnt_hi_u32_b32 %0, -1, %0" : "=v"(l));
    int t = wv * 64 + l;
    asm volatile("" : "+v"(t)); return t; }
__device__ __forceinline__ float fast_rcp(float x) { return __builtin_amdgcn_rcpf(x); }
__device__ __forceinline__ float sigmoidf_(float x) { return fast_rcp(1.f + __expf(-x)); }
__device__ __forceinline__ float siluf_(float x) { return x * sigmoidf_(x); }

#define SWAP_PAIR(BUILTIN, x, r0, r1) unsigned r0, r1; { unsigned a_ = __builtin_bit_cast(unsigned, x), b_ = a_; asm volatile("" : "+v"(b_)); auto r_ = BUILTIN(a_, b_, false, false); r0 = r_[0]; r1 = r_[1]; asm volatile("" : "+v"(r0), "+v"(r1)); }

template <int CTRL> __device__ __forceinline__ float dppf(float x) { return __builtin_bit_cast(float, __builtin_amdgcn_update_dpp(0, __builtin_bit_cast(int, x), CTRL, 0xF, 0xF, true)); }
__device__ __forceinline__ float swap16_max(float x) { SWAP_PAIR(__builtin_amdgcn_permlane16_swap, x, r0, r1); return fmaxf(__builtin_bit_cast(float, r0), __builtin_bit_cast(float, r1)); }
__device__ __forceinline__ float swap32_max(float x) { SWAP_PAIR(__builtin_amdgcn_permlane32_swap, x, r0, r1); return fmaxf(__builtin_bit_cast(float, r0), __builtin_bit_cast(float, r1)); }
__device__ __forceinline__ float swap16_sum(float x) { SWAP_PAIR(__builtin_amdgcn_permlane16_swap, x, r0, r1); return __builtin_bit_cast(float, r0) + __builtin_bit_cast(float, r1); }
__device__ __forceinline__ float swap32_sum(float x) { SWAP_PAIR(__builtin_amdgcn_permlane32_swap, x, r0, r1); return __builtin_bit_cast(float, r0) + __builtin_bit_cast(float, r1); }
__device__ __forceinline__ float wave_max(float x) {
    x = fmaxf(x, dppf<0xB1>(x)); x = fmaxf(x, dppf<0x4E>(x)); x = fmaxf(x, dppf<0x141>(x)); x = fmaxf(x, dppf<0x140>(x));
    return swap32_max(swap16_max(x));
}
__device__ __forceinline__ float row_sum16(float x) {
    x += dppf<0xB1>(x); x += dppf<0x4E>(x); x += dppf<0x141>(x); x += dppf<0x140>(x); return x;
}
__device__ __forceinline__ float wave_sum_fast(float x) { return swap32_sum(swap16_sum(row_sum16(x))); }

__device__ __forceinline__ unsigned pack4_fp8(float a, float b, float c, float d) {
    int p = __builtin_amdgcn_cvt_pk_fp8_f32(a, b, 0, false); p = __builtin_amdgcn_cvt_pk_fp8_f32(c, d, p, true); return (unsigned)p;
}
__device__ __forceinline__ unsigned pack_i8x4(float a, float b, float c, float d) {
    const int qa = (int)__builtin_rintf(a), qb = (int)__builtin_rintf(b), qc = (int)__builtin_rintf(c), qd = (int)__builtin_rintf(d);
    return ((unsigned)qa & 0xffu) | (((unsigned)qb & 0xffu) << 8) | (((unsigned)qc & 0xffu) << 16) | ((unsigned)qd << 24);
}
namespace pg8 {
constexpr int BM = 256, BK = 64, HALF = 128, HTB = HALF * BK * 2, STAGE_BYTES = 8 * HTB, NXCD = 8, WGM = 8;
__host__ __device__ __forceinline__ int lds_byte(int r, int c) { const int st = (r >> 4) * 2 + (c >> 5), rr = r & 15, cc = c & 31, ob = rr * 64 + cc * 2; return st * 1024 + (ob ^ (((ob >> 9) & 1) << 5)); }
__host__ __device__ __forceinline__ void stage_rc(int b, int& R, int& C) { const int st = b / 1024, sb = b % 1024, swz = sb ^ (((sb >> 9) & 1) << 5); R = (st >> 1) * 16 + swz / 64; C = (st & 1) * 32 + (swz % 64) / 2; }
__host__ __device__ __forceinline__ int perm32(int rho) { const int n = rho >> 4, i = rho & 15; return 8 * (i >> 2) + 4 * n + (i & 3); }
struct Unit { int pm, pn; };
struct Gemm { const bf16_t* A; const bf16_t* Bt; int M, N, K, lda, ldb; };
struct StaticOrder {
    int nM, nN, nwg, G, c;
    __device__ void init(int M, int N, int G_, int c_) { nM = M / BM; nN = N / BM; nwg = nM * nN; G = G_; c = c_; }
    __device__ bool next(int i, Unit& u) const {
        const long L = (long)i * G + c; if (L >= nwg) return false;
        int wgid = (int)L; { const int q = nwg / NXCD, r = nwg % NXCD, xcd = wgid % NXCD, off = wgid / NXCD; wgid = (xcd < r ? xcd * (q + 1) : r * (q + 1) + (xcd - r) * q) + off; }
        const int nig = WGM * nN, gid = wgid / nig, fm = gid * WGM, gsz = (nM - fm) < WGM ? (nM - fm) : WGM;
        u.pm = fm + ((wgid % nig) % gsz); u.pn = (wgid % nig) / gsz; return true;
    }
};
template <class Epi, int F8 = 0>
__device__ __forceinline__ void gemm_phase(LAS unsigned char* lds, const Gemm g, const StaticOrder& S, const Epi& E) {
    const int tid = opaque_tid(), wid = __builtin_amdgcn_readfirstlane(tid >> 6), lane = tid & 63, wr = wid >> 2, wc = wid & 3, fr = lane & 15, fq = lane >> 4;
    const int K = g.K, nt = K / BK;
    unsigned voffA[2], voffB[2];
#pragma unroll
    for (int i = 0; i < 2; ++i) { int R, C; stage_rc(tid * 16 + i * 8192, R, C); const int Rb = (R & ~31) + perm32(R & 31);
        voffA[i] = (unsigned)(R * g.lda + C) * 2u; voffB[i] = (unsigned)(Rb * g.ldb + C) * 2u; }
    const size_t kstep = (size_t)(BK * 2);
    const size_t hstepA = (size_t)HALF * g.lda * 2, hstepB = (size_t)HALF * g.ldb * 2;
    const size_t tstepA = 2 * hstepA, tstepB = 2 * hstepB;
    const unsigned ldsw = (unsigned)wid * 1024u;
    const int aoff = lds_byte(wr * 64 + fr, fq * 8), boff = lds_byte(wc * 32 + fr, fq * 8);
#define PG8_SA(b, h) (((b) * 2 + (h)) * HTB)
#define PG8_SB(b, h) ((4 + (b) * 2 + (h)) * HTB)
#define PG8_STAGE(bufoff, gbase, voff) do { _Pragma("unroll") for (int _i = 0; _i < 2; ++_i) { unsigned keep_; \
        asm volatile("s_mov_b32 %0, m0\n\ts_mov_b32 m0, %3\n\ts_nop 0\n\tglobal_load_lds_dwordx4 %1, %2\n\ts_mov_b32 m0, %0" \
                     : "=&s"(keep_) : "v"((voff)[_i]), "s"((const char*)(gbase)), "s"((unsigned)(size_t)(lds + (bufoff) + ldsw + _i * 8192)) : "memory"); } } while (0)
#define PG8_LDA(dst, b, h) do { _Pragma("unroll") for (int m = 0; m < 4; ++m) _Pragma("unroll") for (int k = 0; k < 2; ++k) dst[m][k] = *(const LAS bf16x8*)(lds + PG8_SA(b, h) + aoff + m * 2048 + k * 1024); } while (0)
#define PG8_LDB(dst, b, h) do { _Pragma("unroll") for (int n = 0; n < 2; ++n) _Pragma("unroll") for (int k = 0; k < 2; ++k) dst[n][k] = *(const LAS bf16x8*)(lds + PG8_SB(b, h) + boff + n * 2048 + k * 1024); } while (0)
typedef int i32x4_t_ __attribute__((ext_vector_type(4)));
#define PG8_I8(x0, x1) __builtin_shufflevector(__builtin_bit_cast(i32x4_t_, x0), __builtin_bit_cast(i32x4_t_, x1), 0, 1, 2, 3, 4, 5, 6, 7)
#define PG8_MMA(ai, bj, At, Bt) do { __builtin_amdgcn_s_setprio(1); _Pragma("unroll") for (int m = 0; m < 4; ++m) _Pragma("unroll") for (int n = 0; n < 2; ++n) { \
        if (F8 == 2) { _Pragma("unroll") for (int k = 0; k < 2; ++k) acc[ai][bj][m][n] = __builtin_bit_cast(f32x4, __builtin_amdgcn_mfma_i32_16x16x64_i8(__builtin_bit_cast(i32x4_t_, Bt[n][k]), __builtin_bit_cast(i32x4_t_, At[m][k]), __builtin_bit_cast(i32x4_t_, acc[ai][bj][m][n]), 0, 0, 0)); } \
        else if (F8 == 1) acc[ai][bj][m][n] = __builtin_amdgcn_mfma_scale_f32_16x16x128_f8f6f4(PG8_I8(Bt[n][0], Bt[n][1]), PG8_I8(At[m][0], At[m][1]), acc[ai][bj][m][n], 0, 0, 0, 0, 0, 0); \
        else { _Pragma("unroll") for (int k = 0; k < 2; ++k) acc[ai][bj][m][n] = __builtin_amdgcn_mfma_f32_16x16x32_bf16(Bt[n][k], At[m][k], acc[ai][bj][m][n], 0, 0, 0); } } \
        __builtin_amdgcn_s_setprio(0); } while (0)
#define PG8_WAIT_V(n) asm volatile("s_waitcnt vmcnt(" #n ")" ::: "memory")
#define PG8_WAIT_L(n) asm volatile("s_waitcnt lgkmcnt(" #n ")" ::: "memory")
#define PG8_BAR __builtin_amdgcn_s_barrier()
#define PG8_SCHED __builtin_amdgcn_sched_barrier(0)
    Unit cur, nxt; int ui = 0;
    if (!S.next(0, cur)) return;
    f32x4 acc[2][2][4][2];
#pragma unroll
    for (int a = 0; a < 2; ++a)
#pragma unroll
        for (int b = 0; b < 2; ++b)
#pragma unroll
            for (int m = 0; m < 4; ++m)
#pragma unroll
                for (int n = 0; n < 2; ++n) acc[a][b][m][n] = (f32x4){0.f, 0.f, 0.f, 0.f};
    bf16x8 At[4][2], B0[2][2], B1[2][2];
    const char* cA = (const char*)g.A + (size_t)cur.pm * tstepA; const char* cB = (const char*)g.Bt + (size_t)cur.pn * tstepB;
    PG8_STAGE(PG8_SB(0, 0), cB, voffB); PG8_STAGE(PG8_SB(0, 1), cB + hstepB, voffB); PG8_STAGE(PG8_SA(0, 0), cA, voffA); PG8_STAGE(PG8_SA(0, 1), cA + hstepA, voffA);
    if (wr == 1) PG8_BAR;
    PG8_WAIT_V(2); PG8_BAR;
    PG8_STAGE(PG8_SB(1, 0), cB + kstep, voffB); PG8_STAGE(PG8_SA(1, 0), cA + kstep, voffA); PG8_STAGE(PG8_SB(1, 1), cB + hstepB + kstep, voffB);
    PG8_WAIT_V(6); PG8_BAR;
    for (;;) {
        const bool has_next = S.next(ui + 1, nxt);
        const char* nA = has_next ? (const char*)g.A + (size_t)nxt.pm * tstepA : cA; const char* nB = has_next ? (const char*)g.Bt + (size_t)nxt.pn * tstepB : cB;
#pragma unroll 1
        for (int t = 0; t < nt; t += 2) {
            const bool last = (t == nt - 2);
            const char* a1 = cA + (size_t)(t + 1) * kstep;
            const char* a2 = last ? nA : cA + (size_t)(t + 2) * kstep; const char* b2 = last ? nB : cB + (size_t)(t + 2) * kstep;
            const char* a3 = a2 + kstep; const char* b3 = b2 + kstep;
            PG8_LDB(B0, 0, 0); PG8_LDB(B1, 0, 1); PG8_SCHED; PG8_LDA(At, 0, 0); PG8_STAGE(PG8_SA(1, 1), a1 + hstepA, voffA);
            PG8_WAIT_V(8); PG8_WAIT_L(0); PG8_BAR; PG8_MMA(0, 0, At, B0); PG8_MMA(0, 1, At, B1); PG8_BAR; PG8_SCHED;
            PG8_LDA(At, 0, 1); PG8_STAGE(PG8_SB(0, 0), b2, voffB); PG8_STAGE(PG8_SB(0, 1), b2 + hstepB, voffB); PG8_STAGE(PG8_SA(0, 0), a2, voffA);
            PG8_WAIT_V(8); PG8_WAIT_L(0); PG8_BAR; PG8_MMA(1, 0, At, B0); PG8_MMA(1, 1, At, B1); PG8_BAR; PG8_SCHED;
            PG8_LDB(B0, 1, 0); PG8_LDB(B1, 1, 1); PG8_SCHED; PG8_LDA(At, 1, 0); PG8_STAGE(PG8_SA(0, 1), a2 + hstepA, voffA);
            PG8_WAIT_V(8); PG8_WAIT_L(0); PG8_BAR; PG8_MMA(0, 0, At, B0); PG8_MMA(0, 1, At, B1); PG8_BAR; PG8_SCHED;
            PG8_LDA(At, 1, 1); PG8_STAGE(PG8_SB(1, 0), b3, voffB); PG8_STAGE(PG8_SB(1, 1), b3 + hstepB, voffB); PG8_STAGE(PG8_SA(1, 0), a3, voffA);
            PG8_WAIT_V(8); PG8_WAIT_L(0); PG8_BAR; PG8_MMA(1, 0, At, B0); PG8_MMA(1, 1, At, B1); PG8_BAR; PG8_SCHED;
        }
        if (wr == 0) PG8_BAR;
        { const int l2_ = opaque_tid() & 63; E(acc, cur, wr, wc, l2_ & 15, l2_ >> 4); }
        if (!has_next) break;
#pragma unroll
        for (int a = 0; a < 2; ++a)
#pragma unroll
            for (int b = 0; b < 2; ++b)
#pragma unroll
                for (int m = 0; m < 4; ++m)
#pragma unroll
                    for (int n = 0; n < 2; ++n) acc[a][b][m][n] = (f32x4){0.f, 0.f, 0.f, 0.f};
        cur = nxt; cA = nA; cB = nB; ++ui;
        if (wr == 1) PG8_BAR;
    }
    PG8_WAIT_V(0);
    PG8_BAR;
#undef PG8_SA
#undef PG8_SB
#undef PG8_STAGE
#undef PG8_LDA
#undef PG8_LDB
#undef PG8_MMA
#undef PG8_I8
#undef PG8_WAIT_V
#undef PG8_WAIT_L
#undef PG8_BAR
#undef PG8_SCHED
}
template <class F>
__device__ __forceinline__ void foreach8(const f32x4 (&acc)[2][2][4][2], const Unit& u, int wr, int wc, int fr, int fq, F&& f) {
#pragma unroll
    for (int ai = 0; ai < 2; ++ai)
#pragma unroll
        for (int m = 0; m < 4; ++m) { const int row = u.pm * 256 + ai * 128 + wr * 64 + m * 16 + fr;
#pragma unroll
            for (int bj = 0; bj < 2; ++bj) { const int col = u.pn * 256 + bj * 128 + wc * 32 + 8 * fq; f(row, col, acc[ai][bj][m][0], acc[ai][bj][m][1]); }
            if (m == 3) asm volatile("" ::: "memory"); }
}
template <int MB, class D, class L, class F>
__device__ __forceinline__ void foreach8_batched(const f32x4 (&acc)[2][2][4][2], const Unit& u, int wr, int wc, int fr, int fq, L&& load, F&& apply) {
#pragma unroll
    for (int ai = 0; ai < 2; ++ai)
#pragma unroll
        for (int m0 = 0; m0 < 4; m0 += MB) {
            D d[MB][2];
#pragma unroll
            for (int mm = 0; mm < MB; ++mm) { const int row = u.pm * 256 + ai * 128 + wr * 64 + (m0 + mm) * 16 + fr;
#pragma unroll
                for (int bj = 0; bj < 2; ++bj) { const int col = u.pn * 256 + bj * 128 + wc * 32 + 8 * fq; d[mm][bj] = load(row, col); } }
#pragma unroll
            for (int mm = 0; mm < MB; ++mm) { const int row = u.pm * 256 + ai * 128 + wr * 64 + (m0 + mm) * 16 + fr;
#pragma unroll
                for (int bj = 0; bj < 2; ++bj) { const int col = u.pn * 256 + bj * 128 + wc * 32 + 8 * fq; apply(row, col, acc[ai][bj][m0 + mm][0], acc[ai][bj][m0 + mm][1], d[mm][bj]); } }
            asm volatile("" ::: "memory");
        }
}
}
constexpr size_t MiB = 1u << 20;
constexpr float WIN_SCALE = 32.f;
constexpr size_t WS_CTL = 0;
constexpr size_t WS_WIN = 1 * MiB;
constexpr size_t WS_WAMAX = 128 * 1024;
constexpr size_t WS_XSC = 506 * MiB + 128 * 1024;
constexpr size_t WS_WPAMAX = 160 * 1024;
constexpr size_t WS_WPQ8 = 6 * MiB + 512 * 1024;
constexpr size_t WS_HQ = 218 * MiB;
constexpr float H_QMAX = 6.f;
constexpr size_t WS_WOAMAX = 176 * 1024;
constexpr size_t WS_MQ = 426 * MiB;
constexpr size_t WS_YSQ = 218 * MiB;
constexpr float YS8_SCALE = 16.f;
constexpr float M_QMAX = 4.f;
constexpr size_t WS_WQB = 12 * MiB;
constexpr size_t WS_WK = 14 * MiB;
constexpr size_t WS_WV = 14 * MiB + 512 * 1024;
constexpr size_t WS_PA = 15 * MiB, WS_PB = 17 * MiB, WS_WOUT = 19 * MiB;
constexpr size_t WS_WPQ = 21 * MiB;
constexpr size_t WS_XN = 26 * MiB;
constexpr size_t WS_BC = 26 * MiB;
constexpr size_t WS_BT = 58 * MiB;
constexpr size_t WS_ACSF = 74 * MiB, WS_DTF = 76 * MiB, WS_RACSB = 78 * MiB, WS_DTB = 80 * MiB;
constexpr size_t WS_RQ = 82 * MiB, WS_RKV = 82 * MiB + 256 * 1024;
constexpr size_t WS_COS = 83 * MiB, WS_SIN = 85 * MiB;
constexpr size_t WS_KR = 508 * MiB;
constexpr size_t WS_YM = 26 * MiB;
constexpr size_t WS_PU = 490 * MiB, WS_PV = 42 * MiB;
constexpr size_t WS_PUS = 506 * MiB, WS_PVS = 59 * MiB;
constexpr size_t WS_Z = 90 * MiB;
constexpr size_t WS_YS = WS_Z;
constexpr size_t WS_G = 154 * MiB;
constexpr size_t WS_QA = 282 * MiB;
constexpr size_t WS_KVA = 314 * MiB;
constexpr size_t WS_XBC = 330 * MiB;
constexpr size_t WS_ST = 330 * MiB;
constexpr size_t WS_K = 330 * MiB;
constexpr size_t WS_VT = 426 * MiB;
constexpr size_t WS_M = 282 * MiB;
constexpr size_t WS_HB = 346 * MiB;
constexpr size_t WS_SSQ = 410 * MiB;
constexpr size_t WS_SC = 90 * MiB;
constexpr size_t WS_END = 510 * MiB;

constexpr int LDS_BYTES = 147456;

struct Args { const float* in[25]; float* out; unsigned char* ws; };
#define KIN(i) (((const float* const*)__builtin_amdgcn_kernarg_segment_ptr())[(i)])
#define KOUT() (((float* const*)__builtin_amdgcn_kernarg_segment_ptr())[25])
#define KWS() (((unsigned char* const*)__builtin_amdgcn_kernarg_segment_ptr())[26])

#define AMAXV(w) __builtin_bit_cast(float, (unsigned)(w))
template <int NB, class MapF>
__device__ __forceinline__ void transpose_w(const float* __restrict__ W, int K, int Nsrc, bf16_t* __restrict__ Wt, int Ndst, const float* __restrict__ scale, float cs, MapF mapf, int gtid, int gn) {
    const int items = Ndst * (K / 8);
    for (int it0 = gtid; it0 < items; it0 += NB * gn) {
        float v[NB][8];
#pragma unroll
        for (int b = 0; b < NB; ++b) { const int it = it0 + b * gn; const bool ok = it < items; const int n = it % Ndst, k0 = (it / Ndst) * 8; const int src = ok ? mapf(n) : -1;
#pragma unroll
            for (int j = 0; j < 8; ++j) { float w = (src >= 0) ? W[(size_t)(k0 + j) * Nsrc + src] : 0.f; if (scale && ok) w *= scale[k0 + j]; v[b][j] = w * cs; } }
#pragma unroll
        for (int b = 0; b < NB; ++b) { const int it = it0 + b * gn; if (it < items) { const int n = it % Ndst, k0 = (it / Ndst) * 8;
            *(u32x4*)(Wt + (size_t)n * K + k0) = (u32x4){pk2(v[b][0], v[b][1]), pk2(v[b][2], v[b][3]), pk2(v[b][4], v[b][5]), pk2(v[b][6], v[b][7])}; } }
    }
}
template <int F8OUT = 0, class MapF>
__device__ __forceinline__ void transpose_tile(const float* __restrict__ W, int K, int Nsrc, bf16_t* __restrict__ Wt, const float* __restrict__ scale, float cs, MapF mapf, LAS float* scr, int item, int lane, const unsigned* amax = nullptr) {
    const int nkb = K >> 6; const int kb = item % nkb, nb = item / nkb, k0 = 64 * kb, n0 = 32 * nb;
    const int sb = mapf(n0);
    const int r = lane >> 3, c = lane & 7;
    f32x4 v[8];
#pragma unroll
    for (int i = 0; i < 8; ++i) v[i] = (sb >= 0) ? *(const f32x4*)(W + (size_t)(k0 + 8 * i + r) * Nsrc + sb + 4 * c) : (f32x4){0.f, 0.f, 0.f, 0.f};
    f32x4 s0 = (f32x4){cs, cs, cs, cs}, s1 = s0;
    if (scale) { s0 = *(const f32x4*)(scale + k0 + 8 * c) * cs; s1 = *(const f32x4*)(scale + k0 + 8 * c + 4) * cs; }
#pragma unroll
    for (int i = 0; i < 8; ++i)
#pragma unroll
        for (int j = 0; j < 4; ++j) scr[(8 * i + r) * 33 + 4 * c + j] = v[i][j];
    asm volatile("s_waitcnt lgkmcnt(0)" ::: "memory");
#pragma unroll
    for (int j = 0; j < 4; ++j) { const int n = r + 8 * j; const int col = (sb >= 0) ? mapf(n0 + n) - sb : 0; const LAS float* sp = scr + (8 * c) * 33 + col;
        if (F8OUT == 2) { const float f_ = 127.f / fmaxf(AMAXV(amax[n0 + n]), 1e-30f);
            *(u32x2*)((unsigned char*)Wt + (size_t)(n0 + n) * K + k0 + 8 * c) = (u32x2){pack_i8x4(sp[0 * 33] * s0[0] * f_, sp[1 * 33] * s0[1] * f_, sp[2 * 33] * s0[2] * f_, sp[3 * 33] * s0[3] * f_), pack_i8x4(sp[4 * 33] * s1[0] * f_, sp[5 * 33] * s1[1] * f_, sp[6 * 33] * s1[2] * f_, sp[7 * 33] * s1[3] * f_)}; }
        else if (F8OUT == 1) *(u32x2*)((unsigned char*)Wt + (size_t)(n0 + n) * K + k0 + 8 * c) = (u32x2){pack4_fp8(sp[0 * 33] * s0[0], sp[1 * 33] * s0[1], sp[2 * 33] * s0[2], sp[3 * 33] * s0[3]), pack4_fp8(sp[4 * 33] * s1[0], sp[5 * 33] * s1[1], sp[6 * 33] * s1[2], sp[7 * 33] * s1[3])};
        else { const u32x4 o = (u32x4){pk2(sp[0 * 33] * s0[0], sp[1 * 33] * s0[1]), pk2(sp[2 * 33] * s0[2], sp[3 * 33] * s0[3]), pk2(sp[4 * 33] * s1[0], sp[5 * 33] * s1[1]), pk2(sp[6 * 33] * s1[2], sp[7 * 33] * s1[3])};
        *(u32x4*)(Wt + (size_t)(n0 + n) * K + k0 + 8 * c) = o; } }
    asm volatile("s_waitcnt lgkmcnt(0)" ::: "memory");
}
template <class MapF>
__device__ __forceinline__ void colmax_tile(const float* __restrict__ W, int K, int Nsrc, const float* __restrict__ scale, MapF mapf, unsigned* amax, int item, int lane) {
    const int nkb = K >> 6; const int kb = item % nkb, nb = item / nkb, k0 = 64 * kb, n0 = 32 * nb;
    const int sb = mapf(n0); if (sb < 0) return;
    const int r = lane >> 3, c = lane & 7;
    f32x4 m = (f32x4){0.f, 0.f, 0.f, 0.f};
#pragma unroll
    for (int i = 0; i < 8; ++i) { const f32x4 v = *(const f32x4*)(W + (size_t)(k0 + 8 * i + r) * Nsrc + sb + 4 * c); const float sc = scale ? scale[k0 + 8 * i + r] : 1.f;
#pragma unroll
        for (int j = 0; j < 4; ++j) m[j] = fmaxf(m[j], fabsf(v[j] * sc)); }
#pragma unroll
    for (int j = 0; j < 4; ++j) { float x = m[j]; x = fmaxf(x, __shfl_xor(x, 8)); x = fmaxf(x, __shfl_xor(x, 16)); x = fmaxf(x, __shfl_xor(x, 32));
        if (r == 0) atomicMax(amax + n0 + 4 * c + j, __builtin_bit_cast(unsigned, x)); }
}
struct MapIn { __device__ int operator()(int n) const {
    if (n < 2560) return n;
    if (n < 4608) return 3264 + (n - 2560);
    if (n < 4992) return 2592 + (n - 4608);
    if (n < 5024) return 2560 + (n - 4992);
    if (n < 5056) return 3232 + (n - 5024);
    if (n < 5120) return -1;
    return 2976 + (n - 5120); } };
struct MapInA { __device__ int operator()(int n) const { return n < 2560 ? n : MapIn()(4608 + (n - 2560)); } };
struct MapInB { __device__ int operator()(int n) const { return n < 2048 ? 3264 + n : 2976 + (n - 2048); } };
struct MapQ { __device__ int operator()(int n) const { const int h = n / 96, dd = n % 96; if (dd < 64) return n; const int j = dd - 64, i = j >> 1; return h * 96 + 64 + ((j & 1) ? 16 + i : i); } };
struct MapKn { __device__ int operator()(int n) const { return (n >> 6) * 128 + (n & 63); } };
struct MapV { __device__ int operator()(int n) const { return (n >> 6) * 128 + 64 + (n & 63); } };
struct MapId { __device__ int operator()(int n) const { return n; } };

__device__ __forceinline__ void p0_wpq_item(const float* __restrict__ wq, const float* __restrict__ keys, const float* __restrict__ nw, bf16_t* __restrict__ Wpq, unsigned* wamax, LAS unsigned char* lds, int item) {
    LAS float* kl = (LAS float*)lds;
    LAS float* wl = (LAS float*)(lds + 128 * 132 * 4);
    const int tid = opaque_tid();
    const int hh2 = item >> 4, slab = item & 15, half = hh2 & 1, k0 = slab * 64;
    LAS unsigned* rmx = (LAS unsigned*)(lds + 128 * 132 * 4 + 128 * 68 * 4);
    if (tid < 128) rmx[tid] = 0u;
    {
        f32x4 kv[8], wv[4];
#pragma unroll
        for (int it = 0; it < 8; ++it) { const int i = tid + NT * it, key = i & 127, d4 = i >> 7; kv[it] = *(const f32x4*)(keys + (size_t)half * 16384 + key * 128 + d4 * 4); }
#pragma unroll
        for (int it = 0; it < 4; ++it) { const int i = tid + NT * it, kk = i & 63, d4 = i >> 6; wv[it] = *(const f32x4*)(wq + (size_t)(k0 + kk) * 2048 + hh2 * 128 + d4 * 4); }
#pragma unroll
        for (int it = 0; it < 8; ++it) { const int i = tid + NT * it, key = i & 127, d4 = i >> 7;
#pragma unroll
            for (int j = 0; j < 4; ++j) kl[(4 * d4 + j) * 132 + key] = kv[it][j]; }
#pragma unroll
        for (int it = 0; it < 4; ++it) { const int i = tid + NT * it, kk = i & 63, d4 = i >> 6;
#pragma unroll
            for (int j = 0; j < 4; ++j) wl[(4 * d4 + j) * 68 + kk] = wv[it][j]; }
    }
    __syncthreads();
    const int kq = tid & 31, kg = tid >> 5;
    f32x4 acc[4];
#pragma unroll
    for (int i = 0; i < 4; ++i) acc[i] = (f32x4){0.f, 0.f, 0.f, 0.f};
#pragma unroll 8
    for (int d = 0; d < 128; ++d) {
        const f32x4 kv = *(const LAS f32x4*)(kl + d * 132 + 4 * kq), wv = *(const LAS f32x4*)(wl + d * 68 + 4 * kg);
#pragma unroll
        for (int i = 0; i < 4; ++i) acc[i] += kv * wv[i];
    }
    const int kb = k0 + 4 * kg;
    const f32x4 nv = *(const f32x4*)(nw + kb);
#pragma unroll
    for (int j = 0; j < 4; ++j) {
        *(u32x2*)(Wpq + (size_t)(hh2 * 128 + 4 * kq + j) * 1024 + kb) = (u32x2){pk2(acc[0][j] * nv[0], acc[1][j] * nv[1]), pk2(acc[2][j] * nv[2], acc[3][j] * nv[3])};
        const float mx = fmaxf(fmaxf(fabsf(acc[0][j] * nv[0]), fabsf(acc[1][j] * nv[1])), fmaxf(fabsf(acc[2][j] * nv[2]), fabsf(acc[3][j] * nv[3])));
        __hip_atomic_fetch_max(rmx + 4 * kq + j, __builtin_bit_cast(unsigned, mx), __ATOMIC_RELAXED, __HIP_MEMORY_SCOPE_WORKGROUP); }
    __syncthreads();
    if (tid < 128) atomicMax(wamax + hh2 * 128 + tid, rmx[tid]);
}
__device__ __forceinline__ void rms_row_to_bf16(const float* xrow, bf16_t* orow, int lane) {
    const f32x4* xr = (const f32x4*)xrow + lane;
    f32x4 v[4]; float s = 0.f;
#pragma unroll
    for (int j = 0; j < 4; ++j) { v[j] = xr[64 * j]; s += (v[j].x * v[j].x + v[j].y * v[j].y) + (v[j].z * v[j].z + v[j].w * v[j].w); }
    const float rstd = 1.f / sqrtf(wave_sum(s) * (1.f / DM) + EPS);
    u32x2* o8 = (u32x2*)orow + lane;
#pragma unroll
    for (int j = 0; j < 4; ++j) o8[64 * j] = (u32x2){pk2(v[j].x * rstd, v[j].y * rstd), pk2(v[j].z * rstd, v[j].w * rstd)};
}
template <int NR>
__device__ __forceinline__ void rms_rows_to_bf16(const float* x, bf16_t* o, float* xsc, int m0, int mstride, int lane) {
    f32x4 v[NR][4];
#pragma unroll
    for (int r = 0; r < NR; ++r) { const f32x4* xr = (const f32x4*)(x + (size_t)(m0 + r * mstride) * DM) + lane;
#pragma unroll
        for (int j = 0; j < 4; ++j) v[r][j] = xr[64 * j]; }
#pragma unroll
    for (int r = 0; r < NR; ++r) { float s = 0.f, am = 0.f;
#pragma unroll
        for (int j = 0; j < 4; ++j) { s += (v[r][j].x * v[r][j].x + v[r][j].y * v[r][j].y) + (v[r][j].z * v[r][j].z + v[r][j].w * v[r][j].w);
            am = fmaxf(am, fmaxf(fmaxf(fabsf(v[r][j].x), fabsf(v[r][j].y)), fmaxf(fabsf(v[r][j].z), fabsf(v[r][j].w)))); }
        const float rstd = 1.f / sqrtf(wave_sum_fast(s) * (1.f / DM) + EPS);
        am = fmaxf(wave_max(am), 1e-30f);
        const float f_ = 127.f / am;
        if (lane == 0) xsc[m0 + r * mstride] = am * rstd * (1.f / 127.f);
#pragma unroll
        for (int j = 0; j < 4; ++j) ((unsigned*)((unsigned char*)o + (size_t)(m0 + r * mstride) * DM))[64 * j + lane] = pack_i8x4(v[r][j].x * f_, v[r][j].y * f_, v[r][j].z * f_, v[r][j].w * f_); }
}
__device__ __forceinline__ void p0_prologue_a(const Args& a, LAS unsigned char* lds) {
    unsigned char* ws = KWS();
    const int tid_ = opaque_tid(); const int wave = tid_ >> 6, lane = tid_ & 63;
    const int gw = opaque_bx() * NW + wave, ngw = gridDim.x * NW;
    for (int it = gw; it < 16 * (IN_PAD / 32); it += ngw) colmax_tile(KIN(3), 1024, 5312, KIN(2), MapIn(), (unsigned*)(ws + WS_CTL + WS_WAMAX), it, lane);
    for (int it = gw; it < 16 * 32; it += ngw) colmax_tile(KIN(18), 1024, 1024, (const float*)nullptr, MapId(), (unsigned*)(ws + WS_CTL + WS_WOAMAX), it, lane);
    for (int m = gw; m < TOK; m += 4 * ngw) rms_rows_to_bf16<4>(KIN(0), (bf16_t*)(ws + WS_XN), (float*)(ws + WS_XSC), m, ngw, lane);
    __syncthreads();
    for (int it = opaque_bx(); it < 256; it += gridDim.x) p0_wpq_item(KIN(20), KIN(21), KIN(19), (bf16_t*)(ws + WS_WPQ), (unsigned*)(ws + WS_CTL + WS_WPAMAX), lds, it);
}
__device__ __forceinline__ void p0_prologue_b(const Args& a, LAS unsigned char* lds) {
    unsigned char* ws = KWS();
    const int gtid = opaque_bx() * NT + opaque_tid(), gn = gridDim.x * NT;
    {
        const int tid0 = opaque_tid(); const int wave0 = tid0 >> 6, lane0 = tid0 & 63;
        LAS float* scr = (LAS float*)lds + wave0 * (64 * 33);
        constexpr int C0 = 16 * (IN_PAD / 32), C1 = C0 + 6 * 48, C2 = C1 + 4 * 32, C3 = C2 + 4 * 32, C4 = C3 + 16 * 32, C5 = C4 + 16 * 32, C6 = C5 + 16 * 32;
        for (int it = opaque_bx() * NW + wave0; it < C6; it += gridDim.x * NW) {
            if (it < C0) transpose_tile<2>(KIN(3), 1024, 5312, (bf16_t*)(ws + WS_WIN), KIN(2), 1.f, MapIn(), scr, it, lane0, (const unsigned*)(ws + WS_CTL + WS_WAMAX));
            else if (it < C1) transpose_tile(KIN(13), 384, 1536, (bf16_t*)(ws + WS_WQB), KIN(12), QSCALE, MapQ(), scr, it - C0, lane0);
            else if (it < C2) transpose_tile(KIN(15), 256, 2048, (bf16_t*)(ws + WS_WK), KIN(14), 1.f, MapKn(), scr, it - C1, lane0);
            else if (it < C3) transpose_tile(KIN(15), 256, 2048, (bf16_t*)(ws + WS_WV), KIN(14), 1.f, MapV(), scr, it - C2, lane0);
            else if (it < C4) transpose_tile<1>(KIN(16), 1024, 1024, (bf16_t*)(ws + WS_PA), KIN(11), WIN_SCALE, MapId(), scr, it - C3, lane0);
            else if (it < C5) transpose_tile<1>(KIN(17), 1024, 1024, (bf16_t*)(ws + WS_PB), (const float*)nullptr, WIN_SCALE, MapId(), scr, it - C4, lane0);
            else transpose_tile<2>(KIN(18), 1024, 1024, (bf16_t*)(ws + WS_WOUT), (const float*)nullptr, 1.f, MapId(), scr, it - C5, lane0, (const unsigned*)(ws + WS_CTL + WS_WOAMAX));
        }
        __syncthreads();
    }
    for (int i = gtid; i < 2048 * 64; i += gn) { const int n = i >> 6;
        const u32x4* src = (const u32x4*)((const bf16_t*)(ws + WS_WPQ) + (size_t)i * 16); const u32x4 r0 = src[0], r1 = src[1];
        const float f_ = 127.f / fmaxf(AMAXV(((const unsigned*)(ws + WS_CTL + WS_WPAMAX))[n]), 1e-30f);
        *(u32x4*)(ws + WS_WPQ8 + (size_t)i * 16) = (u32x4){pack_i8x4(bflo(r0[0]) * f_, bfhi(r0[0]) * f_, bflo(r0[1]) * f_, bfhi(r0[1]) * f_), pack_i8x4(bflo(r0[2]) * f_, bfhi(r0[2]) * f_, bflo(r0[3]) * f_, bfhi(r0[3]) * f_),
                                                         pack_i8x4(bflo(r1[0]) * f_, bfhi(r1[0]) * f_, bflo(r1[1]) * f_, bfhi(r1[1]) * f_), pack_i8x4(bflo(r1[2]) * f_, bfhi(r1[2]) * f_, bflo(r1[3]) * f_, bfhi(r1[3]) * f_)}; }
}

typedef int i32x4_e __attribute__((ext_vector_type(4)));
struct EpiInProj {
    bf16_t *Z, *XBC, *G, *QA, *KVA; const float* xsc; const unsigned* amax;
    __device__ __forceinline__ void operator()(const f32x4 (&acc)[2][2][4][2], const pg8::Unit& u, int wr, int wc, int fr, int fq) const {
        const int pn = u.pn; bf16_t* base; int ldc, cb, act;
        if (pn < 4) { base = Z; ldc = 1024; cb = pn * 256; act = 1; }
        else if (pn < 10) { base = XBC; ldc = 1536; cb = (pn - 4) * 256; act = 0; }
        else if (pn < 18) { base = G; ldc = 2048; cb = (pn - 10) * 256; act = 2; }
        else if (pn < 20) { base = QA; ldc = 512; cb = (pn - 18) * 256; act = 0; }
        else { base = KVA; ldc = 256; cb = 0; act = 0; }
        f32x4 cs[2][2];
#pragma unroll
        for (int bj = 0; bj < 2; ++bj) { const u32x4* ap = (const u32x4*)(amax + u.pn * 256 + bj * 128 + wc * 32 + 8 * fq);
#pragma unroll
            for (int h = 0; h < 2; ++h) { const u32x4 w = ap[h];
#pragma unroll
                for (int j = 0; j < 4; ++j) cs[bj][h][j] = AMAXV(w[j]) * (1.f / 127.f); } }
#pragma unroll
        for (int ai = 0; ai < 2; ++ai)
#pragma unroll
            for (int m = 0; m < 4; ++m) { const int row = u.pm * 256 + ai * 128 + wr * 64 + m * 16 + fr; const float rs = xsc[row];
#pragma unroll
                for (int bj = 0; bj < 2; ++bj) { const int c = cb + bj * 128 + wc * 32 + 8 * fq;
                    f32x4 v0, v1;
                    const i32x4_e i0 = __builtin_bit_cast(i32x4_e, acc[ai][bj][m][0]), i1 = __builtin_bit_cast(i32x4_e, acc[ai][bj][m][1]);
#pragma unroll
                    for (int j = 0; j < 4; ++j) { v0[j] = (float)i0[j] * rs * cs[bj][0][j]; v1[j] = (float)i1[j] * rs * cs[bj][1][j]; }
                    if (act == 1) {
#pragma unroll
                        for (int j = 0; j < 4; ++j) { v0[j] = siluf_(v0[j]); v1[j] = siluf_(v1[j]); }
                    }
                    if (act == 2) {
                        unsigned q[8];
#pragma unroll
                        for (int j = 0; j < 4; ++j) { q[j] = (unsigned)(sigmoidf_(v0[j]) * 255.f + 0.5f); q[4 + j] = (unsigned)(sigmoidf_(v1[j]) * 255.f + 0.5f); }
                        *(u32x2*)((unsigned char*)base + (size_t)row * 2048 + c) = (u32x2){q[0] | (q[1] << 8) | (q[2] << 16) | (q[3] << 24), q[4] | (q[5] << 8) | (q[6] << 16) | (q[7] << 24)};
                    } else
                        *(u32x4*)(base + (size_t)row * ldc + c) = (u32x4){pk2(v0[0], v0[1]), pk2(v0[2], v0[3]), pk2(v1[0], v1[1]), pk2(v1[2], v1[3])};
                }
                if (m == 3) asm volatile("" ::: "memory"); }
    }
};
constexpr int CONV_ITEMS = (TOK / 64) * 6;
struct ConvRaw { u32x4 v[5]; };
__device__ __forceinline__ void p2_conv_load(const bf16_t* __restrict__ XBC, int item, int tid, ConvRaw& R) {
    const int slab = item / 6, grp = item % 6, t0 = slab * 64, b = t0 / SEQ, s0 = t0 % SEQ, c0 = grp * 256;
#pragma unroll
    for (int i = 0; i < 5; ++i) { const int ci = tid + NT * i, r = ci >> 5, ch = ci & 31, tok = s0 - 1 + r;
        R.v[i] = (u32x4){0u, 0u, 0u, 0u};
        if (ci < 66 * 32 && tok >= 0 && tok < SEQ) R.v[i] = *(const u32x4*)(XBC + (size_t)(b * SEQ + tok) * 1536 + c0 + ch * 8); }
}
__device__ __forceinline__ void p2_conv_item(const ConvRaw& R, const float* __restrict__ conv_w, const float* __restrict__ conv_b,
                                             bf16_t* __restrict__ XS, bf16_t* __restrict__ XST, bf16_t* __restrict__ BC, bf16_t* __restrict__ BT, LAS unsigned char* lds, int item, int tid) {
    const int slab = item / 6, grp = item % 6, t0 = slab * 64, b = t0 / SEQ, s0 = t0 % SEQ, c0 = grp * 256;
    LAS unsigned char* rawl = lds;
    LAS unsigned char* outl = lds + 66 * 528;
#pragma unroll
    for (int i = 0; i < 5; ++i) { const int ci = tid + NT * i, r = ci >> 5, ch = ci & 31; if (ci < 66 * 32) *(LAS u32x4*)(rawl + r * 528 + ch * 16) = R.v[i]; }
    __syncthreads();
    {
        const int ch = tid & 31, tk = tid >> 5;
        float w0[8], w1[8], w2[8], bb[8];
#pragma unroll
        for (int j = 0; j < 8; ++j) { const int c = c0 + ch * 8 + j; w0[j] = conv_w[c]; w1[j] = conv_w[1536 + c]; w2[j] = conv_w[3072 + c]; bb[j] = conv_b[c]; }
#pragma unroll
        for (int i = 0; i < 4; ++i) {
            const int tt = tk + 16 * i;
            const u32x4 xa = *(const LAS u32x4*)(rawl + tt * 528 + ch * 16), xb = *(const LAS u32x4*)(rawl + (tt + 1) * 528 + ch * 16), xc = *(const LAS u32x4*)(rawl + (tt + 2) * 528 + ch * 16);
            float y[8];
#pragma unroll
            for (int q = 0; q < 4; ++q) {
                y[2 * q] = bb[2 * q] + w0[2 * q] * bflo(xa[q]) + w1[2 * q] * bflo(xb[q]) + w2[2 * q] * bflo(xc[q]);
                y[2 * q + 1] = bb[2 * q + 1] + w0[2 * q + 1] * bfhi(xa[q]) + w1[2 * q + 1] * bfhi(xb[q]) + w2[2 * q + 1] * bfhi(xc[q]);
            }
#pragma unroll
            for (int j = 0; j < 8; ++j) y[j] = siluf_(y[j]);
            const u32x4 o = (u32x4){pk2(y[0], y[1]), pk2(y[2], y[3]), pk2(y[4], y[5]), pk2(y[6], y[7])};
            if (grp >= 4) *(u32x4*)(BC + (size_t)(t0 + tt) * 512 + (grp - 4) * 256 + ch * 8) = o;
            *(LAS u32x4*)(outl + tt * 528 + ch * 16) = o;
        }
    }
    __syncthreads();
    if (grp < 5) {
        bf16_t* dstT = (grp < 4) ? XST + ((size_t)b * 1024 + c0) * SEQ : BT + (size_t)b * 256 * SEQ;
#pragma unroll
        for (int i = 0; i < 4; ++i) {
            const int idx = tid + NT * i, tch = idx & 7, c = idx >> 3;
            unsigned short v[8];
#pragma unroll
            for (int j = 0; j < 8; ++j) v[j] = *(const LAS unsigned short*)(outl + (tch * 8 + j) * 528 + c * 2);
            const u32x4 o = (u32x4){(unsigned)v[0] | ((unsigned)v[1] << 16), (unsigned)v[2] | ((unsigned)v[3] << 16), (unsigned)v[4] | ((unsigned)v[5] << 16), (unsigned)v[6] | ((unsigned)v[7] << 16)};
            *(u32x4*)(dstT + (size_t)c * SEQ + s0 + tch * 8) = o;
        }
    }
    __syncthreads();
}
__device__ __forceinline__ float softplusf_(float x) { return fmaxf(x, 0.f) + log1pf(__expf(-fabsf(x))); }
__device__ __forceinline__ void p2_dt_item(const Args& a, int item, int lane) {
    unsigned char* ws = KWS();
    const bf16_t* QA = (const bf16_t*)(ws + WS_QA);
    const int hh = item & 15, bc = item >> 4, b = bc >> 5, c = bc & 31;
    const int t0 = b * SEQ + c * CHUNK, s = 2 * lane;
    const float bf = KIN(6)[hh], bbw = KIN(7)[hh], Af = -__expf(KIN(8)[hh]), Ab = -__expf(KIN(9)[hh]);
    const float dtf0 = softplusf_(bf1(QA[(size_t)(t0 + s) * 512 + 384 + hh]) + bf), dtf1 = softplusf_(bf1(QA[(size_t)(t0 + s + 1) * 512 + 384 + hh]) + bf);
    const float dtb0 = softplusf_(bf1(QA[(size_t)(t0 + s) * 512 + 400 + hh]) + bbw), dtb1 = softplusf_(bf1(QA[(size_t)(t0 + s + 1) * 512 + 400 + hh]) + bbw);
    const float af0 = dtf0 * Af, af1 = dtf1 * Af, ab0 = dtb0 * Ab, ab1 = dtb1 * Ab;
    float sf = af0 + af1, sb = ab0 + ab1;
#pragma unroll
    for (int o = 1; o < 64; o <<= 1) { const float uf = __shfl_up(sf, o), ub = __shfl_up(sb, o); if (lane >= o) { sf += uf; sb += ub; } }
    const float totb = __shfl(sb, 63);
    const float pref = sf - (af0 + af1), preb = sb - (ab0 + ab1);
    const size_t idx = ((size_t)(b * 16 + hh)) * SEQ + c * CHUNK + s;
    *(f32x2*)((float*)(ws + WS_ACSF) + idx) = (f32x2){pref + af0, pref + af0 + af1};
    *(f32x2*)((float*)(ws + WS_DTF) + idx) = (f32x2){dtf0, dtf1};
    *(f32x2*)((float*)(ws + WS_RACSB) + idx) = (f32x2){totb - preb, totb - preb - ab0};
    *(f32x2*)((float*)(ws + WS_DTB) + idx) = (f32x2){dtb0, dtb1};
}
template <int NTK>
__device__ __forceinline__ void p2_tok_items(const Args& a, int t0, int tstride, int lane) {
    unsigned char* ws = KWS();
    const bf16_t* QA = (const bf16_t*)(ws + WS_QA); const bf16_t* KVA = (const bf16_t*)(ws + WS_KVA);
    u32x4 qv[NTK], kv[NTK]; float pos[NTK], x1[NTK], x2[NTK];
#pragma unroll
    for (int k = 0; k < NTK; ++k) {
        const int t = t0 + k * tstride;
        qv[k] = (u32x4){0u, 0u, 0u, 0u}; kv[k] = (u32x4){0u, 0u, 0u, 0u}; pos[k] = 0.f; x1[k] = 0.f; x2[k] = 0.f;
        if (lane < 48) qv[k] = *(const u32x4*)(QA + (size_t)t * 512 + lane * 8);
        if (lane < 32) kv[k] = *(const u32x4*)(KVA + (size_t)t * 256 + lane * 8);
        if (lane < 16) { pos[k] = (float)((const int*)KIN(1))[t]; x1[k] = bf1(QA[(size_t)t * 512 + 416 + lane]); x2[k] = bf1(QA[(size_t)t * 512 + 432 + lane]); }
    }
#pragma unroll
    for (int k = 0; k < NTK; ++k) {
        const int t = t0 + k * tstride;
        float sq = 0.f, sk = 0.f;
#pragma unroll
        for (int q = 0; q < 4; ++q) { const float x = bflo(qv[k][q]), y = bfhi(qv[k][q]); sq += x * x + y * y; const float z = bflo(kv[k][q]), w = bfhi(kv[k][q]); sk += z * z + w * w; }
        sq = wave_sum_fast(sq); sk = wave_sum_fast(sk);
        if (lane == 0) { ((float*)(ws + WS_RQ))[t] = 1.f / sqrtf(sq * (1.f / 384.f) + EPS); ((float*)(ws + WS_RKV))[t] = 1.f / sqrtf(sk * (1.f / 256.f) + EPS); }
        if (lane < 16) {
            const int i = lane;
            const float inv = exp2f(-(float)i * (13.287712379549449f / 16.f));
            const float ang = pos[k] * inv;
            const float kk = rintf(ang * 0.15915494309189535f);
            float r = fmaf(-kk, 6.28318548202514648f, ang); r = fmaf(-kk, -1.7484555e-7f, r);
            const float sn = __sinf(r), cs = __cosf(r);
            ((unsigned short*)(ws + WS_KR))[(size_t)t * 16 + i] = (unsigned short)__builtin_amdgcn_cvt_pk_fp8_f32(x1[k] * cs - x2[k] * sn, x1[k] * sn + x2[k] * cs, 0, false);
            ((float*)(ws + WS_COS))[(size_t)t * 16 + i] = cs; ((float*)(ws + WS_SIN))[(size_t)t * 16 + i] = sn;
        }
    }
}
__device__ __forceinline__ void p2_prep(const Args& a, LAS unsigned char* lds) {
    unsigned char* ws = KWS();
    const int tid_ = opaque_tid(); const int wave = tid_ >> 6, lane = tid_ & 63;
    {
        const bf16_t* XBC = (const bf16_t*)(ws + WS_XBC); const int G = gridDim.x;
        int it = opaque_bx();
        ConvRaw Ra, Rb;
        if (it < CONV_ITEMS) p2_conv_load(XBC, it, tid_, Ra);
        for (; it < CONV_ITEMS; it += 2 * G) {
            if (it + G < CONV_ITEMS) p2_conv_load(XBC, it + G, tid_, Rb);
            p2_conv_item(Ra, KIN(4), KIN(5), (bf16_t*)KOUT(), (bf16_t*)KOUT() + (size_t)TOK * 1024, (bf16_t*)(ws + WS_BC), (bf16_t*)(ws + WS_BT), lds, it, tid_);
            if (it + G < CONV_ITEMS) {
                if (it + 2 * G < CONV_ITEMS) p2_conv_load(XBC, it + 2 * G, tid_, Ra);
                p2_conv_item(Rb, KIN(4), KIN(5), (bf16_t*)KOUT(), (bf16_t*)KOUT() + (size_t)TOK * 1024, (bf16_t*)(ws + WS_BC), (bf16_t*)(ws + WS_BT), lds, it + G, tid_);
            }
        }
    }
    const int gw = opaque_bx() * NW + wave, ngw = gridDim.x * NW;
    for (int it = gw; it < BATCH * NCHUNK * 16; it += ngw) p2_dt_item(a, it, lane);
    for (int t = gw; t < TOK; t += 4 * ngw) p2_tok_items<4>(a, t, ngw, lane);
}

__device__ __forceinline__ bf16x8 ld8(const bf16_t* p) { return *(const bf16x8*)p; }
__device__ __forceinline__ bf16x8 scale8(bf16x8 v, const float (&w)[8]) {
    const u32x4 u = __builtin_bit_cast(u32x4, v); u32x4 o;
#pragma unroll
    for (int q = 0; q < 4; ++q) o[q] = pk2(bflo(u[q]) * w[2 * q], bfhi(u[q]) * w[2 * q + 1]);
    return __builtin_bit_cast(bf16x8, o);
}
__device__ __forceinline__ bf16x8 scale8a(bf16x8 v, const float (&w)[8], const float (&ad)[8]) {
    const u32x4 u = __builtin_bit_cast(u32x4, v); u32x4 o;
#pragma unroll
    for (int q = 0; q < 4; ++q) o[q] = pk2(bflo(u[q]) * w[2 * q] + ad[2 * q], bfhi(u[q]) * w[2 * q + 1] + ad[2 * q + 1]);
    return __builtin_bit_cast(bf16x8, o);
}
__device__ __forceinline__ bf16x8 scale8s(bf16x8 v, float w) {
    const u32x4 u = __builtin_bit_cast(u32x4, v); u32x4 o;
#pragma unroll
    for (int q = 0; q < 4; ++q) o[q] = pk2(bflo(u[q]) * w, bfhi(u[q]) * w);
    return __builtin_bit_cast(bf16x8, o);
}
#define MFMA32(a, b, c) __builtin_amdgcn_mfma_f32_32x32x16_bf16((a), (b), (c), 0, 0, 0)

__device__ __forceinline__ void p3_states_unit(const Args& a, LAS unsigned char* lds, int unit) {
    unsigned char* ws = KWS();
    const int tid_ = opaque_tid(); const int lane = tid_ & 63, wave = tid_ >> 6, r32 = lane & 31, hi = lane >> 5;
    const int g = unit & 1, bc = unit >> 1, b = bc >> 5, c = bc & 31, hh = g * 8 + wave;
    const bf16_t* XST = (const bf16_t*)KOUT() + (size_t)TOK * 1024;
    const bf16_t* BT = (const bf16_t*)(ws + WS_BT);
    const size_t hbase = (size_t)(b * 16 + hh) * SEQ + c * CHUNK;
    LAS float* wl = (LAS float*)(lds + wave * 1024);
    {
        const float* ACSF = (const float*)(ws + WS_ACSF) + hbase; const float* DTF = (const float*)(ws + WS_DTF) + hbase;
        const float* RACSB = (const float*)(ws + WS_RACSB) + hbase; const float* DTB = (const float*)(ws + WS_DTB) + hbase;
        const float cendf = ACSF[CHUNK - 1], cendb = RACSB[0];
        const f32x2 cf = *(const f32x2*)(ACSF + 2 * lane), df = *(const f32x2*)(DTF + 2 * lane), cb = *(const f32x2*)(RACSB + 2 * lane), db = *(const f32x2*)(DTB + 2 * lane);
        *(LAS f32x2*)(wl + 2 * lane) = (f32x2){df.x * __expf(cendf - cf.x), df.y * __expf(cendf - cf.y)};
        *(LAS f32x2*)(wl + 128 + 2 * lane) = (f32x2){db.x * __expf(cendb - cb.x), db.y * __expf(cendb - cb.y)};
    }
    const bf16_t* xrow0 = XST + ((size_t)b * 1024 + hh * 64 + r32) * SEQ + c * CHUNK + 8 * hi;
    const bf16_t* brow0 = BT + ((size_t)b * 256 + g * 128 + r32) * SEQ + c * CHUNK + 8 * hi;
    bf16x8 xf[2][8];
#pragma unroll
    for (int pb = 0; pb < 2; ++pb)
#pragma unroll
        for (int ks = 0; ks < 8; ++ks) xf[pb][ks] = ld8(xrow0 + (size_t)(32 * pb) * SEQ + 16 * ks);
    asm volatile("s_waitcnt lgkmcnt(0)" ::: "memory");
#pragma unroll 1
    for (int nh = 0; nh < 2; ++nh) {
        bf16x8 bfr[2][8];
#pragma unroll
        for (int nb = 0; nb < 2; ++nb)
#pragma unroll
            for (int ks = 0; ks < 8; ++ks) bfr[nb][ks] = ld8(brow0 + (size_t)(32 * (2 * nh + nb)) * SEQ + 16 * ks);
#pragma unroll 1
        for (int dir = 0; dir < 2; ++dir) {
            f32x16 acc[2][2];
#pragma unroll
            for (int i = 0; i < 2; ++i)
#pragma unroll
                for (int j = 0; j < 2; ++j) acc[i][j] = f32x16{};
#pragma unroll
            for (int ks = 0; ks < 8; ++ks) {
                const f32x4 w0 = *(const volatile LAS f32x4*)(wl + dir * 128 + 16 * ks + 8 * hi), w1 = *(const volatile LAS f32x4*)(wl + dir * 128 + 16 * ks + 8 * hi + 4);
                const float w[8] = {w0[0], w0[1], w0[2], w0[3], w1[0], w1[1], w1[2], w1[3]};
#pragma unroll
                for (int pb = 0; pb < 2; ++pb) { u32x4 xr = __builtin_bit_cast(u32x4, xf[pb][ks]); asm volatile("" : "+v"(xr));
                    const bf16x8 xs = scale8(__builtin_bit_cast(bf16x8, xr), w);
#pragma unroll
                    for (int nb = 0; nb < 2; ++nb) acc[nb][pb] = MFMA32(bfr[nb][ks], xs, acc[nb][pb]); }
                __builtin_amdgcn_sched_barrier(0);
            }
            bf16_t* STo = (bf16_t*)(ws + WS_ST) + ((((size_t)(dir * BATCH + b) * NCHUNK + c) * 16 + hh) * 64 + r32) * 128 + 64 * nh + 4 * hi;
#pragma unroll
            for (int nb = 0; nb < 2; ++nb)
#pragma unroll
                for (int pb = 0; pb < 2; ++pb)
#pragma unroll
                    for (int q = 0; q < 4; ++q) {
                        const f32x16& v = acc[nb][pb];
                        *(u32x2*)(STo + (size_t)(32 * pb) * 128 + 32 * nb + 8 * q) = (u32x2){pk2(v[4 * q], v[4 * q + 1]), pk2(v[4 * q + 2], v[4 * q + 3])};
                    }
            __builtin_amdgcn_sched_barrier(0);
        }
    }
}
constexpr int P34_XT = 8192, P34_XROW = 272, P34_XDIR = 32 * P34_XROW, P34_XBUF = 2 * P34_XDIR;
constexpr int P34_BT = P34_XT + 2 * P34_XBUF, P34_BDIR = 128 * P34_XROW;
__device__ __forceinline__ void p34_chain(const Args& a, LAS unsigned char* lds, int unit) {
    unsigned char* ws = KWS();
    const int tid_ = opaque_tid(); const int lane = tid_ & 63, wave = tid_ >> 6, r32 = lane & 31, hi = lane >> 5;
    const int pb = unit & 1, bh = unit >> 1, b = bh >> 4, hh = bh & 15, g = hh >> 3;
    const int dir = wave >> 2, nbq = wave & 3;
    const float* CS = (const float*)(ws + (dir ? WS_RACSB : WS_ACSF)) + (size_t)(b * 16 + hh) * SEQ;
    const float* DT = (const float*)(ws + (dir ? WS_DTB : WS_DTF)) + (size_t)(b * 16 + hh) * SEQ;
    const int cendo = dir ? 0 : CHUNK - 1;
    bf16_t* STo = (bf16_t*)(ws + WS_ST) + ((((size_t)(dir * BATCH + b) * NCHUNK) * 16 + hh) * 64 + 32 * pb + r32) * 128 + 32 * nbq + 4 * hi;
    LAS float* wl = (LAS float*)(lds + wave * 1024);
    const int srow = tid_ >> 4, spc = tid_ & 15;
    const bf16_t* xg = (const bf16_t*)KOUT() + (size_t)TOK * 1024 + ((size_t)b * 1024 + hh * 64 + 32 * pb + srow) * SEQ + spc * 8;
    const bf16_t* bg = (const bf16_t*)(ws + WS_BT) + ((size_t)b * 256 + g * 128 + srow) * SEQ + spc * 8;
    const int sl = srow * P34_XROW + spc * 16;
    const int xfo = P34_XT + dir * P34_XDIR + r32 * P34_XROW + hi * 16, bfo = P34_BT + dir * P34_BDIR + (32 * nbq + r32) * P34_XROW + hi * 16;
    f32x16 P = f32x16{};
    const int c0 = dir ? NCHUNK - 1 : 0, cstep = dir ? -1 : 1;
    u32x4 sb0[8], sb1[8], sx0[2], sx1[2]; f32x2 cs0, dt0, cs1, dt1; float ce0, ce1;
#define P34_LOAD(SB, SX, CSv, DTv, CEv, idx) do { const int cf_ = (idx) * CHUNK, cb_ = (NCHUNK - 1 - (idx)) * CHUNK; \
        _Pragma("unroll") for (int k = 0; k < 4; ++k) { SB[k] = *(const u32x4*)(bg + (size_t)(32 * k) * SEQ + cf_); SB[4 + k] = *(const u32x4*)(bg + (size_t)(32 * k) * SEQ + cb_); } \
        SX[0] = *(const u32x4*)(xg + cf_); SX[1] = *(const u32x4*)(xg + cb_); \
        { const int t0_ = (c0 + (idx) * cstep) * CHUNK; CSv = *(const f32x2*)(CS + t0_ + 2 * lane); DTv = *(const f32x2*)(DT + t0_ + 2 * lane); CEv = CS[t0_ + cendo]; } } while (0)
#define P34_PUT(SB, SX, idx) do { \
        _Pragma("unroll") for (int k = 0; k < 4; ++k) { *(LAS u32x4*)(lds + P34_BT + sl + 32 * k * P34_XROW) = SB[k]; *(LAS u32x4*)(lds + P34_BT + P34_BDIR + sl + 32 * k * P34_XROW) = SB[4 + k]; } \
        LAS unsigned char* xb_ = lds + P34_XT + ((idx) & 1) * P34_XBUF + sl; *(LAS u32x4*)xb_ = SX[0]; *(LAS u32x4*)(xb_ + P34_XDIR) = SX[1]; } while (0)
#define P34_STEP(SB, SX, CSv, DTv, CEv, CSc, DTc, CEc, idx) do { \
        *(LAS f32x2*)(wl + 2 * lane) = (f32x2){DTc.x * __expf(CEc - CSc.x), DTc.y * __expf(CEc - CSc.y)}; \
        bf16x8 xf[8], bfr[8]; \
        _Pragma("unroll") for (int ks = 0; ks < 8; ++ks) { xf[ks] = *(const LAS bf16x8*)(lds + xfo + ((idx) & 1) * P34_XBUF + 32 * ks); bfr[ks] = *(const LAS bf16x8*)(lds + bfo + 32 * ks); } \
        const float dk = __expf(CEc); \
        asm volatile("s_waitcnt lgkmcnt(0)" ::: "memory"); \
        __syncthreads(); \
        if ((idx) + 1 < NCHUNK) P34_PUT(SB, SX, (idx) + 1); \
        if ((idx) + 3 < NCHUNK) P34_LOAD(SB, SX, CSv, DTv, CEv, (idx) + 3); \
        f32x16 acc = f32x16{}; \
        _Pragma("unroll") for (int ks = 0; ks < 8; ++ks) { \
            const f32x4 w0 = *(const volatile LAS f32x4*)(wl + 16 * ks + 8 * hi), w1 = *(const volatile LAS f32x4*)(wl + 16 * ks + 8 * hi + 4); \
            const float w[8] = {w0[0], w0[1], w0[2], w0[3], w1[0], w1[1], w1[2], w1[3]}; \
            acc = MFMA32(bfr[ks], scale8(xf[ks], w), acc); } \
        bf16_t* so = STo + (size_t)(c0 + (idx) * cstep) * 16 * 8192; \
        _Pragma("unroll") for (int q = 0; q < 4; ++q) *(u32x2*)(so + 8 * q) = (u32x2){pk2(P[4 * q], P[4 * q + 1]), pk2(P[4 * q + 2], P[4 * q + 3])}; \
        _Pragma("unroll") for (int r = 0; r < 16; ++r) P[r] = P[r] * dk + acc[r]; \
        asm volatile("s_waitcnt lgkmcnt(0)" ::: "memory"); \
        __syncthreads(); } while (0)
    P34_LOAD(sb0, sx0, cs0, dt0, ce0, 0); P34_LOAD(sb1, sx1, cs1, dt1, ce1, 1);
    __syncthreads();
    P34_PUT(sb0, sx0, 0);
    f32x2 csc = cs0, dtc = dt0; float cec = ce0;
    P34_LOAD(sb0, sx0, cs0, dt0, ce0, 2);
    asm volatile("s_waitcnt lgkmcnt(0)" ::: "memory");
    __syncthreads();
#pragma unroll 1
    for (int i = 0; i < NCHUNK; i += 2) {
        { const f32x2 csn = cs1, dtn = dt1; const float cen = ce1;
          P34_STEP(sb1, sx1, cs1, dt1, ce1, csc, dtc, cec, i);
          csc = csn; dtc = dtn; cec = cen; }
        { const f32x2 csn = cs0, dtn = dt0; const float cen = ce0;
          P34_STEP(sb0, sx0, cs0, dt0, ce0, csc, dtc, cec, i + 1);
          csc = csn; dtc = dtn; cec = cen; }
    }
#undef P34_STEP
#undef P34_PUT
#undef P34_LOAD
}
__device__ __forceinline__ void p4_scan(const Args& a) {
    unsigned char* ws = KWS();
    const int gtid = opaque_bx() * NT + opaque_tid(), gn = gridDim.x * NT;
    for (int it = gtid; it < 2 * BATCH * 16 * 1024; it += gn) {
        const int e8 = it & 1023, hh = (it >> 10) & 15, b = (it >> 14) & 7, dir = it >> 17;
        const float* CS = (const float*)(ws + (dir ? WS_RACSB : WS_ACSF)) + (size_t)(b * 16 + hh) * SEQ + (dir ? 0 : CHUNK - 1);
        bf16_t* base = (bf16_t*)(ws + WS_ST) + (((size_t)(dir * BATCH + b) * NCHUNK) * 16 + hh) * 8192 + e8 * 8;
        const long cstep = dir ? -(long)16 * 8192 : (long)16 * 8192; const int dstep = dir ? -CHUNK : CHUNK;
        bf16_t* p = base + (dir ? (size_t)(NCHUNK - 1) * 16 * 8192 : 0); const float* cp = CS + (dir ? (NCHUNK - 1) * CHUNK : 0);
        float prev[8];
#pragma unroll
        for (int j = 0; j < 8; ++j) prev[j] = 0.f;
#pragma unroll 1
        for (int c0 = 0; c0 < NCHUNK; c0 += 8) {
            u32x4 sv[8]; float dec[8];
#pragma unroll
            for (int k = 0; k < 8; ++k) { sv[k] = *(const u32x4*)(p + k * cstep); dec[k] = cp[k * dstep]; }
#pragma unroll
            for (int k = 0; k < 8; ++k) {
                *(u32x4*)(p + k * cstep) = (u32x4){pk2(prev[0], prev[1]), pk2(prev[2], prev[3]), pk2(prev[4], prev[5]), pk2(prev[6], prev[7])};
                const float dk = __expf(dec[k]);
#pragma unroll
                for (int q = 0; q < 4; ++q) { prev[2 * q] = prev[2 * q] * dk + bflo(sv[k][q]); prev[2 * q + 1] = prev[2 * q + 1] * dk + bfhi(sv[k][q]); }
            }
            p += 8 * cstep; cp += 8 * dstep;
        }
    }
}
constexpr int P5_G = 0, P5_B = 128 * 272, P5_C = 2 * 128 * 272, P5_ARR = 3 * 128 * 272, P5_RED = P5_ARR + 8 * 2048, P5_END = P5_RED + 64 * 8 * 4;
__device__ __forceinline__ bf16x8 opaque8(bf16x8 v) { u32x4 r = __builtin_bit_cast(u32x4, v); asm volatile("" : "+v"(r)); return __builtin_bit_cast(bf16x8, r); }
__device__ __forceinline__ void p5_out_unit(const Args& a, LAS unsigned char* lds, int unit) {
    unsigned char* ws = KWS();
    const int tid = opaque_tid(); const int lane = tid & 63, wave = tid >> 6, r32 = lane & 31, hi = lane >> 5;
    const int g = unit & 1, bc = unit >> 1, b = bc >> 5, c = bc & 31, hh = g * 8 + wave;
    const int t0 = b * SEQ + c * CHUNK;
    const bf16_t* XS = (const bf16_t*)KOUT(); const bf16_t* XST = XS + (size_t)TOK * 1024;
    const bf16_t* BC = (const bf16_t*)(ws + WS_BC);
    bf16_t* ZY = (bf16_t*)(ws + WS_Z);
    const size_t hbase = (size_t)(b * 16 + hh) * SEQ + c * CHUNK;
    LAS float* arr = (LAS float*)(lds + P5_ARR + wave * 2048);
    LAS float* red = (LAS float*)(lds + P5_RED);
    {
        u32x4 tb[4], tc[4];
#pragma unroll
        for (int i = 0; i < 4; ++i) { const int ci = tid + NT * i, r = ci >> 4, ch = ci & 15;
            tb[i] = *(const u32x4*)(BC + (size_t)(t0 + r) * 512 + g * 128 + ch * 8); tc[i] = *(const u32x4*)(BC + (size_t)(t0 + r) * 512 + 256 + g * 128 + ch * 8); }
        const float* src[4] = {(const float*)(ws + WS_ACSF) + hbase, (const float*)(ws + WS_RACSB) + hbase, (const float*)(ws + WS_DTF) + hbase, (const float*)(ws + WS_DTB) + hbase};
        f32x2 av[4];
#pragma unroll
        for (int k = 0; k < 4; ++k) av[k] = *(const f32x2*)(src[k] + 2 * lane);
#pragma unroll
        for (int i = 0; i < 4; ++i) { const int ci = tid + NT * i, r = ci >> 4, ch = ci & 15;
            *(LAS u32x4*)(lds + P5_B + r * 272 + ch * 16) = tb[i]; *(LAS u32x4*)(lds + P5_C + r * 272 + ch * 16) = tc[i]; }
#pragma unroll
        for (int k = 0; k < 4; ++k) { arr[k * 128 + 2 * lane] = av[k].x; arr[k * 128 + 2 * lane + 1] = av[k].y; }
    }
    __syncthreads();
    {
        const int lb = wave >> 1;
        LAS unsigned char* crow = lds + P5_C + (32 * lb + r32) * 272 + 16 * hi;
#pragma unroll
        for (int sbi = 0; sbi < 2; ++sbi) {
            const int sb = 2 * (wave & 1) + sbi;
            LAS unsigned char* brow = lds + P5_B + (32 * sb + r32) * 272 + 16 * hi;
            f32x16 acc = f32x16{};
#pragma unroll
            for (int ks = 0; ks < 8; ++ks) acc = MFMA32(*(const LAS bf16x8*)(brow + 32 * ks), *(const LAS bf16x8*)(crow + 32 * ks), acc);
#pragma unroll
            for (int q = 0; q < 4; ++q)
                *(LAS u32x2*)(lds + P5_G + (32 * lb + r32) * 272 + (32 * sb + 8 * q + 4 * hi) * 2) = (u32x2){pk2(acc[4 * q], acc[4 * q + 1]), pk2(acc[4 * q + 2], acc[4 * q + 3])};
        }
    }
    __syncthreads();
    const float dsk = KIN(10)[hh];
    const bf16_t* xrow0 = XST + ((size_t)b * 1024 + hh * 64 + r32) * SEQ + c * CHUNK + 8 * hi;
#pragma unroll 1
    for (int lh = 0; lh < 2; ++lh) {
        f32x16 acc[2][2];
#pragma unroll
        for (int i = 0; i < 2; ++i)
#pragma unroll
            for (int j = 0; j < 2; ++j) acc[i][j] = f32x16{};
#pragma unroll 1
        for (int kh = 0; kh < 2; ++kh) {
            bf16x8 xf[2][4];
            int kho = kh * 64; asm volatile("" : "+s"(kho));
            const bf16_t* xr = xrow0 + kho;
#pragma unroll
            for (int pb = 0; pb < 2; ++pb)
#pragma unroll
                for (int k4 = 0; k4 < 4; ++k4) xf[pb][k4] = ld8(xr + (size_t)(32 * pb) * SEQ + 16 * k4);
#pragma unroll
            for (int lb2 = 0; lb2 < 2; ++lb2) {
                const int l = 64 * lh + 32 * lb2 + r32;
                const float afl = arr[l], rbl = arr[128 + l];
#pragma unroll
                for (int k4 = 0; k4 < 4; ++k4) {
                    const int s8 = kho + 16 * k4 + 8 * hi;
                    const bf16x8 gv = *(const LAS bf16x8*)(lds + P5_G + l * 272 + s8 * 2);
                    float w[8]; bf16x8 mf;
                    const int sblk = kho + 16 * k4, lblk = 64 * lh + 32 * lb2;
                    if (sblk + 16 <= lblk) {
#pragma unroll
                        for (int j = 0; j < 8; ++j) w[j] = __expf(afl - arr[s8 + j]) * arr[256 + s8 + j];
                        mf = scale8(gv, w);
                    } else if (sblk >= lblk + 32) {
#pragma unroll
                        for (int j = 0; j < 8; ++j) w[j] = __expf(rbl - arr[128 + s8 + j]) * arr[384 + s8 + j];
                        mf = scale8(gv, w);
                    } else {
                        float ad[8];
#pragma unroll
                        for (int j = 0; j < 8; ++j) {
                            const int s = s8 + j;
                            const float afs = arr[s], rbs = arr[128 + s], dfs = arr[256 + s], dbs = arr[384 + s];
                            const bool fw = s < l;
                            const float e = __expf(fminf(fw ? (afl - afs) : (rbl - rbs), 0.f)) * (fw ? dfs : dbs);
                            w[j] = (s == l) ? (dfs + dbs) : e; ad[j] = (s == l) ? dsk : 0.f;
                        }
                        mf = scale8a(gv, w, ad);
                    }
#pragma unroll
                    for (int pb = 0; pb < 2; ++pb) acc[pb][lb2] = MFMA32(opaque8(xf[pb][k4]), mf, acc[pb][lb2]);
                    __builtin_amdgcn_sched_barrier(0);
                }
            }
        }
#pragma unroll 1
        for (int dir = 0; dir < 2; ++dir) {
            f32x16 tacc[2][2];
#pragma unroll
            for (int i = 0; i < 2; ++i)
#pragma unroll
                for (int j = 0; j < 2; ++j) tacc[i][j] = f32x16{};
            int diro = dir; asm volatile("" : "+s"(diro));
            const bf16_t* sp = (const bf16_t*)(ws + WS_ST) + ((((size_t)(diro * BATCH + b) * NCHUNK + c) * 16 + hh) * 64 + r32) * 128 + 8 * hi;
            bf16x8 pf[2][8];
#pragma unroll
            for (int pb = 0; pb < 2; ++pb)
#pragma unroll
                for (int ks = 0; ks < 8; ++ks) pf[pb][ks] = ld8(sp + (size_t)(32 * pb) * 128 + 16 * ks);
#pragma unroll
            for (int ks = 0; ks < 8; ++ks) {
#pragma unroll
                for (int lb2 = 0; lb2 < 2; ++lb2) {
                    const int l = 64 * lh + 32 * lb2 + r32;
                    const bf16x8 cv = *(const LAS bf16x8*)(lds + P5_C + l * 272 + (16 * ks + 8 * hi) * 2);
#pragma unroll
                    for (int pb = 0; pb < 2; ++pb) tacc[pb][lb2] = MFMA32(pf[pb][ks], cv, tacc[pb][lb2]);
                }
            }
#pragma unroll
            for (int lb2 = 0; lb2 < 2; ++lb2) {
                const int l = 64 * lh + 32 * lb2 + r32;
                const float e = __expf(arr[(dir ? 128 : 0) + l]);
#pragma unroll
                for (int pb = 0; pb < 2; ++pb)
#pragma unroll
                    for (int r = 0; r < 16; ++r) acc[pb][lb2][r] += e * tacc[pb][lb2][r];
            }
        }
        float ssq[2] = {0.f, 0.f};
#pragma unroll
        for (int lb2 = 0; lb2 < 2; ++lb2) {
            const int t = t0 + 64 * lh + 32 * lb2 + r32;
#pragma unroll
            for (int pb = 0; pb < 2; ++pb)
#pragma unroll
                for (int q = 0; q < 4; ++q) {
                    const int ch = hh * 64 + 32 * pb + 8 * q + 4 * hi;
                    const u32x2 zv = *(const u32x2*)(ZY + (size_t)t * 1024 + ch);
                    f32x16& v = acc[pb][lb2];
                    v[4 * q] *= bflo(zv.x); v[4 * q + 1] *= bfhi(zv.x); v[4 * q + 2] *= bflo(zv.y); v[4 * q + 3] *= bfhi(zv.y);
                    ssq[lb2] += (v[4 * q] * v[4 * q] + v[4 * q + 1] * v[4 * q + 1]) + (v[4 * q + 2] * v[4 * q + 2] + v[4 * q + 3] * v[4 * q + 3]);
                }
        }
#pragma unroll
        for (int lb2 = 0; lb2 < 2; ++lb2) { ssq[lb2] += __shfl_xor(ssq[lb2], 32); if (hi == 0) red[(32 * lb2 + r32) * 8 + wave] = ssq[lb2]; }
        __syncthreads();
#pragma unroll
        for (int lb2 = 0; lb2 < 2; ++lb2) {
            const f32x4 r0 = *(const LAS f32x4*)(red + (32 * lb2 + r32) * 8), r1 = *(const LAS f32x4*)(red + (32 * lb2 + r32) * 8 + 4);
            const float tot = ((r0.x + r0.y) + (r0.z + r0.w)) + ((r1.x + r1.y) + (r1.z + r1.w));
            const float rstd = YS8_SCALE / sqrtf(tot * (1.f / 512.f) + EPS);
            const int t = t0 + 64 * lh + 32 * lb2 + r32;
#pragma unroll
            for (int pb = 0; pb < 2; ++pb)
#pragma unroll
                for (int q = 0; q < 4; ++q) {
                    const int ch = hh * 64 + 32 * pb + 8 * q + 4 * hi; const f32x16& v = acc[pb][lb2];
                    *(unsigned*)(KWS() + WS_YSQ + (size_t)t * 1024 + ch) = pack4_fp8(v[4 * q] * rstd, v[4 * q + 1] * rstd, v[4 * q + 2] * rstd, v[4 * q + 3] * rstd);
                }
        }
        __syncthreads();
    }
}
#define PK8(v0, v1) (u32x4){pk2((v0)[0], (v0)[1]), pk2((v0)[2], (v0)[3]), pk2((v1)[0], (v1)[1]), pk2((v1)[2], (v1)[3])}
#define PKF8(v0, v1) (u32x2){pack4_fp8((v0)[0], (v0)[1], (v0)[2], (v0)[3]), pack4_fp8((v1)[0], (v1)[1], (v1)[2], (v1)[3])}
struct DQ { float rs; f32x4 cs, sn; };
struct EpiQ {
    unsigned char* __restrict__ Q; const float* __restrict__ RQ; const float* __restrict__ COS; const float* __restrict__ SIN;
    __device__ __forceinline__ void operator()(const f32x4 (&acc)[2][2][4][2], const pg8::Unit& u, int wr, int wc, int fr, int fq) const {
        pg8::foreach8_batched<4, DQ>(acc, u, wr, wc, fr, fq,
            [&](int row, int col) { DQ d; d.rs = RQ[row]; const int dd = col % 96; const int i0 = (dd >= 64) ? ((dd - 64) >> 1) : 0;
                d.cs = *(const f32x4*)(COS + (size_t)row * 16 + i0); d.sn = *(const f32x4*)(SIN + (size_t)row * 16 + i0); return d; },
            [&](int row, int col, f32x4 v0, f32x4 v1, const DQ& d) {
                v0 = v0 * d.rs; v1 = v1 * d.rs;
                if (col % 96 >= 64) { const f32x4 cs = d.cs, sn = d.sn; const f32x4 a0 = v0, a1 = v1;
                    v0[0] = a0[0] * cs[0] - a0[1] * sn[0]; v0[1] = a0[0] * sn[0] + a0[1] * cs[0]; v0[2] = a0[2] * cs[1] - a0[3] * sn[1]; v0[3] = a0[2] * sn[1] + a0[3] * cs[1];
                    v1[0] = a1[0] * cs[2] - a1[1] * sn[2]; v1[1] = a1[0] * sn[2] + a1[1] * cs[2]; v1[2] = a1[2] * cs[3] - a1[3] * sn[3]; v1[3] = a1[2] * sn[3] + a1[3] * cs[3]; }
                *(u32x2*)(Q + (size_t)row * QW + col) = PKF8(v0, v1); });
    }
};
struct DR { float rs; };
struct EpiK {
    unsigned char* __restrict__ K; const float* __restrict__ RKV;
    __device__ __forceinline__ void operator()(const f32x4 (&acc)[2][2][4][2], const pg8::Unit& u, int wr, int wc, int fr, int fq) const {
        pg8::foreach8_batched<4, DR>(acc, u, wr, wc, fr, fq,
            [&](int row, int col) { DR d; d.rs = RKV[row]; return d; },
            [&](int row, int col, f32x4 v0, f32x4 v1, const DR& d) { v0 = v0 * d.rs; v1 = v1 * d.rs;
                *(u32x2*)(K + (size_t)row * KW + col) = PKF8(v0, v1); });
    }
};
constexpr float YSCALE = 32.f;
constexpr float VSCALE = 4.f;
struct EpiVT {
    unsigned char* VT; const float* RKV;
    __device__ __forceinline__ void operator()(const f32x4 (&acc)[2][2][4][2], const pg8::Unit& u, int wr, int wc, int fr, int fq) const {
        pg8::foreach8(acc, u, wr, wc, fr, fq, [&](int row, int col, f32x4 v0, f32x4 v1) {
            const f32x4 r0 = *(const f32x4*)(RKV + col) * VSCALE, r1 = *(const f32x4*)(RKV + col + 4) * VSCALE; v0 = v0 * r0; v1 = v1 * r1;
            const int a = (col >> 3) & 7, pos = (col & ~63) + 16 * (a >> 2) + 4 * (a & 3);
            *(unsigned*)(VT + (size_t)row * TOK + pos) = pack4_fp8(v0[0], v0[1], v0[2], v0[3]);
            *(unsigned*)(VT + (size_t)row * TOK + pos + 32) = pack4_fp8(v1[0], v1[1], v1[2], v1[3]);
        });
    }
};
constexpr int AT_KS = 112, AT_VS = 80;
constexpr int AT_KB = 64 * AT_KS, AT_VB = 64 * AT_VS;
constexpr int AT_K0 = 0, AT_V0 = 4 * AT_KB, AT_WS = AT_V0 + 4 * AT_VB, AT_END = AT_WS + 8 * 256;
constexpr float AT_THR = 8.f;
__device__ __forceinline__ unsigned cvtpk(float lo, float hi) { f32x2 v = {lo, hi}; bf16x2_t b = __builtin_convertvector(v, bf16x2_t); return __builtin_bit_cast(unsigned, b); }
#define MX3(a, b, c) __builtin_fmaxf(__builtin_fmaxf((a), (b)), (c))
__device__ __forceinline__ void p7_attn_unit(const Args& a, LAS unsigned char* lds, int b, int h, int qb) {
    unsigned char* ws = KWS();
    const int tid = opaque_tid(), lane = tid & 63, wave = tid >> 6, r32 = lane & 31, hi = lane >> 5;
    const unsigned char* Q = (const unsigned char*)KOUT(); const unsigned char* K = (const unsigned char*)(ws + WS_K); const unsigned char* VT = (const unsigned char*)(ws + WS_VT);
    unsigned char* YM = (unsigned char*)(ws + WS_YM);
    const int q0 = qb * 256 + wave * 32;
    i32x8_t qb1, qb2;
    { const unsigned char* qp = Q + (size_t)(b * SEQ + q0 + r32) * QW + h * 96;
      const u32x4 a0 = *(const u32x4*)(qp + 32 * hi), a1 = *(const u32x4*)(qp + 32 * hi + 16), c0 = *(const u32x4*)(qp + 64), c1 = *(const u32x4*)(qp + 80);
      qb1 = (i32x8_t){(int)a0.x, (int)a0.y, (int)a0.z, (int)a0.w, (int)a1.x, (int)a1.y, (int)a1.z, (int)a1.w};
      qb2 = hi ? (i32x8_t){0, 0, 0, 0, 0, 0, 0, 0} : (i32x8_t){(int)c0.x, (int)c0.y, (int)c0.z, (int)c0.w, (int)c1.x, (int)c1.y, (int)c1.z, (int)c1.w}; }
    const int kr0 = (tid < 384 ? tid : 0) / 6, kc0 = (tid < 384 ? tid : 0) % 6;
    const int vd = (tid & 255) >> 2, vc = tid & 3;
    const unsigned char* KRp = (const unsigned char*)(ws + WS_KR);
    const unsigned ks0 = kc0 < 4 ? KW : 32;
    const unsigned char* kg0 = kc0 < 4 ? K + (size_t)(b * SEQ + kr0) * KW + h * 64 + kc0 * 16 : KRp + (size_t)(b * SEQ + kr0) * 32 + (kc0 - 4) * 16;
    const unsigned char* vg = VT + (size_t)(h * 64 + vd) * TOK + b * SEQ + vc * 16;
    const int kl0 = kr0 * AT_KS + kc0 * 16, vl = vd * AT_VS + vc * 16;
    LAS float* wsf = (LAS float*)(lds + AT_WS + wave * 256);
    u32x4 kA0 = (u32x4){0u, 0u, 0u, 0u}, kA1 = kA0, vA0s = kA0, vA1s = kA0, kB0 = kA0, kB1 = kA0, vB0s = kA0, vB1s = kA0;
    { u32x4 k2_ = kA0;
      if (tid < 384) { kA0 = *(const u32x4*)kg0; kA1 = *(const u32x4*)(kg0 + 64u * ks0); k2_ = *(const u32x4*)(kg0 + 128u * ks0); }
      if (tid < 256) { vA0s = *(const u32x4*)vg; vA1s = *(const u32x4*)(vg + 64); }
      __syncthreads();
      if (tid < 384) { *(LAS u32x4*)(lds + AT_K0 + kl0) = kA0; *(LAS u32x4*)(lds + AT_K0 + AT_KB + kl0) = kA1; *(LAS u32x4*)(lds + AT_K0 + 2 * AT_KB + kl0) = k2_; }
      if (tid < 256) { *(LAS u32x4*)(lds + AT_V0 + vl) = vA0s; *(LAS u32x4*)(lds + AT_V0 + AT_VB + vl) = vA1s; }
      asm volatile("s_waitcnt lgkmcnt(0)" ::: "memory"); }
    if (tid < 384) { kB0 = *(const u32x4*)(kg0 + 192u * ks0); kB1 = *(const u32x4*)(kg0 + 256u * ks0); }
    if (tid < 256) { vB0s = *(const u32x4*)(vg + 128); vB1s = *(const u32x4*)(vg + 192); }
    __syncthreads();
    f32x16 o0 = f32x16{}, o1 = f32x16{};
    float mref = 0.f, lrun = 0.f;
    f32x16 negm;
#pragma unroll
    for (int r = 0; r < 16; ++r) negm[r] = 0.f;
    constexpr int NTILE = SEQ / 64;
    const int koff = r32 * AT_KS + hi * 32, voff = r32 * AT_VS + hi * 32;
#define AT_KFRAG(kb) \
        const u32x4 k00 = *(const LAS u32x4*)(kb), k01 = *(const LAS u32x4*)(kb + 16), k02 = *(const LAS u32x4*)(kb + 64 - 32 * hi), k03 = *(const LAS u32x4*)(kb + 80 - 32 * hi);            \
        const u32x4 k10 = *(const LAS u32x4*)(kb + 32 * AT_KS), k11 = *(const LAS u32x4*)(kb + 32 * AT_KS + 16), k12 = *(const LAS u32x4*)(kb + 32 * AT_KS + 64 - 32 * hi), k13 = *(const LAS u32x4*)(kb + 32 * AT_KS + 80 - 32 * hi); \
        const i32x8_t ka0 = {(int)k00.x, (int)k00.y, (int)k00.z, (int)k00.w, (int)k01.x, (int)k01.y, (int)k01.z, (int)k01.w}, kc0_ = {(int)k02.x, (int)k02.y, (int)k02.z, (int)k02.w, (int)k03.x, (int)k03.y, (int)k03.z, (int)k03.w}; \
        const i32x8_t ka1 = {(int)k10.x, (int)k10.y, (int)k10.z, (int)k10.w, (int)k11.x, (int)k11.y, (int)k11.z, (int)k11.w}, kc1_ = {(int)k12.x, (int)k12.y, (int)k12.z, (int)k12.w, (int)k13.x, (int)k13.y, (int)k13.z, (int)k13.w};
#define AT_MMA(D, A, B) do { __builtin_amdgcn_sched_barrier(0); __builtin_amdgcn_s_setprio(1); D = __builtin_amdgcn_mfma_scale_f32_32x32x64_f8f6f4(A, B, D, 0, 0, 0, 0, 0, 0); __builtin_amdgcn_s_setprio(0); __builtin_amdgcn_sched_barrier(0); } while (0)
    f32x16 pA0 = negm, pA1 = negm, pB0 = negm, pB1 = negm;
    {
        LAS unsigned char* kb = lds + AT_K0 + koff;
        AT_KFRAG(kb)
        AT_MMA(pA0, ka0, qb1); AT_MMA(pA1, ka1, qb1); AT_MMA(pA0, kc0_, qb2); AT_MMA(pA1, kc1_, qb2);
        asm volatile("s_waitcnt lgkmcnt(0)" ::: "memory");
        __syncthreads();
    }
#define AT_BODY(t, PC0, PC1, PN0, PN1) do { \
        LAS unsigned char* kb = lds + AT_K0 + (((t) + 1) & 3) * AT_KB + koff; LAS unsigned char* vb = lds + AT_V0 + ((t) & 3) * AT_VB + voff;        \
        AT_KFRAG(kb) \
        const u32x4 vA0 = *(const LAS u32x4*)(vb), vA1 = *(const LAS u32x4*)(vb + 16), vB0 = *(const LAS u32x4*)(vb + 32 * AT_VS), vB1 = *(const LAS u32x4*)(vb + 32 * AT_VS + 16);     \
        PN0 = negm; PN1 = negm; \
        AT_MMA(PN0, ka0, qb1); \
        float ma = MX3(PC0[0], PC0[1], PC1[0]), mb = MX3(PC0[2], PC0[3], PC1[1]); ma = MX3(ma, PC1[2], PC1[3]); \
        _Pragma("unroll") for (int r = 4; r < 16; r += 4) { ma = MX3(ma, PC0[r], PC0[r + 1]); mb = MX3(mb, PC0[r + 2], PC0[r + 3]); ma = MX3(ma, PC1[r], PC1[r + 1]); mb = MX3(mb, PC1[r + 2], PC1[r + 3]); } \
        float mx = fmaxf(ma, mb); \
        { SWAP_PAIR(__builtin_amdgcn_permlane32_swap, mx, x0, x1); mx = fmaxf(__builtin_bit_cast(float, x0), __builtin_bit_cast(float, x1)); } \
        AT_MMA(PN1, ka1, qb1); \
        if ((t) == 0 || __any(mx > AT_THR)) { \
            const float dl = ((t) == 0) ? mx : fmaxf(mx, 0.f); mref += dl; \
            const float f = ((t) == 0) ? 1.f : __builtin_amdgcn_exp2f(-dl); lrun *= f; \
            _Pragma("unroll") for (int r = 0; r < 16; ++r) { PC0[r] -= dl; PC1[r] -= dl; PN0[r] -= dl; PN1[r] -= dl; negm[r] = -mref; }        \
            if (hi == 0) wsf[r32] = f; \
            asm volatile("s_waitcnt lgkmcnt(0)" ::: "memory"); \
            _Pragma("unroll") for (int q = 0; q < 4; ++q) { const f32x4 al = *(const volatile LAS f32x4*)(wsf + 8 * q + 4 * hi); \
                _Pragma("unroll") for (int i = 0; i < 4; ++i) { o0[4 * q + i] *= al[i]; o1[4 * q + i] *= al[i]; } } \
        } \
        f32x2 ls2_ = (f32x2){0.f, 0.f}; \
        _Pragma("unroll") for (int r = 0; r < 8; r += 2) { PC0[r] = __builtin_amdgcn_exp2f(PC0[r]); PC0[r + 1] = __builtin_amdgcn_exp2f(PC0[r + 1]); PC1[r] = __builtin_amdgcn_exp2f(PC1[r]); PC1[r + 1] = __builtin_amdgcn_exp2f(PC1[r + 1]); \
            ls2_ += (f32x2){PC0[r], PC0[r + 1]}; ls2_ += (f32x2){PC1[r], PC1[r + 1]}; } \
        AT_MMA(PN0, kc0_, qb2); \
        _Pragma("unroll") for (int r = 8; r < 16; r += 2) { PC0[r] = __builtin_amdgcn_exp2f(PC0[r]); PC0[r + 1] = __builtin_amdgcn_exp2f(PC0[r + 1]); PC1[r] = __builtin_amdgcn_exp2f(PC1[r]); PC1[r + 1] = __builtin_amdgcn_exp2f(PC1[r + 1]); \
            ls2_ += (f32x2){PC0[r], PC0[r + 1]}; ls2_ += (f32x2){PC1[r], PC1[r + 1]}; }                         \
        AT_MMA(PN1, kc1_, qb2); \
        const float ls = ls2_.x + ls2_.y; \
        lrun += ls; \
          \
        const i32x8_t pa_ = {(int)pack4_fp8(PC0[0], PC0[1], PC0[2], PC0[3]), (int)pack4_fp8(PC0[4], PC0[5], PC0[6], PC0[7]), (int)pack4_fp8(PC0[8], PC0[9], PC0[10], PC0[11]), (int)pack4_fp8(PC0[12], PC0[13], PC0[14], PC0[15]), \
                             (int)pack4_fp8(PC1[0], PC1[1], PC1[2], PC1[3]), (int)pack4_fp8(PC1[4], PC1[5], PC1[6], PC1[7]), (int)pack4_fp8(PC1[8], PC1[9], PC1[10], PC1[11]), (int)pack4_fp8(PC1[12], PC1[13], PC1[14], PC1[15])}; \
        const i32x8_t va_ = {(int)vA0.x, (int)vA0.y, (int)vA0.z, (int)vA0.w, (int)vA1.x, (int)vA1.y, (int)vA1.z, (int)vA1.w}; \
        const i32x8_t vb_ = {(int)vB0.x, (int)vB0.y, (int)vB0.z, (int)vB0.w, (int)vB1.x, (int)vB1.y, (int)vB1.z, (int)vB1.w}; \
        AT_MMA(o0, pa_, va_); \
        AT_MMA(o1, pa_, vb_); \
        asm volatile("s_waitcnt lgkmcnt(0)" ::: "memory"); } while (0)
#define AT_INTERVAL(T, RK0, RK1, RV0, RV1, WK0, WK1, WV0, WV1) do { \
        if (tid < 384) { if ((T) + 5 < NTILE) RK0 = *(const u32x4*)(kg0 + (unsigned)((T) + 5) * 64u * ks0); if ((T) + 6 < NTILE) RK1 = *(const u32x4*)(kg0 + (unsigned)((T) + 6) * 64u * ks0); } \
        if (tid < 256) { if ((T) + 4 < NTILE) RV0 = *(const u32x4*)(vg + ((T) + 4) * 64); if ((T) + 5 < NTILE) RV1 = *(const u32x4*)(vg + ((T) + 5) * 64); } \
        AT_BODY(T, pA0, pA1, pB0, pB1); \
        AT_BODY((T) + 1, pB0, pB1, pA0, pA1); \
        if (tid < 384) { if ((T) + 3 < NTILE) *(LAS u32x4*)(lds + AT_K0 + (((T) + 3) & 3) * AT_KB + kl0) = WK0; if ((T) + 4 < NTILE) *(LAS u32x4*)(lds + AT_K0 + (((T) + 4) & 3) * AT_KB + kl0) = WK1; } \
        if (tid < 256) { if ((T) + 2 < NTILE) *(LAS u32x4*)(lds + AT_V0 + (((T) + 2) & 3) * AT_VB + vl) = WV0; if ((T) + 3 < NTILE) *(LAS u32x4*)(lds + AT_V0 + (((T) + 3) & 3) * AT_VB + vl) = WV1; } \
        __syncthreads(); } while (0)
#pragma unroll 1
    for (int t = 0; t < NTILE; t += 4) {
        AT_INTERVAL(t, kA0, kA1, vA0s, vA1s, kB0, kB1, vB0s, vB1s);
        AT_INTERVAL(t + 2, kB0, kB1, vB0s, vB1s, kA0, kA1, vA0s, vA1s);
    }
#undef AT_INTERVAL
#undef AT_KFRAG
#undef AT_MMA
#undef AT_BODY
    { SWAP_PAIR(__builtin_amdgcn_permlane32_swap, lrun, x0, x1); lrun = __builtin_bit_cast(float, x0) + __builtin_bit_cast(float, x1); }
    if (hi == 0) wsf[32 + r32] = (YSCALE / VSCALE) / lrun;
    asm volatile("s_waitcnt lgkmcnt(0)" ::: "memory");
#pragma unroll
    for (int q = 0; q < 4; ++q) { const f32x4 il = *(const volatile LAS f32x4*)(wsf + 32 + 8 * q + 4 * hi);
#pragma unroll
        for (int i = 0; i < 4; ++i) { const int row = q0 + 8 * q + 4 * hi + i; unsigned char* yp = YM + (size_t)(b * SEQ + row) * 1024 + h * 64 + r32;
            const unsigned pk_ = (unsigned)__builtin_amdgcn_cvt_pk_fp8_f32(o0[4 * q + i] * il[i], o1[4 * q + i] * il[i], 0, false); yp[0] = (unsigned char)(pk_ & 0xffu); yp[32] = (unsigned char)((pk_ >> 8) & 0xffu); } }
}
__device__ __forceinline__ void p7_attention(const Args& a, LAS unsigned char* lds) {
    const int G = gridDim.x, bx = opaque_bx();
    const int vcu = (G % 8 == 0) ? (bx % 8) * (G / 8) + bx / 8 : bx;
    for (int u = vcu; u < BATCH * 16 * 16; u += G) {
        const int qb = u & 15, bh = u >> 4;
        p7_attn_unit(a, lds, bh >> 4, bh & 15, qb);
    }
}

struct DG { u32x2 g; };
struct DGM { u32x2 g; u32x4 m; };
#define GATE8(gv, g) GATE8C(gv, g, (1.f / 255.f))
#define GATE8C(gv, g, cc) float g[8]; { const float c_ = (cc); g[0] = (float)((gv.x >> 0) & 0xffu) * c_; g[1] = (float)((gv.x >> 8) & 0xffu) * c_; g[2] = (float)((gv.x >> 16) & 0xffu) * c_; g[3] = (float)((gv.x >> 24) & 0xffu) * c_; \
    g[4] = (float)((gv.y >> 0) & 0xffu) * c_; g[5] = (float)((gv.y >> 8) & 0xffu) * c_; g[6] = (float)((gv.y >> 16) & 0xffu) * c_; g[7] = (float)((gv.y >> 24) & 0xffu) * c_; }
struct EpiMerge1 {
    bf16_t* __restrict__ M; const unsigned char* __restrict__ G; float osc;
    __device__ __forceinline__ void operator()(const f32x4 (&acc)[2][2][4][2], const pg8::Unit& u, int wr, int wc, int fr, int fq) const {
        pg8::foreach8_batched<2, DG>(acc, u, wr, wc, fr, fq,
            [&](int row, int col) { DG d; d.g = *(const u32x2*)(G + (size_t)row * 2048 + col); return d; },
            [&](int row, int col, f32x4 v0, f32x4 v1, const DG& d) { const u32x2 gv = d.g; GATE8C(gv, g, osc);
#pragma unroll
                for (int j = 0; j < 4; ++j) { v0[j] *= g[j]; v1[j] *= g[4 + j]; }
                *(u32x4*)(M + (size_t)row * 1024 + col) = PK8(v0, v1); });
    }
};
struct EpiMerge2 {
    bf16_t* M; const unsigned char* G; float osc; unsigned char* MQ;
    __device__ __forceinline__ void operator()(const f32x4 (&acc)[2][2][4][2], const pg8::Unit& u, int wr, int wc, int fr, int fq) const {
        pg8::foreach8_batched<4, DGM>(acc, u, wr, wc, fr, fq,
            [&](int row, int col) { DGM d; d.g = *(const u32x2*)(G + (size_t)row * 2048 + 1024 + col); d.m = *(const u32x4*)(M + (size_t)row * 1024 + col); return d; },
            [&](int row, int col, f32x4 v0, f32x4 v1, const DGM& d) { const u32x2 gv = d.g; const u32x4 mv = d.m; GATE8C(gv, g, osc);
                v0[0] = bflo(mv.x) + v0[0] * g[0]; v0[1] = bfhi(mv.x) + v0[1] * g[1]; v0[2] = bflo(mv.y) + v0[2] * g[2]; v0[3] = bfhi(mv.y) + v0[3] * g[3];
                v1[0] = bflo(mv.z) + v1[0] * g[4]; v1[1] = bfhi(mv.z) + v1[1] * g[5]; v1[2] = bflo(mv.w) + v1[2] * g[6]; v1[3] = bfhi(mv.w) + v1[3] * g[7];
                const float qf = 127.f / M_QMAX;
#pragma unroll
                for (int j = 0; j < 4; ++j) { v0[j] = fminf(fmaxf(v0[j] * qf, -127.f), 127.f); v1[j] = fminf(fmaxf(v1[j] * qf, -127.f), 127.f); }
                *(u32x2*)(MQ + (size_t)row * 1024 + col) = (u32x2){pack_i8x4(v0[0], v0[1], v0[2], v0[3]), pack_i8x4(v1[0], v1[1], v1[2], v1[3])}; });
    }
};
struct DX { f32x4 x0, x1; };
struct EpiOut {
    const float* __restrict__ X; bf16_t* __restrict__ HB; float* __restrict__ SSQ; unsigned char* __restrict__ HQ; const unsigned* __restrict__ woamax;
    __device__ __forceinline__ void operator()(const f32x4 (&acc)[2][2][4][2], const pg8::Unit& u, int wr, int wc, int fr, int fq) const {
        f32x4 cs[2][2];
#pragma unroll
        for (int bj = 0; bj < 2; ++bj) { const u32x4* ap = (const u32x4*)(woamax + u.pn * 256 + bj * 128 + wc * 32 + 8 * fq);
#pragma unroll
            for (int h = 0; h < 2; ++h) { const u32x4 w = ap[h];
#pragma unroll
                for (int j = 0; j < 4; ++j) cs[bj][h][j] = AMAXV(w[j]) * (M_QMAX / (127.f * 127.f)); } }
#pragma unroll
        for (int ai = 0; ai < 2; ++ai)
#pragma unroll
            for (int m0 = 0; m0 < 4; m0 += 2) {
                DX d[2][2];
#pragma unroll
                for (int mm = 0; mm < 2; ++mm) { const int row = u.pm * 256 + ai * 128 + wr * 64 + (m0 + mm) * 16 + fr;
#pragma unroll
                    for (int bj = 0; bj < 2; ++bj) { const int col = u.pn * 256 + bj * 128 + wc * 32 + 8 * fq;
                        d[mm][bj].x0 = *(const f32x4*)(X + (size_t)row * 1024 + col); d[mm][bj].x1 = *(const f32x4*)(X + (size_t)row * 1024 + col + 4); } }
#pragma unroll
                for (int mm = 0; mm < 2; ++mm) { const int m = m0 + mm; const int row = u.pm * 256 + ai * 128 + wr * 64 + m * 16 + fr; float s = 0.f;
#pragma unroll
                    for (int bj = 0; bj < 2; ++bj) { const int col = u.pn * 256 + bj * 128 + wc * 32 + 8 * fq;
                        const i32x4_e i0 = __builtin_bit_cast(i32x4_e, acc[ai][bj][m][0]), i1 = __builtin_bit_cast(i32x4_e, acc[ai][bj][m][1]);
                        f32x4 v0, v1;
#pragma unroll
                        for (int j = 0; j < 4; ++j) { v0[j] = (float)i0[j] * cs[bj][0][j] + d[mm][bj].x0[j]; v1[j] = (float)i1[j] * cs[bj][1][j] + d[mm][bj].x1[j]; }
                        *(u32x4*)(HB + (size_t)row * 1024 + col) = PK8(v0, v1);
                        { const float qf = 127.f / H_QMAX; f32x4 q0 = v0 * qf, q1 = v1 * qf;
#pragma unroll
                          for (int j = 0; j < 4; ++j) { q0[j] = fminf(fmaxf(q0[j], -127.f), 127.f); q1[j] = fminf(fmaxf(q1[j], -127.f), 127.f); }
                          *(u32x2*)(HQ + (size_t)row * 1024 + col) = (u32x2){pack_i8x4(q0[0], q0[1], q0[2], q0[3]), pack_i8x4(q1[0], q1[1], q1[2], q1[3])}; }
                        s += (v0[0] * v0[0] + v0[1] * v0[1]) + (v0[2] * v0[2] + v0[3] * v0[3]) + (v1[0] * v1[0] + v1[1] * v1[1]) + (v1[2] * v1[2] + v1[3] * v1[3]); }
                    s += __shfl_xor(s, 16); s += __shfl_xor(s, 32);
                    if (fq == 0) SSQ[(size_t)row * 16 + u.pn * 4 + wc] = s; }
                asm volatile("" ::: "memory");
            }
    }
};
struct EpiScore {
    float* __restrict__ SC; const float* __restrict__ SSQ; const unsigned* __restrict__ wamax;
    __device__ __forceinline__ void operator()(const f32x4 (&acc)[2][2][4][2], const pg8::Unit& u, int wr, int wc, int fr, int fq) const {
        float rs[2][4];
#pragma unroll
        for (int ai = 0; ai < 2; ++ai)
#pragma unroll
            for (int m = 0; m < 4; ++m) {
                const int row = u.pm * 256 + ai * 128 + wr * 64 + m * 16 + fr;
                const f32x4* sp = (const f32x4*)(SSQ + (size_t)row * 16);
                const f32x4 s0 = sp[0], s1 = sp[1], s2 = sp[2], s3 = sp[3];
                const float tot = (((s0[0] + s0[1]) + (s0[2] + s0[3])) + ((s1[0] + s1[1]) + (s1[2] + s1[3]))) + (((s2[0] + s2[1]) + (s2[2] + s2[3])) + ((s3[0] + s3[1]) + (s3[2] + s3[3])));
                rs[ai][m] = (H_QMAX / (127.f * 127.f)) / sqrtf(tot * (1.f / 1024.f) + EPS);
            }
        f32x4 cs[2][2];
#pragma unroll
        for (int bj = 0; bj < 2; ++bj) { const u32x4* ap = (const u32x4*)(wamax + u.pn * 256 + bj * 128 + wc * 32 + 8 * fq);
#pragma unroll
            for (int h = 0; h < 2; ++h) { const u32x4 w = ap[h];
#pragma unroll
                for (int j = 0; j < 4; ++j) cs[bj][h][j] = AMAXV(w[j]); } }
#pragma unroll
        for (int ai = 0; ai < 2; ++ai)
#pragma unroll
            for (int m = 0; m < 4; ++m) {
                const int row = u.pm * 256 + ai * 128 + wr * 64 + m * 16 + fr;
#pragma unroll
                for (int bj = 0; bj < 2; ++bj) {
                    const int col = u.pn * 256 + bj * 128 + wc * 32 + 8 * fq;
                    const i32x4_e i0 = __builtin_bit_cast(i32x4_e, acc[ai][bj][m][0]), i1 = __builtin_bit_cast(i32x4_e, acc[ai][bj][m][1]);
                    f32x4 a0, a1;
#pragma unroll
                    for (int j = 0; j < 4; ++j) { a0[j] = (float)i0[j] * rs[ai][m] * cs[bj][0][j]; a1[j] = (float)i1[j] * rs[ai][m] * cs[bj][1][j]; }
                    unsigned w[4];
#pragma unroll
                    for (int i = 0; i < 2; ++i) {
                        w[i] = (unsigned)__builtin_bit_cast(unsigned short, (_Float16)a0[2 * i]) | ((unsigned)__builtin_bit_cast(unsigned short, (_Float16)a0[2 * i + 1]) << 16);
                        w[2 + i] = (unsigned)__builtin_bit_cast(unsigned short, (_Float16)a1[2 * i]) | ((unsigned)__builtin_bit_cast(unsigned short, (_Float16)a1[2 * i + 1]) << 16); }
                    *(u32x4*)((unsigned short*)SC + (size_t)row * 2048 + col) = (u32x4){w[0], w[1], w[2], w[3]};
                }
            }
    }
};
__device__ __forceinline__ unsigned pack_fp8x4(float a, float b, float c, float d) {
    int p = __builtin_amdgcn_cvt_pk_fp8_f32(a, b, 0, false); p = __builtin_amdgcn_cvt_pk_fp8_f32(c, d, p, true); return (unsigned)p;
}
__device__ __forceinline__ void p9_peer_tables(const Args& a, int rbeg, int rend, int blk, int nblk) {
    unsigned char* ws = KWS();
    const int tid_ = opaque_tid(); const int wave = tid_ >> 6, lane = tid_ & 63;
    const int gw = blk * NW + wave, ngw = nblk * NW;
    const f32x4* NWv = (const f32x4*)KIN(19) + lane;
    const f32x4 n0 = NWv[0], n1 = NWv[64], n2 = NWv[128], n3 = NWv[192];
    constexpr int RB = 4;
    for (int r0 = rbeg + gw * RB; r0 < rend; r0 += ngw * RB) {
        f32x4 v[RB][4];
#pragma unroll
        for (int k = 0; k < RB; ++k) { const int r = r0 + k; const bool isv = r >= 16384; const int row = isv ? r - 16384 : r;
            const f32x4* src = (const f32x4*)(isv ? KIN(23) : KIN(22)) + (size_t)row * 256 + lane;
#pragma unroll
            for (int q = 0; q < 4; ++q) v[k][q] = src[64 * q]; }
#pragma unroll
        for (int k = 0; k < RB; ++k) { const int r = r0 + k; const bool isv = r >= 16384; const int row = isv ? r - 16384 : r;
            f32x4 v0 = v[k][0], v1 = v[k][1], v2 = v[k][2], v3 = v[k][3];
            if (!isv) { v0 = v0 * n0; v1 = v1 * n1; v2 = v2 * n2; v3 = v3 * n3; }
            float m = 0.f;
#pragma unroll
            for (int j = 0; j < 4; ++j) m = fmaxf(m, fmaxf(fmaxf(fabsf(v0[j]), fabsf(v1[j])), fmaxf(fabsf(v2[j]), fabsf(v3[j]))));
            m = fmaxf(wave_max(m), 1e-30f);
            const float sc = 127.f / m;
            v0 = v0 * sc; v1 = v1 * sc; v2 = v2 * sc; v3 = v3 * sc;
            const u32x4 o = (u32x4){pack_i8x4(v0[0], v0[1], v0[2], v0[3]), pack_i8x4(v1[0], v1[1], v1[2], v1[3]), pack_i8x4(v2[0], v2[1], v2[2], v2[3]), pack_i8x4(v3[0], v3[1], v3[2], v3[3])};
            *(u32x4*)(ws + (isv ? WS_PV : WS_PU) + (size_t)row * 1024 + 16 * lane) = o;
            if (lane == 0) ((float*)(ws + (isv ? WS_PVS : WS_PUS)))[row] = m * (1.f / 127.f);
        }
    }
}
typedef unsigned int gu32_t;
#define XB_TMO      128
#define XB_XCNT(j)  (256  + 64 * (j))
#define XB_XSUB(j)  (1280 + 64 * (j))
#define XB_XGEN(j)  (2304 + 64 * (j))
#define XB_TOP      3328
#define XB_TOPGEN   3392
#define XCD_BAR_WORDS 3456
#define XB_SPIN_CAP (1u << 18)

__device__ __forceinline__ unsigned xb_ld(unsigned* p)              { return __hip_atomic_load(p, __ATOMIC_RELAXED, __HIP_MEMORY_SCOPE_AGENT); }
__device__ __forceinline__ unsigned xb_add(unsigned* p, unsigned v) { return __hip_atomic_fetch_add(p, v, __ATOMIC_RELAXED, __HIP_MEMORY_SCOPE_AGENT); }
__device__ __forceinline__ unsigned xb_xcc_id() { return (unsigned)__builtin_amdgcn_s_getreg((3 << 11) | 20) & 0xFu; }
#define XB_SPIN(cond, bar) do { unsigned _sp = 0; while (cond) { __builtin_amdgcn_s_sleep(1); \
    if ((++_sp & 255u) == 0u) { if (xb_ld(&(bar)[XB_TMO])) break; if (_sp > XB_SPIN_CAP) { atomicAdd(&(bar)[XB_TMO], 1u); break; } } } } while (0)

struct XcdBarrier {
    unsigned* bar; unsigned x;
    volatile LAS unsigned* st;
};

__device__ __forceinline__ XcdBarrier xcd_barrier_post(unsigned* bar, volatile LAS unsigned* st) {
    XcdBarrier b; b.bar = bar; b.x = xb_xcc_id(); b.st = st;
    if (threadIdx.x == 0) (void)xb_add(&bar[XB_XCNT(b.x)], 1u);
    return b;
}
__device__ __forceinline__ void xcd_barrier_complete(unsigned* bar, unsigned x, unsigned& nloc, unsigned& nx) {
    const unsigned G = gridDim.x * gridDim.y * gridDim.z;
    unsigned sum, cnt, mine, sp = 0u;
    for (;;) {
        sum = 0u; cnt = 0u; mine = 0u;
#pragma unroll
        for (unsigned j = 0; j < 16; ++j) { const unsigned c = xb_ld(&bar[XB_XCNT(j)]); sum += c; cnt += (c > 0u) ? 1u : 0u; mine = (j == x) ? c : mine; }
        if (sum == G) break;
        __builtin_amdgcn_s_sleep(1);
        if ((++sp & 255u) == 0u) { if (xb_ld(&bar[XB_TMO])) break; if (sp > XB_SPIN_CAP) { atomicAdd(&bar[XB_TMO], 1u); break; } }
    }
    nloc = mine > 0u ? mine : 1u; nx = cnt > 0u ? cnt : 1u;
}

__device__ __forceinline__ void xcd_barrier(const XcdBarrier& b) {
    asm volatile("s_waitcnt vmcnt(0)" ::: "memory");
    __syncthreads();
    if (opaque_tid() == 0) {
        unsigned* bar = b.bar;
        __builtin_amdgcn_s_waitcnt(0);
        unsigned nloc = b.st[0], nx = b.st[1];
        if (nloc == 0u) { xcd_barrier_complete(bar, b.x, nloc, nx); b.st[0] = nloc; b.st[1] = nx; }
        const unsigned old = xb_add(&bar[XB_XSUB(b.x)], 1u);
        const unsigned gen = old / nloc;
        if (old + 1u == (gen + 1u) * nloc) {
            __builtin_amdgcn_fence(__ATOMIC_RELEASE, "agent");
            asm volatile("s_waitcnt vmcnt(0)" ::: "memory");
            const unsigned og = xb_add(&bar[XB_TOP], 1u);
            const unsigned tg = og / nx;
            if (og + 1u == (tg + 1u) * nx) xb_add(&bar[XB_TOPGEN], 1u);
            else XB_SPIN(xb_ld(&bar[XB_TOPGEN]) == tg, bar);
            __builtin_amdgcn_fence(__ATOMIC_ACQUIRE, "agent");
            xb_add(&bar[XB_XGEN(b.x)], 1u);
            asm volatile("s_waitcnt vmcnt(0)" ::: "memory");
        } else {
            XB_SPIN(xb_ld(&bar[XB_XGEN(b.x)]) == gen, bar);
            __builtin_amdgcn_fence(__ATOMIC_ACQUIRE, "agent");
            asm volatile("s_waitcnt vmcnt(0)" ::: "memory");
        }
    }
    __syncthreads();
}

__device__ __forceinline__ float xor4f(float x) {
    int t = __builtin_amdgcn_update_dpp(0, __builtin_bit_cast(int, x), 0x104, 0xF, 0x5, false);
    t = __builtin_amdgcn_update_dpp(t, __builtin_bit_cast(int, x), 0x114, 0xF, 0xA, false);
    return __builtin_bit_cast(float, t);
}
__device__ __forceinline__ unsigned okey(unsigned b) { return b ^ ((unsigned)((int)b >> 31) | 0x80000000u); }
__device__ __forceinline__ unsigned okey_inv(unsigned u) { return (u & 0x80000000u) ? (u ^ 0x80000000u) : ~u; }
__device__ __forceinline__ unsigned umax_(unsigned a, unsigned b) { return a > b ? a : b; }
__device__ __forceinline__ unsigned umin_(unsigned a, unsigned b) { return a < b ? a : b; }
template <int CTRL> __device__ __forceinline__ unsigned dppu(unsigned x) { return (unsigned)__builtin_amdgcn_update_dpp(0, (int)x, CTRL, 0xF, 0xF, true); }
__device__ __forceinline__ unsigned xor4u(unsigned x) {
    int t = __builtin_amdgcn_update_dpp(0, (int)x, 0x104, 0xF, 0x5, false); t = __builtin_amdgcn_update_dpp(t, (int)x, 0x114, 0xF, 0xA, false); return (unsigned)t;
}
template <int N> __device__ __forceinline__ void bitonic_merge_desc(unsigned (&a)[N]) {
#pragma unroll
    for (int j = N >> 1; j > 0; j >>= 1)
#pragma unroll
        for (int i = 0; i < N; ++i) { const int l = i ^ j; if (l > i) { const unsigned hi = umax_(a[i], a[l]), lo = umin_(a[i], a[l]); a[i] = hi; a[l] = lo; } }
}
template <int N> __device__ __forceinline__ void bitonic_sort_desc(unsigned (&a)[N]) {
#pragma unroll
    for (int k = 2; k <= N; k <<= 1)
#pragma unroll
        for (int j = k >> 1; j > 0; j >>= 1)
#pragma unroll
            for (int i = 0; i < N; ++i) { const int l = i ^ j; if (l > i) { const bool asc = (k < N) && ((i & k) != 0);
                const unsigned hi = umax_(a[i], a[l]), lo = umin_(a[i], a[l]); a[i] = asc ? lo : hi; a[l] = asc ? hi : lo; } }
}
__device__ __forceinline__ float row_max16(float x) { x = fmaxf(x, dppf<0xB1>(x)); x = fmaxf(x, dppf<0x4E>(x)); x = fmaxf(x, dppf<0x141>(x)); x = fmaxf(x, dppf<0x140>(x)); return x; }
constexpr int P11_LISTS = 0, P11_TOPK = 1024, P11_TAB = 1536, P11_RES = 2048, P11_WAVE_LDS = 2048 + 8 * 1536;
__device__ __forceinline__ void p11_load_scores(u32x4 (&sc)[8], int t, int lane) {
    const u32x4* SC = (const u32x4*)((const unsigned short*)(KWS() + WS_SC) + (size_t)t * 2048 + 32 * lane);
    u32x4 raw[4];
#pragma unroll
    for (int i = 0; i < 4; ++i) raw[i] = SC[i];
#pragma unroll
    for (int i = 0; i < 4; ++i)
#pragma unroll
        for (int c = 0; c < 4; ++c) { const unsigned w = raw[i][c];
            const float fx = (float)__builtin_bit_cast(_Float16, (unsigned short)(w & 0xFFFFu)), fy = (float)__builtin_bit_cast(_Float16, (unsigned short)(w >> 16));
            sc[2 * i + (c >> 1)][2 * (c & 1)] = __builtin_bit_cast(unsigned, fx); sc[2 * i + (c >> 1)][2 * (c & 1) + 1] = __builtin_bit_cast(unsigned, fy); }
}
__device__ __forceinline__ void p11_setup(LAS unsigned char* wl, int lane, unsigned (&lut)[7]) {
    int c = lane, ti = 0, tj = 0, valid = 0;
#pragma unroll 1
    for (int i = 0; i < 16; ++i) { const int n = 16 / (i + 1); if (c < n) { ti = i; tj = c; valid = 1; break; } c -= n; }
    ((LAS unsigned*)(wl + P11_TAB))[lane] = (unsigned)(ti | (tj << 4) | (valid << 8));
    asm volatile("s_waitcnt lgkmcnt(0)" ::: "memory");
#pragma unroll
    for (int m = 0; m < 7; ++m) lut[m] = ((volatile LAS unsigned*)(wl + P11_TAB))[(lane & 7) + 8 * m];
}
#ifndef P11_NTG
#define P11_NTG 4
#endif
__device__ __forceinline__ void p11_topk(const u32x4 (&sc)[8], const unsigned (&lut)[7], LAS unsigned char* wl, int lane, unsigned (&e_slot)[2], float (&g_slot)[2]) {
    {
        unsigned h0[16], h1[16];
        const unsigned pbase = (unsigned)((lane & 3) * 32);
#pragma unroll
        for (int i = 0; i < 4; ++i)
#pragma unroll
            for (int c = 0; c < 4; ++c) { h0[4 * i + c] = okey((sc[i][c] & ~0x7Fu) | (pbase + 4 * i + c)); h1[4 * i + c] = okey((sc[4 + i][c] & ~0x7Fu) | (pbase + 16 + 4 * i + c)); }
        bitonic_sort_desc<16>(h0); bitonic_sort_desc<16>(h1);
        unsigned s16[16];
#pragma unroll
        for (int i = 0; i < 16; ++i) s16[i] = umax_(h0[i], h1[15 - i]);
        bitonic_merge_desc<16>(s16);
        { unsigned d[16];
#pragma unroll
          for (int i = 0; i < 16; ++i) d[i] = umax_(s16[i], dppu<0xB1>(s16[15 - i]));
          bitonic_merge_desc<16>(d);
#pragma unroll
          for (int i = 0; i < 16; ++i) s16[i] = umax_(d[i], dppu<0x4E>(d[15 - i]));
          bitonic_merge_desc<16>(s16); }
        if ((lane & 3) == 0) { LAS u32x4* lp = (LAS u32x4*)(wl + P11_LISTS + (lane >> 2) * 64);
            lp[0] = (u32x4){s16[0], s16[1], s16[2], s16[3]}; lp[1] = (u32x4){s16[4], s16[5], s16[6], s16[7]}; lp[2] = (u32x4){s16[8], s16[9], s16[10], s16[11]}; lp[3] = (u32x4){s16[12], s16[13], s16[14], s16[15]}; }
        asm volatile("s_waitcnt lgkmcnt(0)" ::: "memory");
        const int hd = lane >> 3, e = lane & 7;
        volatile LAS unsigned* la = (volatile LAS unsigned*)(wl + P11_LISTS + (2 * hd) * 64);
        volatile LAS unsigned* lb = (volatile LAS unsigned*)(wl + P11_LISTS + (2 * hd + 1) * 64);
        unsigned cand[8];
#pragma unroll
        for (int m = 0; m < 7; ++m) {
            const unsigned ij = lut[m];
            const float av = __builtin_bit_cast(float, okey_inv(la[ij & 15u]) & ~0x7Fu), bv = __builtin_bit_cast(float, okey_inv(lb[(ij >> 4) & 15u]) & ~0x7Fu);
            const unsigned kk = okey((__builtin_bit_cast(unsigned, av + bv) & ~0x3Fu) | (unsigned)(e + 8 * m));
            cand[m] = (ij & 0x100u) ? kk : 0u;
        }
        cand[7] = 0u;
        bitonic_sort_desc<8>(cand);
        unsigned t16[16];
#pragma unroll
        for (int i = 0; i < 8; ++i) { t16[i] = cand[i]; t16[15 - i] = dppu<0xB1>(cand[i]); }
        bitonic_merge_desc<16>(t16);
        { unsigned d[16];
#pragma unroll
          for (int i = 0; i < 16; ++i) d[i] = umax_(t16[i], dppu<0x4E>(t16[15 - i]));
          bitonic_merge_desc<16>(d);
#pragma unroll
          for (int i = 0; i < 16; ++i) t16[i] = umax_(d[i], xor4u(d[15 - i]));
          bitonic_merge_desc<16>(t16); }
        if (e == 0) { LAS u32x4* tp = (LAS u32x4*)(wl + P11_TOPK + hd * 64);
            tp[0] = (u32x4){t16[0], t16[1], t16[2], t16[3]}; tp[1] = (u32x4){t16[4], t16[5], t16[6], t16[7]}; tp[2] = (u32x4){t16[8], t16[9], t16[10], t16[11]}; tp[3] = (u32x4){t16[12], t16[13], t16[14], t16[15]}; }
        asm volatile("s_waitcnt lgkmcnt(0)" ::: "memory");
#pragma unroll
        for (int sl = 0; sl < 2; ++sl) {
            const int hd2 = 4 * sl + (lane >> 4);
            const unsigned kb = okey_inv(((volatile LAS unsigned*)(wl + P11_TOPK))[hd2 * 16 + (lane & 15)]);
            const unsigned ij = ((volatile LAS unsigned*)(wl + P11_TAB))[kb & 0x3Fu];
            const unsigned ka = okey_inv(((volatile LAS unsigned*)(wl + P11_LISTS))[(2 * hd2) * 16 + (ij & 15u)]);
            const unsigned kq = okey_inv(((volatile LAS unsigned*)(wl + P11_LISTS))[(2 * hd2 + 1) * 16 + ((ij >> 4) & 15u)]);
            e_slot[sl] = (ka & 0x7Fu) * 128u + (kq & 0x7Fu);
            const float sv = __builtin_bit_cast(float, kb & ~0x3Fu);
            const float ex = __expf(sv - row_max16(sv));
            g_slot[sl] = ex / row_sum16(ex);
        }
    }
#pragma unroll
    for (int sl = 0; sl < 2; ++sl) {
        unsigned key = (e_slot[sl] << 6) | (unsigned)lane;
#pragma unroll
        for (int k = 2; k <= 64; k <<= 1)
#pragma unroll
            for (int j = k >> 1; j > 0; j >>= 1) {
                const unsigned other = (unsigned)__shfl_xor((int)key, j);
                const bool up = (k == 64) || ((lane & k) == 0), lower = (lane & j) == 0;
                const unsigned mn = umin_(key, other), mx = umax_(key, other);
                key = (lower == up) ? mn : mx;
            }
        e_slot[sl] = key >> 6;
        g_slot[sl] = __shfl(g_slot[sl], (int)(key & 63u));
    }
    {
        unsigned k0 = (e_slot[0] << 7) | (unsigned)lane, k1 = (e_slot[1] << 7) | 64u | (unsigned)lane;
        const unsigned r1 = (unsigned)__shfl((int)k1, 63 - lane);
        unsigned lo = umin_(k0, r1), hi = umax_(k0, r1);
#pragma unroll
        for (int j = 32; j > 0; j >>= 1) {
            const unsigned ol = (unsigned)__shfl_xor((int)lo, j), oh = (unsigned)__shfl_xor((int)hi, j);
            const bool lower = (lane & j) == 0;
            lo = lower ? umin_(lo, ol) : umax_(lo, ol); hi = lower ? umin_(hi, oh) : umax_(hi, oh);
        }
        const float g0 = g_slot[0], g1 = g_slot[1];
        const float a0 = __shfl(g0, (int)(lo & 63u)), a1 = __shfl(g1, (int)(lo & 63u)), b0 = __shfl(g0, (int)(hi & 63u)), b1 = __shfl(g1, (int)(hi & 63u));
        e_slot[0] = lo >> 7; g_slot[0] = (lo & 64u) ? a1 : a0;
        e_slot[1] = hi >> 7; g_slot[1] = (hi & 64u) ? b1 : b0;
    }
}
typedef __bf16 bf16x2_t __attribute__((ext_vector_type(2)));
template <int NTG>
__device__ __forceinline__ void p11_group(const Args& a, int t0, int tstride, const unsigned (&lut)[7], LAS unsigned char* wl, int lane) {
    unsigned char* ws = KWS();
    unsigned es[NTG][2]; float cu[NTG][2], cv[NTG][2];
    {
        u32x4 sc[8];
#pragma unroll 1
        for (int j0 = 0; j0 < NTG; j0 += 2) {
#pragma unroll
            for (int jj = 0; jj < 2; ++jj) {
                const int j = j0 + jj, t = t0 + j * tstride;
                int lo_ = lane; asm volatile("" : "+v"(lo_));
                p11_load_scores(sc, t, lo_);
                unsigned e2[2]; float g_slot[2];
                p11_topk(sc, lut, wl, lo_, e2, g_slot);
                const f32x4* sp = (const f32x4*)((const float*)(ws + WS_SSQ) + (size_t)t * 16);
                const f32x4 s0 = sp[0], s1 = sp[1], s2 = sp[2], s3 = sp[3];
                const float tot = (((s0[0] + s0[1]) + (s0[2] + s0[3])) + ((s1[0] + s1[1]) + (s1[2] + s1[3]))) + (((s2[0] + s2[1]) + (s2[2] + s2[3])) + ((s3[0] + s3[1]) + (s3[2] + s3[3])));
                const float rs = 1.f / sqrtf(tot * (1.f / 1024.f) + EPS);
                volatile LAS unsigned* res = (volatile LAS unsigned*)(wl + P11_RES) + j * 384;
#pragma unroll
                for (int sl = 0; sl < 2; ++sl) {
                    res[sl * 64 + lo_] = e2[sl];
                    res[128 + sl * 64 + lo_] = __builtin_bit_cast(unsigned, rs * ((const float*)(ws + WS_PUS))[e2[sl]]);
                    res[256 + sl * 64 + lo_] = __builtin_bit_cast(unsigned, g_slot[sl] * ((const float*)(ws + WS_PVS))[e2[sl]]);
                }
            }
        }
        asm volatile("s_waitcnt lgkmcnt(0)" ::: "memory");
#pragma unroll
        for (int j = 0; j < NTG; ++j) { volatile LAS unsigned* res = (volatile LAS unsigned*)(wl + P11_RES) + j * 384;
#pragma unroll
            for (int sl = 0; sl < 2; ++sl) { es[j][sl] = res[sl * 64 + lane]; cu[j][sl] = __builtin_bit_cast(float, res[128 + sl * 64 + lane]); cv[j][sl] = __builtin_bit_cast(float, res[256 + sl * 64 + lane]); } }
    }
    const int loff = 16 * lane;
    u32x4 rr[2][4];
#define P11_LOADR(TAB, B, l, sl, k) do { const int es_ = (int)es[l][sl]; const int p0_ = (k) * 4; \
        _Pragma("unroll") for (int jj = 0; jj < 4; ++jj) { const size_t eo_ = (size_t)(unsigned)__builtin_amdgcn_readlane(es_, p0_ + jj) * 1024; rr[B][jj] = *(const u32x4*)(((TAB) + eo_) + loff); } } while (0)
    float wgt[NTG][2];
    {
        const unsigned char* PU = ws + WS_PU;
        u32x4 hh_[NTG], hl_[NTG]; float hsc[NTG];
#pragma unroll
        for (int j = 0; j < NTG; ++j) { const int t = t0 + j * tstride;
            const bf16_t* hrow_ = (const bf16_t*)(ws + WS_HB) + (size_t)t * 1024 + 4 * lane;
            float f[16]; float am = 0.f;
#pragma unroll
            for (int q = 0; q < 4; ++q) { const u32x2 hq_ = *(const u32x2*)(hrow_ + 256 * q); f[4 * q] = bflo(hq_.x); f[4 * q + 1] = bfhi(hq_.x); f[4 * q + 2] = bflo(hq_.y); f[4 * q + 3] = bfhi(hq_.y); }
#pragma unroll
            for (int i = 0; i < 16; ++i) am = fmaxf(am, fabsf(f[i]));
            am = fmaxf(wave_max(am), 1e-30f);
            const float sh = 127.f / am; hsc[j] = am * (1.f / (127.f * 254.f));
            unsigned wh[4], wl_[4];
#pragma unroll
            for (int q = 0; q < 4; ++q) { float a_[4], r_[4];
#pragma unroll
                for (int i = 0; i < 4; ++i) { a_[i] = __builtin_rintf(f[4 * q + i] * sh); r_[i] = (f[4 * q + i] * sh - a_[i]) * 254.f; }
                wh[q] = pack_i8x4(a_[0], a_[1], a_[2], a_[3]); wl_[q] = pack_i8x4(r_[0], r_[1], r_[2], r_[3]); }
            hh_[j] = (u32x4){wh[0], wh[1], wh[2], wh[3]}; hl_[j] = (u32x4){wl_[0], wl_[1], wl_[2], wl_[3]}; }
        float dots[NTG][2];
#pragma unroll
        for (int j = 0; j < NTG; ++j) { dots[j][0] = 0.f; dots[j][1] = 0.f; }
        __syncthreads();
#define P11_COMPU(B, l, sl, k) do { float part[4]; \
        u32x4 h0_ = hh_[l], h1_ = hl_[l]; asm volatile("" : "+v"(h0_), "+v"(h1_)); \
        _Pragma("unroll") for (int jj = 0; jj < 4; ++jj) { int ah_ = 0, al_ = 0; \
            _Pragma("unroll") for (int q = 0; q < 4; ++q) { ah_ = __builtin_amdgcn_sdot4((int)rr[B][jj][q], (int)h0_[q], ah_, false); al_ = __builtin_amdgcn_sdot4((int)rr[B][jj][q], (int)h1_[q], al_, false); } \
            part[jj] = (float)(ah_ * 254 + al_); } \
        float q2[2]; \
        _Pragma("unroll") for (int kk = 0; kk < 2; ++kk) { const float keep = (lane & 1) ? part[2 * kk + 1] : part[2 * kk], send = (lane & 1) ? part[2 * kk] : part[2 * kk + 1]; q2[kk] = keep + dppf<0xB1>(send); } \
        float d_ = ((lane & 2) ? q2[1] : q2[0]) + dppf<0x4E>((lane & 2) ? q2[0] : q2[1]); \
        d_ += xor4f(d_); d_ += dppf<0x128>(d_); d_ = swap32_sum(swap16_sum(d_));                       \
        if ((lane >> 2) == (k)) dots[l][sl] = d_; } while (0)
        constexpr int L = NTG;
        P11_LOADR(PU, 0, 0, 0, 0);
#pragma unroll
        for (int sl = 0; sl < 2; ++sl) {
#pragma unroll 1
            for (int k = 0; k < 16; ++k) {
#pragma unroll
                for (int l = 0; l < L; ++l) {
                    if (l + 1 < L) { if ((l & 1) == 0) P11_LOADR(PU, 1, l + 1, sl, k); else P11_LOADR(PU, 0, l + 1, sl, k); }
                    else if (k + 1 < 16) P11_LOADR(PU, 0, 0, sl, k + 1);
                    else if (sl == 0) P11_LOADR(PU, 0, 0, 1, 0);
                    if ((l & 1) == 0) P11_COMPU(0, l, sl, k); else P11_COMPU(1, l, sl, k);
                }
            }
        }
#undef P11_COMPU
#pragma unroll
        for (int j = 0; j < NTG; ++j)
#pragma unroll
            for (int sl = 0; sl < 2; ++sl) { const float z = dots[j][sl] * hsc[j] * cu[j][sl]; wgt[j][sl] = cv[j][sl] * (0.5f * z * (1.f + erff(z * 0.70710678118654752f))); }
    }
    int o[NTG][16]; float wsc[NTG]; unsigned wpk[NTG][2];
#pragma unroll
    for (int j = 0; j < NTG; ++j) {
#pragma unroll
        for (int i = 0; i < 16; ++i) o[j][i] = 0;
        const float am = fmaxf(wave_max(fmaxf(fabsf(wgt[j][0]), fabsf(wgt[j][1]))), 1e-30f);
        const float sw = 127.f / am; wsc[j] = am * (1.f / 127.f);
#pragma unroll
        for (int sl = 0; sl < 2; ++sl) { const unsigned wq_ = (unsigned)(int)__builtin_rintf(wgt[j][sl] * sw) & 0xffu;
            wpk[j][sl] = dppu<0x00>(wq_) | (dppu<0x55>(wq_) << 8) | (dppu<0xAA>(wq_) << 16) | (dppu<0xFF>(wq_) << 24); }
    }
    __syncthreads();
    {
        const unsigned char* PV = ws + WS_PV;
#define P11_COMPV(B, l, sl, k) do { const unsigned w4_ = (unsigned)__builtin_amdgcn_readlane((int)wpk[l][sl], (k) * 4); \
        _Pragma("unroll") for (int q = 0; q < 4; ++q) { const unsigned r0_ = rr[B][0][q], r1_ = rr[B][1][q], r2_ = rr[B][2][q], r3_ = rr[B][3][q]; \
            const unsigned a_ = __builtin_amdgcn_perm(r1_, r0_, 0x05010400u), b_ = __builtin_amdgcn_perm(r1_, r0_, 0x07030602u); \
            const unsigned c_ = __builtin_amdgcn_perm(r3_, r2_, 0x05010400u), d_ = __builtin_amdgcn_perm(r3_, r2_, 0x07030602u); \
            o[l][4 * q] = __builtin_amdgcn_sdot4((int)__builtin_amdgcn_perm(c_, a_, 0x05040100u), (int)w4_, o[l][4 * q], false); \
            o[l][4 * q + 1] = __builtin_amdgcn_sdot4((int)__builtin_amdgcn_perm(c_, a_, 0x07060302u), (int)w4_, o[l][4 * q + 1], false); \
            o[l][4 * q + 2] = __builtin_amdgcn_sdot4((int)__builtin_amdgcn_perm(d_, b_, 0x05040100u), (int)w4_, o[l][4 * q + 2], false); \
            o[l][4 * q + 3] = __builtin_amdgcn_sdot4((int)__builtin_amdgcn_perm(d_, b_, 0x07060302u), (int)w4_, o[l][4 * q + 3], false); } } while (0)
        constexpr int L = NTG;
        P11_LOADR(PV, 0, 0, 0, 0);
#pragma unroll
        for (int sl = 0; sl < 2; ++sl) {
#pragma unroll 1
            for (int k = 0; k < 16; ++k) {
#pragma unroll
                for (int l = 0; l < L; ++l) {
                    if (l + 1 < L) { if ((l & 1) == 0) P11_LOADR(PV, 1, l + 1, sl, k); else P11_LOADR(PV, 0, l + 1, sl, k); }
                    else if (k + 1 < 16) P11_LOADR(PV, 0, 0, sl, k + 1);
                    else if (sl == 0) P11_LOADR(PV, 0, 0, 1, 0);
                    if ((l & 1) == 0) P11_COMPV(0, l, sl, k); else P11_COMPV(1, l, sl, k);
                }
            }
        }
#undef P11_COMPV
    }
#undef P11_LOADR
    const float* NF = KIN(24) + 4 * lane;
#pragma unroll
    for (int j = 0; j < NTG; ++j) {
        float* H = KOUT() + (size_t)(t0 + j * tstride) * 1024 + 4 * lane;
        const bf16_t* hb = (const bf16_t*)(ws + WS_HB) + (size_t)(t0 + j * tstride) * 1024 + 4 * lane;
        float y[16]; float ss = 0.f;
#pragma unroll
        for (int q = 0; q < 4; ++q) { const u32x2 hq_ = *(const u32x2*)(hb + 256 * q); y[4 * q] = bflo(hq_.x); y[4 * q + 1] = bfhi(hq_.x); y[4 * q + 2] = bflo(hq_.y); y[4 * q + 3] = bfhi(hq_.y); }
#pragma unroll
        for (int i = 0; i < 16; ++i) { y[i] += (float)o[j][i] * wsc[j]; ss += y[i] * y[i]; }
        const float rf = 1.f / sqrtf(wave_sum_fast(ss) * (1.f / 1024.f) + EPS);
#pragma unroll
        for (int q = 0; q < 4; ++q) { const f32x4 nv = *(const f32x4*)(NF + 256 * q);
            *(f32x4*)(H + 256 * q) = (f32x4){y[4 * q] * rf * nv[0], y[4 * q + 1] * rf * nv[1], y[4 * q + 2] * rf * nv[2], y[4 * q + 3] * rf * nv[3]}; }
    }
}

__global__ void __launch_bounds__(NT, 2) mega(Args a) {
    extern __shared__ __attribute__((aligned(16))) unsigned char lds_raw[];
    LAS unsigned char* lds = (LAS unsigned char*)lds_raw;
    volatile LAS unsigned* MISC = (volatile LAS unsigned*)(lds + 131072 + 320);
    if (threadIdx.x < 32) MISC[threadIdx.x] = 0u;
    if ((threadIdx.x & 63) == 0) ((volatile LAS int*)(lds + TID_TABLE_LDS))[hw_wave_slot()] = (int)(threadIdx.x >> 6);
    __syncthreads();
    XcdBarrier xbar = xcd_barrier_post((unsigned*)(KWS() + WS_CTL) + 4096, MISC + 8);
#define GSYNC() xcd_barrier(xbar)
#ifndef PH_LO
#define PH_LO 0
#endif
#ifndef PH_HI
#define PH_HI 99
#endif
#define IN(k) (PH_LO <= (k) && (k) <= PH_HI)
    if (IN(0)) { p0_prologue_a(a, lds); GSYNC(); p0_prologue_b(a, lds); GSYNC(); }
    if (IN(1)) {
        unsigned char* ws = KWS(); const int G = gridDim.x, bx = opaque_bx(); pg8::StaticOrder S;
        { pg8::Gemm g{(const bf16_t*)(ws + WS_XN), (const bf16_t*)(ws + WS_WIN), TOK, IN_PAD, 512, 512, 512}; S.init(TOK, IN_PAD, G, bx);
          EpiInProj E{(bf16_t*)(ws + WS_Z), (bf16_t*)(ws + WS_XBC), (bf16_t*)(ws + WS_G), (bf16_t*)(ws + WS_QA), (bf16_t*)(ws + WS_KVA), (const float*)(ws + WS_XSC), (const unsigned*)(ws + WS_CTL + WS_WAMAX)};
          { const int rem = S.nwg % G; if (rem == 0) p9_peer_tables(a, 0, 16384, bx, G); else if (bx >= rem) p9_peer_tables(a, 0, 16384, bx - rem, G - rem); }
          pg8::gemm_phase<EpiInProj, 2>(lds, g, S, E); }
        GSYNC();
    }
    if (IN(2)) { p2_prep(a, lds); GSYNC(); }
    if (IN(3)) { const int G = gridDim.x; for (int u = opaque_bx(); u < BATCH * 16 * 2; u += G) p34_chain(a, lds, u); GSYNC(); }
    if (IN(5)) { const int G = gridDim.x; for (int u = opaque_bx(); u < BATCH * NCHUNK * 2; u += G) p5_out_unit(a, lds, u); GSYNC(); }
    if (IN(6)) {
        unsigned char* ws = KWS(); const int G = gridDim.x, bx = opaque_bx(); pg8::StaticOrder S;
        const int rot = (bx >> 3) % 3;
#pragma unroll 1
        for (int s_ = 0; s_ < 3; ++s_) {
            int ph_ = s_ + rot; if (ph_ >= 3) ph_ -= 3; asm volatile("" : "+s"(ph_));
            if (ph_ == 0) {
        { pg8::Gemm g{(const bf16_t*)(ws + WS_QA), (const bf16_t*)(ws + WS_WQB), TOK, 1536, 384, 512, 384}; S.init(TOK, 1536, G, bx);
          EpiQ E{(unsigned char*)KOUT(), (const float*)(ws + WS_RQ), (const float*)(ws + WS_COS), (const float*)(ws + WS_SIN)}; pg8::gemm_phase(lds, g, S, E); }
            } else if (ph_ == 1) {
        { pg8::Gemm g{(const bf16_t*)(ws + WS_KVA), (const bf16_t*)(ws + WS_WK), TOK, 1024, 256, 256, 256}; S.init(TOK, 1024, G, bx);
          EpiK E{(unsigned char*)(ws + WS_K), (const float*)(ws + WS_RKV)}; pg8::gemm_phase(lds, g, S, E); }
            } else {
        { pg8::Gemm g{(const bf16_t*)(ws + WS_WV), (const bf16_t*)(ws + WS_KVA), 1024, TOK, 256, 256, 256}; S.init(1024, TOK, G, bx);
          EpiVT E{(unsigned char*)(ws + WS_VT), (const float*)(ws + WS_RKV)}; pg8::gemm_phase(lds, g, S, E); }
            }
        }
        GSYNC();
    }
    if (IN(7)) { p7_attention(a, lds); GSYNC(); }
    if (IN(8)) {
        unsigned char* ws = KWS(); const int G = gridDim.x, bx = opaque_bx(); pg8::StaticOrder S;
        { pg8::Gemm g{(const bf16_t*)(ws + WS_YSQ), (const bf16_t*)(ws + WS_PA), TOK, 1024, 512, 512, 512}; S.init(TOK, 1024, G, bx);
          EpiMerge1 E{(bf16_t*)(ws + WS_M), (const unsigned char*)(ws + WS_G), (1.f / 255.f) / (YS8_SCALE * WIN_SCALE)}; pg8::gemm_phase<EpiMerge1, 1>(lds, g, S, E); }
        { pg8::Gemm g{(const bf16_t*)(ws + WS_YM), (const bf16_t*)(ws + WS_PB), TOK, 1024, 512, 512, 512}; S.init(TOK, 1024, G, bx);
          EpiMerge2 E{(bf16_t*)(ws + WS_M), (const unsigned char*)(ws + WS_G), (1.f / 255.f) / (YSCALE * WIN_SCALE), ws + WS_MQ}; pg8::gemm_phase<EpiMerge2, 1>(lds, g, S, E); }
        GSYNC();
    }
    if (IN(9)) {
        unsigned char* ws = KWS(); const int G = gridDim.x, bx = opaque_bx(); pg8::StaticOrder S;
        { pg8::Gemm g{(const bf16_t*)(ws + WS_MQ), (const bf16_t*)(ws + WS_WOUT), TOK, 1024, 512, 512, 512}; S.init(TOK, 1024, G, bx);
          EpiOut E{KIN(0), (bf16_t*)(ws + WS_HB), (float*)(ws + WS_SSQ), ws + WS_HQ, (const unsigned*)(ws + WS_CTL + WS_WOAMAX)};
          const bool first = (bx >> 3) & 1;
          if (first) p9_peer_tables(a, 16384, 32768, bx, G);
          pg8::gemm_phase<EpiOut, 2>(lds, g, S, E);
          if (!first) p9_peer_tables(a, 16384, 32768, bx, G); }
        GSYNC();
    }
    if (IN(10)) {
        unsigned char* ws = KWS(); const int G = gridDim.x, bx = opaque_bx(); pg8::StaticOrder S;
        pg8::Gemm g{(const bf16_t*)(ws + WS_HQ), (const bf16_t*)(ws + WS_WPQ8), TOK, 2048, 512, 512, 512}; S.init(TOK, 2048, G, bx);
        EpiScore E{(float*)(ws + WS_SC), (const float*)(ws + WS_SSQ), (const unsigned*)(ws + WS_CTL + WS_WPAMAX)}; pg8::gemm_phase<EpiScore, 2>(lds, g, S, E);
        GSYNC();
    }
    if (IN(11)) { const int tid_ = opaque_tid(); const int wave = tid_ >> 6, lane = tid_ & 63; const int gw = opaque_bx() * NW + wave, ngw = gridDim.x * NW; LAS unsigned char* wl = lds + wave * P11_WAVE_LDS; unsigned lut[7]; p11_setup(wl, lane, lut); for (int t = gw; t < TOK; t += P11_NTG * ngw) p11_group<P11_NTG>(a, t, ngw, lut, wl, lane); }
}

extern "C" void kernel_launch(void* const* d_in, const int* in_sizes, int n_in, void* d_out, int out_size, void* d_ws, size_t ws_size, hipStream_t stream) {
    static int grid = 0;
    if (grid == 0) {
        if (n_in != 25 || out_size != TOK * DM || ws_size < WS_END) { fprintf(stderr, "kernel_launch: unexpected sizes n_in %d out %d ws %zu\n", n_in, out_size, ws_size); grid = -1; return; }
        int dev = 0, cus = 0, per_cu = 0;
        (void)hipGetDevice(&dev);
        (void)hipDeviceGetAttribute(&cus, hipDeviceAttributeMultiprocessorCount, dev);
        (void)hipFuncSetAttribute((const void*)mega, hipFuncAttributeMaxDynamicSharedMemorySize, LDS_BYTES);
        (void)hipOccupancyMaxActiveBlocksPerMultiprocessor(&per_cu, (const void*)mega, NT, LDS_BYTES);
        if (per_cu < 1) { fprintf(stderr, "kernel_launch: occupancy query reports %d\n", per_cu); grid = -1; return; }
        grid = cus;
    }
    if (grid < 0) return;
    if (hipMemsetAsync((char*)d_ws + WS_CTL, 0, 1 * MiB, stream) != hipSuccess) { fprintf(stderr, "kernel_launch: hipMemsetAsync failed\n"); return; }
    Args a{};
    for (int i = 0; i < 25; ++i) a.in[i] = (const float*)d_in[i];
    a.out = (float*)d_out; a.ws = (unsigned char*)d_ws;
    void* args[] = {&a};
    hipError_t e = hipLaunchCooperativeKernel((const void*)mega, dim3(grid), dim3(NT), args, LDS_BYTES, stream);
    if (e != hipSuccess) fprintf(stderr, "kernel_launch: cooperative launch failed: %s (grid %d)\n", hipGetErrorString(e), grid);
}
```
